# Optimizing an MI355X kernel written in HIP

```python
import jax, jax.numpy as jnp
from jax import lax
import numpy as np

D_MODEL = 1024
BATCH = 4
SEQ = 4096
DEPTH = 1
DEC_BATCH = 128
DEC_SEQ = 4
PAST_LEN = 8192
PAGE_SIZE = 128

EPS = 1e-6
GLA_HEADS = 4
GLA_DK = D_MODEL // 2 // GLA_HEADS
GLA_DV = D_MODEL // GLA_HEADS
GLA_RANK = 16
GLA_TAU = 16.0
GLA_CHUNK = 64
GLA_SCALE = GLA_DK ** -0.5
DSW_GROUPS = ((128, 1), (512, 4), (2048, 16))
DSW_N_GROUPS = len(DSW_GROUPS)
DSW_HEADS = 4
DSW_HEAD_DIM = 64
DSW_SCALE = DSW_HEAD_DIM ** -0.5
BAND_BLOCK = 128
ROPE_THETA = 10000.0
D_FF = -(-8 * D_MODEL // (3 * 256)) * 256
GLA_QK_W = GLA_HEADS * GLA_DK
GLA_V_W = GLA_HEADS * GLA_DV
DSW_W = DSW_N_GROUPS * DSW_HEADS * DSW_HEAD_DIM
DSW_OUT_W = DSW_HEADS * DSW_HEAD_DIM
IN_SIZES = (GLA_QK_W, GLA_QK_W, GLA_V_W, GLA_V_W, GLA_RANK, DSW_W, DSW_W, DSW_W, D_MODEL, D_MODEL)
IN_W = sum(IN_SIZES)
IN_OFFSETS = tuple(int(o) for o in np.cumsum(IN_SIZES)[:-1])

kernel_name = "gla_dilated_window_hybrid_adaln_step"


def _rmsnorm(x, g):
    xf = x.astype(jnp.float32)
    y = xf * lax.rsqrt(jnp.mean(xf * xf, axis=-1, keepdims=True) + EPS)
    return (y * g.astype(jnp.float32)).astype(x.dtype)


def _rope(x, pos):
    half = x.shape[-1] // 2
    inv = ROPE_THETA ** (-jnp.arange(half, dtype=jnp.float32) / half)
    ang = pos[:, None] * inv[None, :]
    cos, sin = jnp.cos(ang)[:, None, :], jnp.sin(ang)[:, None, :]
    xf = x.astype(jnp.float32)
    x1, x2 = xf[..., :half], xf[..., half:]
    return jnp.concatenate([x1 * cos - x2 * sin, x2 * cos + x1 * sin], axis=-1).astype(x.dtype)


def _masked_softmax(s, valid):
    s = jnp.where(valid, s, -jnp.inf)
    m = jnp.max(s, axis=-1, keepdims=True)
    e = jnp.exp(s - m)
    den = jnp.sum(e, axis=-1, keepdims=True)
    return e / den, (m + jnp.log(den))[..., 0]


def _gla(q, k, v, log_a, S0):
    B, T, H, dk = q.shape
    dv = v.shape[-1]
    C = min(GLA_CHUNK, T)
    n = T // C
    f = lambda a: a.astype(jnp.float32).reshape(B, n, C, H, a.shape[-1]).transpose(0, 1, 3, 2, 4)
    qc, kc, vc, lc = f(q) * GLA_SCALE, f(k), f(v), f(log_a)
    b = jnp.cumsum(lc, axis=3)
    b_last = b[:, :, :, -1:, :]
    qg = qc * jnp.exp(b)
    kd = kc * jnp.exp(-b)
    kl = kc * jnp.exp(b_last - b)
    causal = jnp.tril(jnp.ones((C, C), jnp.float32))
    att = jnp.einsum('bnhcd,bnhsd->bnhcs', qg, kd) * causal
    intra = jnp.einsum('bnhcs,bnhsv->bnhcv', att, vc)
    dec = jnp.exp(b_last[:, :, :, 0, :])

    def step(S, inp):
        qg_c, kl_c, v_c, dec_c = inp
        inter = jnp.einsum('bhcd,bhdv->bhcv', qg_c, S)
        S = dec_c[..., None] * S + jnp.einsum('bhcd,bhcv->bhdv', kl_c, v_c)
        return S, inter

    xs = (jnp.moveaxis(qg, 1, 0), jnp.moveaxis(kl, 1, 0), jnp.moveaxis(vc, 1, 0), jnp.moveaxis(dec, 1, 0))
    S_fin, inter = lax.scan(step, S0.astype(jnp.float32), xs)
    o = intra + jnp.moveaxis(inter, 0, 1)
    o = o.transpose(0, 1, 3, 2, 4).reshape(B, T, H, dv)
    return o, S_fin


def _band_attn(q, k, v, max_dist):
    N, L, H, hd = q.shape
    blk = BAND_BLOCK
    nb = -(-L // blk)
    pad = nb * blk - L
    blocks = lambda a: jnp.pad(a, ((0, 0), (0, pad), (0, 0), (0, 0))).reshape(N, nb, blk, H, hd)
    qb, kb, vb = blocks(q), blocks(k), blocks(v)

    def with_prev(a):
        prev = jnp.concatenate([jnp.zeros_like(a[:, :1]), a[:, :-1]], axis=1)
        return jnp.concatenate([prev, a], axis=2)

    kw, vw = with_prev(kb), with_prev(vb)
    s = jnp.einsum('nbqhd,nbkhd->nbhqk', qb, kw).astype(jnp.float32) * DSW_SCALE
    qi = jnp.arange(blk)[:, None] + blk
    ki = jnp.arange(2 * blk)[None, :]
    dist = qi - ki
    kabs = jnp.arange(nb)[:, None, None] * blk - blk + ki[None]
    valid = (dist >= 0) & (dist <= max_dist) & (kabs >= 0)
    p, lse = _masked_softmax(s, valid[None, :, None])
    o = jnp.einsum('nbhqk,nbkhd->nbqhd', p.astype(v.dtype), vw).reshape(N, nb * blk, H, hd)[:, :L]
    lse = lse.transpose(0, 1, 3, 2).reshape(N, nb * blk, H)[:, :L]
    return o, lse


def _dilated_band(q, k, v, dil, n_keys):
    B, T, H, hd = q.shape
    L = T // dil
    fold = lambda a: a.reshape(B, L, dil, H, hd).transpose(0, 2, 1, 3, 4).reshape(B * dil, L, H, hd)
    o, lse = _band_attn(fold(q), fold(k), fold(v), n_keys)
    o = o.reshape(B, dil, L, H, hd).transpose(0, 2, 1, 3, 4).reshape(B, T, H, hd)
    lse = lse.reshape(B, dil, L, H).transpose(0, 2, 1, 3).reshape(B, T, H)
    return o, lse


def _combine(outs, lses):
    w = jax.nn.softmax(jnp.stack(lses, axis=0), axis=0)[..., None]
    return jnp.sum(w * jnp.stack(outs, axis=0).astype(jnp.float32), axis=0)


def _dsw_prompt(q, k, v):
    T = q.shape[1]
    outs, lses, new = [], [], []
    for g, (win, dil) in enumerate(DSW_GROUPS):
        o, lse = _dilated_band(q[:, :, g], k[:, :, g], v[:, :, g], dil, win // dil)
        outs.append(o)
        lses.append(lse)
        keep = min(win, T)
        new.append(jnp.stack([k[:, T - keep:, g], v[:, T - keep:, g]], axis=2))
    return _combine(outs, lses), tuple(new)


def _dsw_sample(q, k, v, caches):
    S = q.shape[1]
    outs, lses, new = [], [], []
    for g, (win, dil) in enumerate(DSW_GROUPS):
        cache = caches[g]
        Wb = cache.shape[1]
        kc = jnp.concatenate([cache[:, :, 0].astype(k.dtype), k[:, :, g]], axis=1)
        vc = jnp.concatenate([cache[:, :, 1].astype(v.dtype), v[:, :, g]], axis=1)
        n_keys = win // dil
        idx = Wb + jnp.arange(S)[:, None] - jnp.arange(n_keys + 1)[None, :] * dil
        valid = idx >= 0
        idxc = jnp.maximum(idx, 0)
        kg, vg = kc[:, idxc], vc[:, idxc]
        s = jnp.einsum('bshd,bskhd->bhsk', q[:, :, g], kg).astype(jnp.float32) * DSW_SCALE
        p, lse = _masked_softmax(s, valid[None, None])
        outs.append(jnp.einsum('bhsk,bskhd->bshd', p.astype(vg.dtype), vg))
        lses.append(lse.transpose(0, 2, 1))
        keep = min(win, Wb + S)
        new.append(jnp.stack([kc[:, Wb + S - keep:], vc[:, Wb + S - keep:]], axis=2))
    return _combine(outs, lses), tuple(new)


def _layer(x, c, pos, S0, caches, norm1_g, norm2_g, w_ada, b_ada, w_in, b_in, w_alpha2, b_alpha2,
           gla_norm_g, w_proj_a, w_proj_b, w_out, w_up, w_down):
    B, T, D = x.shape
    mod = (jax.nn.silu(c) @ w_ada + b_ada).reshape(B, 6, 1, D)
    sh1, sc1, g1, sh2, sc2, g2 = (mod[:, i] for i in range(6))
    h = _rmsnorm(x, norm1_g) * (1 + sc1) + sh1
    proj = h @ w_in + b_in
    gq, gk, gv, gr, glr, dq, dk, dv, ga, gb = jnp.split(proj, IN_OFFSETS, axis=-1)
    heads = lambda a, n: a.reshape(B, T, GLA_HEADS, n)
    log_a = jax.nn.log_sigmoid((glr @ w_alpha2 + b_alpha2).astype(jnp.float32)) / GLA_TAU
    o_a, S_new = _gla(heads(gq, GLA_DK), heads(gk, GLA_DK), heads(gv, GLA_DV), heads(log_a, GLA_DK), S0)
    o_a = (_rmsnorm(o_a, gla_norm_g).reshape(B, T, GLA_V_W) * jax.nn.silu(gr.astype(jnp.float32))).astype(x.dtype)
    dsw = lambda a: a.reshape(B, T, DSW_N_GROUPS * DSW_HEADS, DSW_HEAD_DIM)
    q = _rope(dsw(dq), pos).reshape(B, T, DSW_N_GROUPS, DSW_HEADS, DSW_HEAD_DIM)
    k = _rope(dsw(dk), pos).reshape(B, T, DSW_N_GROUPS, DSW_HEADS, DSW_HEAD_DIM)
    v = dv.reshape(B, T, DSW_N_GROUPS, DSW_HEADS, DSW_HEAD_DIM)
    if caches is None:
        o_b, new_kv = _dsw_prompt(q, k, v)
    else:
        o_b, new_kv = _dsw_sample(q, k, v, caches)
    o_b = o_b.reshape(B, T, DSW_OUT_W).astype(x.dtype)
    merged = jax.nn.sigmoid(ga) * (o_a @ w_proj_a) + jax.nn.sigmoid(gb) * (o_b @ w_proj_b)
    x = x + g1 * (merged @ w_out)
    h2 = _rmsnorm(x, norm2_g) * (1 + sc2) + sh2
    u1, u2 = jnp.split(h2 @ w_up, 2, axis=-1)
    x = x + g2 * ((jax.nn.silu(u1) * u2) @ w_down)
    return x, S_new, new_kv


def setup_inputs(seed: int = 0) -> dict:
    key = jax.random.key(seed)
    ks = jax.random.split(key, 24)
    nrm = lambda k, shape, scale: jax.random.normal(k, shape, jnp.float32) * scale
    D = D_MODEL
    kv_shape = lambda win: (DEPTH, DEC_BATCH, min(win, PAST_LEN), 2, DSW_HEADS, DSW_HEAD_DIM)
    return {
        "x_prompt": nrm(ks[0], (BATCH, SEQ, D), 1.0),
        "x_sample": nrm(ks[1], (DEC_BATCH, DEC_SEQ, D), 1.0),
        "state_gla": nrm(ks[2], (DEPTH, DEC_BATCH, GLA_HEADS, GLA_DK, GLA_DV), 1.0),
        "cache_kv_w128": nrm(ks[3], kv_shape(DSW_GROUPS[0][0]), 1.0),
        "cache_kv_w512": nrm(ks[4], kv_shape(DSW_GROUPS[1][0]), 1.0),
        "cache_kv_w2048": nrm(ks[5], kv_shape(DSW_GROUPS[2][0]), 1.0),
        "c_prompt": nrm(ks[6], (BATCH, D), 1.0),
        "c_sample": nrm(ks[7], (DEC_BATCH, D), 1.0),
        "norm1_g": 1.0 + nrm(ks[8], (DEPTH, D), 0.05),
        "norm2_g": 1.0 + nrm(ks[9], (DEPTH, D), 0.05),
        "w_ada": nrm(ks[10], (DEPTH, D, 6 * D), 0.5 * D ** -0.5),
        "b_ada": nrm(ks[11], (DEPTH, 6 * D), 0.02),
        "w_in": nrm(ks[12], (DEPTH, D, IN_W), D ** -0.5),
        "b_in": nrm(ks[13], (DEPTH, IN_W), 0.02),
        "w_alpha2": nrm(ks[14], (DEPTH, GLA_RANK, GLA_QK_W), GLA_RANK ** -0.5),
        "b_alpha2": nrm(ks[15], (DEPTH, GLA_QK_W), 0.1),
        "gla_norm_g": 1.0 + nrm(ks[16], (DEPTH, GLA_DV), 0.05),
        "w_proj_a": nrm(ks[17], (DEPTH, GLA_V_W, D), GLA_V_W ** -0.5),
        "w_proj_b": nrm(ks[18], (DEPTH, DSW_OUT_W, D), DSW_OUT_W ** -0.5),
        "w_out": nrm(ks[19], (DEPTH, D, D), D ** -0.5),
        "w_up": nrm(ks[20], (DEPTH, D, 2 * D_FF), D ** -0.5),
        "w_down": nrm(ks[21], (DEPTH, D_FF, D), D_FF ** -0.5),
        "normf_g": 1.0 + nrm(ks[22], (D,), 0.05),
    }


def reference(x_prompt, x_sample, state_gla, cache_kv_w128, cache_kv_w512, cache_kv_w2048, c_prompt, c_sample,
              norm1_g, norm2_g, w_ada, b_ada, w_in, b_in, w_alpha2, b_alpha2, gla_norm_g, w_proj_a, w_proj_b,
              w_out, w_up, w_down, normf_g):
    pos_p = jnp.arange(x_prompt.shape[1], dtype=jnp.float32)
    pos_s = PAST_LEN + jnp.arange(x_sample.shape[1], dtype=jnp.float32)
    S0_p = jnp.zeros((x_prompt.shape[0], GLA_HEADS, GLA_DK, GLA_DV), jnp.float32)
    xp, xs = x_prompt, x_sample
    sp_list, kvp_list, ss_list, kvs_list = [], [], [], []
    for l in range(DEPTH):
        lw = (norm1_g[l], norm2_g[l], w_ada[l], b_ada[l], w_in[l], b_in[l], w_alpha2[l], b_alpha2[l],
              gla_norm_g[l], w_proj_a[l], w_proj_b[l], w_out[l], w_up[l], w_down[l])
        xp, s_p, kv_p = _layer(xp, c_prompt, pos_p, S0_p, None, *lw)
        xs, s_s, kv_s = _layer(xs, c_sample, pos_s, state_gla[l],
                               (cache_kv_w128[l], cache_kv_w512[l], cache_kv_w2048[l]), *lw)
        sp_list.append(s_p)
        kvp_list.append(kv_p)
        ss_list.append(s_s)
        kvs_list.append(kv_s)
    y_prompt = _rmsnorm(xp, normf_g)
    y_sample = _rmsnorm(xs, normf_g)
    state_gla_p = jnp.stack(sp_list).astype(x_prompt.dtype)
    kv128_p = jnp.stack([kv[0] for kv in kvp_list])
    kv512_p = jnp.stack([kv[1] for kv in kvp_list])
    kv2048_p = jnp.stack([kv[2] for kv in kvp_list])
    state_gla_s = jnp.stack(ss_list).astype(state_gla.dtype)
    kv128_s = jnp.stack([kv[0] for kv in kvs_list])
    kv512_s = jnp.stack([kv[1] for kv in kvs_list])
    kv2048_s = jnp.stack([kv[2] for kv in kvs_list])
    return (y_prompt, y_sample, state_gla_p, kv128_p, kv512_p, kv2048_p, state_gla_s, kv128_s, kv512_s, kv2048_s)
```

```cpp
#include <hip/hip_runtime.h>
#include <hip/hip_cooperative_groups.h>
#include <cstdio>
namespace cg = cooperative_groups;
namespace pg8 {
#define PG8_LAS __attribute__((address_space(3)))
typedef unsigned short bf16_t;
typedef short bf16x8 __attribute__((ext_vector_type(8)));
typedef float f32x4 __attribute__((ext_vector_type(4)));
typedef unsigned u32x4 __attribute__((ext_vector_type(4)));
constexpr int BM = 256, BK = 64, HALF = 128, HTB = HALF * BK * 2  , STAGE_BYTES = 8 * HTB, NXCD = 8, WGM = 8;

__host__ __device__ __forceinline__ int lds_byte(int r, int c) { const int st = (r >> 4) * 2 + (c >> 5), rr = r & 15, cc = c & 31, ob = rr * 64 + cc * 2; return st * 1024 + (ob ^ (((ob >> 9) & 1) << 5)); }
__host__ __device__ __forceinline__ void stage_rc(int b, int& R, int& C) { const int st = b / 1024, sb = b % 1024, swz = sb ^ (((sb >> 9) & 1) << 5); R = (st >> 1) * 16 + swz / 64; C = (st & 1) * 32 + (swz % 64) / 2; }
__host__ __device__ __forceinline__ int perm32(int rho) { const int n = rho >> 4, i = rho & 15; return 8 * (i >> 2) + 4 * n + (i & 3); }

struct Unit { int pm, pn; };
struct Gemm { const bf16_t* A; const bf16_t* Bt; int M, N, K; };

struct StaticOrder {
    int nM, nN, nwg, G, c;
    __host__ __device__ void init(int M, int N, int G_, int c_) { nM = M / BM; nN = N / BM; nwg = nM * nN; G = G_; c = c_; }
    __host__ __device__ bool next(int i, Unit& u) const {
        const long L = (long)i * G + c; if (L >= nwg) return false;
        int wgid = (int)L; { const int q = nwg / NXCD, r = nwg % NXCD, xcd = wgid % NXCD, off = wgid / NXCD; wgid = (xcd < r ? xcd * (q + 1) : r * (q + 1) + (xcd - r) * q) + off; }
        const int nig = WGM * nN, gid = wgid / nig, fm = gid * WGM, gsz = (nM - fm) < WGM ? (nM - fm) : WGM;
        u.pm = fm + ((wgid % nig) % gsz); u.pn = (wgid % nig) / gsz; return true;
    }
    __device__ __forceinline__ void a_ready(const Unit&) const {}
    __device__ __forceinline__ void done(const Unit&) const {}
};
__device__ __forceinline__ unsigned cvt_pk_bf16(float lo, float hi) { unsigned r; asm volatile("v_cvt_pk_bf16_f32 %0, %1, %2" : "=v"(r) : "v"(lo), "v"(hi)); return r; }
typedef float f32x2 __attribute__((ext_vector_type(2)));
template <class Epi, class Sched, bool STAMP = false>
__device__ __forceinline__ void gemm_phase(PG8_LAS unsigned char* lds, const Gemm g, const Sched& S, const Epi& E, unsigned long long* stamps) {
    const int tid = threadIdx.x, wid = __builtin_amdgcn_readfirstlane(tid >> 6), lane = tid & 63, wr = wid >> 2, wc = wid & 3, fr = lane & 15, fq = lane >> 4;
    const int K = g.K, nt = K / BK;
    int ts_lo = 0, ts_hi = 0, nts = 0; const unsigned long long rt_entry = STAMP ? (unsigned long long)wall_clock64() : 0ull;
#define PG8_STAMP() do { if (STAMP && wid == 0 && nts < 64) { const unsigned long long _c = (unsigned long long)clock64(); \
        ts_lo = (lane == nts) ? (int)(unsigned)_c : ts_lo; ts_hi = (lane == nts) ? (int)(unsigned)(_c >> 32) : ts_hi; ++nts; } } while (0)
    PG8_STAMP();
    unsigned voffA[2], voffB[2];
#pragma unroll
    for (int i = 0; i < 2; ++i) { int R, C; stage_rc(tid * 16 + i * 8192, R, C); const int Rb = Epi::PERM ? ((R & ~31) + perm32(R & 31)) : R;
        voffA[i] = (unsigned)(R * K + C) * 2u; voffB[i] = (unsigned)(Rb * K + C) * 2u; }
    const size_t kstep = (size_t)(BK * 2);
    const size_t hstep = (size_t)HALF * K * 2;
    const size_t tstep = 2 * hstep;
    const unsigned ldsw = (unsigned)wid * 1024u;
    const int aoff = lds_byte(wr * 64 + fr, fq * 8), boff = lds_byte(wc * 32 + fr, fq * 8);
#define PG8_SA(b, h) (((b) * 2 + (h)) * HTB)
#define PG8_SB(b, h) ((4 + (b) * 2 + (h)) * HTB)
#define PG8_STAGE(bufoff, gbase, voff) do { _Pragma("unroll") for (int _i = 0; _i < 2; ++_i) \
        __builtin_amdgcn_global_load_lds((const unsigned*)((const char*)(gbase) + (voff)[_i]), (PG8_LAS unsigned*)(lds + (bufoff) + ldsw + _i * 8192), 16, 0, 0); } while (0)
#define PG8_LDA(dst, b, h) do { _Pragma("unroll") for (int m = 0; m < 4; ++m) _Pragma("unroll") for (int k = 0; k < 2; ++k) dst[m][k] = *(const PG8_LAS bf16x8*)(lds + PG8_SA(b, h) + aoff + m * 2048 + k * 1024); } while (0)
#define PG8_LDB(dst, b, h) do { _Pragma("unroll") for (int n = 0; n < 2; ++n) _Pragma("unroll") for (int k = 0; k < 2; ++k) dst[n][k] = *(const PG8_LAS bf16x8*)(lds + PG8_SB(b, h) + boff + n * 2048 + k * 1024); } while (0)
#define PG8_MMA(ai, bj, At, Bt) do { __builtin_amdgcn_s_setprio(1); _Pragma("unroll") for (int m = 0; m < 4; ++m) _Pragma("unroll") for (int n = 0; n < 2; ++n) _Pragma("unroll") for (int k = 0; k < 2; ++k) \
        acc[ai][bj][m][n] = __builtin_amdgcn_mfma_f32_16x16x32_bf16(Bt[n][k], At[m][k], acc[ai][bj][m][n], 0, 0, 0); __builtin_amdgcn_s_setprio(0); } while (0)
#define PG8_WAIT_V(n) asm volatile("s_waitcnt vmcnt(" #n ")" ::: "memory")
#define PG8_WAIT_L(n) asm volatile("s_waitcnt lgkmcnt(" #n ")" ::: "memory")
#define PG8_BAR __builtin_amdgcn_s_barrier()
#define PG8_SCHED __builtin_amdgcn_sched_barrier(0)
    Unit cur, nxt; int ui = 0;
    if (!S.next(0, cur)) return;
    f32x4 acc[2][2][4][2];
#pragma unroll
    for (int a = 0; a < 2; ++a)
#pragma unroll
        for (int b = 0; b < 2; ++b)
#pragma unroll
            for (int m = 0; m < 4; ++m)
#pragma unroll
                for (int n = 0; n < 2; ++n) acc[a][b][m][n] = (f32x4){0.f, 0.f, 0.f, 0.f};
    bf16x8 At[4][2], B0[2][2], B1[2][2];
    const char* cA = (const char*)g.A + (size_t)cur.pm * tstep; const char* cB = (const char*)g.Bt + (size_t)cur.pn * tstep;
    S.a_ready(cur);
    PG8_STAGE(PG8_SB(0, 0), cB, voffB); PG8_STAGE(PG8_SA(0, 0), cA, voffA); PG8_STAGE(PG8_SB(0, 1), cB + hstep, voffB); PG8_STAGE(PG8_SA(0, 1), cA + hstep, voffA);
    if (wr == 1) PG8_BAR;
    PG8_WAIT_V(4); PG8_BAR;
    PG8_STAGE(PG8_SB(1, 0), cB + kstep, voffB); PG8_STAGE(PG8_SA(1, 0), cA + kstep, voffA); PG8_STAGE(PG8_SB(1, 1), cB + hstep + kstep, voffB);
    PG8_WAIT_V(6); PG8_BAR;
    PG8_STAMP();
    for (;;) {
        const bool has_next = S.next(ui + 1, nxt);
        const char* nA = has_next ? (const char*)g.A + (size_t)nxt.pm * tstep : cA; const char* nB = has_next ? (const char*)g.Bt + (size_t)nxt.pn * tstep : cB;
        for (int t = 0; t < nt; t += 2) {
            const bool last = (t == nt - 2);
            const char* a1 = cA + (size_t)(t + 1) * kstep;
            const char* a2 = last ? nA : cA + (size_t)(t + 2) * kstep; const char* b2 = last ? nB : cB + (size_t)(t + 2) * kstep;
            const char* a3 = a2 + kstep; const char* b3 = b2 + kstep;
            if (last && has_next) S.a_ready(nxt);
            PG8_LDB(B0, 0, 0); PG8_SCHED; PG8_LDA(At, 0, 0); PG8_STAGE(PG8_SA(1, 1), a1 + hstep, voffA);
            PG8_WAIT_L(8); PG8_BAR; PG8_WAIT_L(0); PG8_MMA(0, 0, At, B0); PG8_BAR; PG8_SCHED;
            PG8_LDB(B1, 0, 1); PG8_STAGE(PG8_SB(0, 0), b2, voffB);
            PG8_BAR; PG8_WAIT_L(0); PG8_MMA(0, 1, At, B1); PG8_BAR;
            PG8_LDA(At, 0, 1); PG8_STAGE(PG8_SA(0, 0), a2, voffA);
            PG8_BAR; PG8_WAIT_L(0); PG8_MMA(1, 0, At, B0); PG8_BAR; PG8_SCHED;
            PG8_STAGE(PG8_SB(0, 1), b2 + hstep, voffB);
            PG8_WAIT_V(6); PG8_BAR; PG8_MMA(1, 1, At, B1); PG8_BAR;
            PG8_LDB(B0, 1, 0); PG8_SCHED; PG8_LDA(At, 1, 0); PG8_STAGE(PG8_SA(0, 1), a2 + hstep, voffA);
            PG8_WAIT_L(8); PG8_BAR; PG8_WAIT_L(0); PG8_MMA(0, 0, At, B0); PG8_BAR; PG8_SCHED;
            PG8_LDB(B1, 1, 1); PG8_STAGE(PG8_SB(1, 0), b3, voffB);
            PG8_BAR; PG8_WAIT_L(0); PG8_MMA(0, 1, At, B1); PG8_BAR;
            PG8_LDA(At, 1, 1); PG8_STAGE(PG8_SA(1, 0), a3, voffA);
            PG8_BAR; PG8_WAIT_L(0); PG8_MMA(1, 0, At, B0); PG8_BAR; PG8_SCHED;
            PG8_STAGE(PG8_SB(1, 1), b3 + hstep, voffB);
            PG8_WAIT_V(6); PG8_BAR; PG8_MMA(1, 1, At, B1); PG8_BAR;
        }
        PG8_STAMP();
        if constexpr (!Epi::AFTER_DRAIN) { E(acc, cur, wr, wc, fr, fq); S.done(cur); }
        PG8_STAMP();
        if (!has_next) break;
#pragma unroll
        for (int a = 0; a < 2; ++a)
#pragma unroll
            for (int b = 0; b < 2; ++b)
#pragma unroll
                for (int m = 0; m < 4; ++m)
#pragma unroll
                    for (int n = 0; n < 2; ++n) acc[a][b][m][n] = (f32x4){0.f, 0.f, 0.f, 0.f};
        cur = nxt; cA = nA; cB = nB; ++ui;
    }
    PG8_WAIT_V(0);
    if (wr == 0) PG8_BAR;
    PG8_BAR;
    if constexpr (Epi::AFTER_DRAIN) { E.fused(acc, cur, wr, wc, fr, fq, lds, wid, lane); S.done(cur); }
    PG8_STAMP();
    if (STAMP && wid == 0) { stamps[lane] = lane < nts ? (((unsigned long long)(unsigned)ts_hi << 32) | (unsigned)ts_lo) : 0ull;
        if (lane == 62) stamps[62] = rt_entry; if (lane == 63) stamps[63] = (unsigned long long)wall_clock64(); }
#undef PG8_STAMP
#undef PG8_SA
#undef PG8_SB
#undef PG8_STAGE
#undef PG8_LDA
#undef PG8_LDB
#undef PG8_MMA
#undef PG8_WAIT_V
#undef PG8_WAIT_L
#undef PG8_BAR
#undef PG8_SCHED
}
}

#ifndef PHMASK
#define PHMASK 0x7FFFF
#endif
namespace mk {
using pg8::bf16_t; using pg8::bf16x8; using pg8::f32x4; using pg8::u32x4;
typedef unsigned u32x2 __attribute__((ext_vector_type(2)));
typedef float f32x2 __attribute__((ext_vector_type(2)));

constexpr int D = 1024, T = 4096, NB = 4, TP = NB * T, DBATCH = 128, SS = 4, TS = DBATCH * SS, M = TP + TS;
constexpr int NIN = 7680, NADA = 6144, NUP = 5632, DFF = 2816;
constexpr int C_GQ = 0, C_GK = 512, C_GV = 1024, C_GR = 2048, C_DQ = 3072, C_DK = 3840, C_DV = 4608, C_GA = 5376, C_GB = 6400, C_GLR = 7424, C_END = 7440;
constexpr int LDS_BYTES = 131072;
constexpr float EPS = 1e-6f;

constexpr size_t al(size_t x) { return (x + 255) & ~(size_t)255; }
constexpr size_t WS_WADA = 0;
constexpr size_t WS_WIN = WS_WADA + al((size_t)NADA * D * 2);
constexpr size_t WS_WPA = WS_WIN + al((size_t)NIN * D * 2);
constexpr size_t WS_WPB = WS_WPA + al((size_t)D * D * 2);
constexpr size_t WS_WOUT = WS_WPB + al((size_t)D * 256 * 2);
constexpr size_t WS_WUP = WS_WOUT + al((size_t)D * D * 2);
constexpr size_t WS_WDN = WS_WUP + al((size_t)NUP * D * 2);
constexpr size_t WS_BIN = WS_WDN + al((size_t)D * DFF * 2);
constexpr size_t WS_SC = WS_BIN + al((size_t)NIN * 4);
constexpr size_t WS_ROPE = WS_SC + al((size_t)256 * D * 2);
constexpr size_t WS_MOD = WS_ROPE + al((size_t)4100 * 32 * 8);
constexpr size_t WS_H = WS_MOD + al((size_t)256 * NADA * 4);
constexpr size_t WS_PROJ = WS_H + al((size_t)M * D * 2);
constexpr size_t WS_GLR = WS_PROJ + al((size_t)M * NIN * 2);
constexpr size_t WS_U = WS_GLR + al((size_t)M * 16 * 4);
constexpr size_t WS_DEC = WS_U + al((size_t)1024 * 32768 * 4);
constexpr size_t WS_SST = WS_DEC + al((size_t)1024 * 128 * 4);
constexpr size_t WS_OG = WS_SST + al((size_t)1024 * 32768 * 2);
constexpr size_t WS_LSE = WS_OG + al((size_t)TP * 768 * 2);
constexpr size_t WS_OA = WS_LSE + al((size_t)TP * 12 * 4);
constexpr size_t WS_OB = WS_OA + al((size_t)M * D * 2);
constexpr size_t WS_MG = WS_OB + al((size_t)M * 256 * 2);
constexpr size_t WS_X1 = WS_MG + al((size_t)M * D * 2);
constexpr size_t WS_ACT = WS_X1 + al((size_t)M * D * 4);
constexpr size_t WS_END = WS_ACT + al((size_t)M * DFF * 2);

constexpr size_t O_Y = 0;
constexpr size_t O_SGP = O_Y + (size_t)M * D;
constexpr size_t O_KVP0 = O_SGP + (size_t)4 * 4 * 128 * 256;
constexpr size_t O_KVP1 = O_KVP0 + (size_t)4 * 128 * 512;
constexpr size_t O_KVP2 = O_KVP1 + (size_t)4 * 512 * 512;
constexpr size_t O_SGS = O_KVP2 + (size_t)4 * 2048 * 512;
constexpr size_t O_KVS0 = O_SGS + (size_t)128 * 4 * 128 * 256;
constexpr size_t O_KVS1 = O_KVS0 + (size_t)128 * 128 * 512;
constexpr size_t O_KVS2 = O_KVS1 + (size_t)128 * 512 * 512;
constexpr size_t O_END = O_KVS2 + (size_t)128 * 2048 * 512;

struct Params { const float* in[23]; float* out; unsigned char* ws; };

__device__ __forceinline__ float bf2f(unsigned short b) { return __uint_as_float(((unsigned)b) << 16); }
__device__ __forceinline__ unsigned short f2bf(float f) { unsigned u = __float_as_uint(f); u += 0x7FFFu + ((u >> 16) & 1u); return (unsigned short)(u >> 16); }
__device__ __forceinline__ unsigned pk2(float lo, float hi) { return (unsigned)f2bf(lo) | ((unsigned)f2bf(hi) << 16); }
__device__ __forceinline__ float silu_f(float x) { return x / (1.f + __expf(-x)); }
__device__ __forceinline__ float sigm_f(float x) { return 1.f / (1.f + __expf(-x)); }
__device__ __forceinline__ int brow_of(int row) { return row < TP ? (row >> 12) : 4 + ((row - TP) >> 2); }
__device__ __forceinline__ size_t okvp(int g) { return g == 0 ? O_KVP0 : (g == 1 ? O_KVP1 : O_KVP2); }
__device__ __forceinline__ size_t okvs(int g) { return g == 0 ? O_KVS0 : (g == 1 ? O_KVS1 : O_KVS2); }
__device__ __forceinline__ f32x4 mfma16(bf16x8 a, bf16x8 b, f32x4 c) { return __builtin_amdgcn_mfma_f32_16x16x32_bf16(a, b, c, 0, 0, 0); }
__device__ __forceinline__ u32x4 pack8(f32x4 a, f32x4 b) { u32x4 w; w.x = pk2(a[0], a[1]); w.y = pk2(a[2], a[3]); w.z = pk2(b[0], b[1]); w.w = pk2(b[2], b[3]); return w; }
__device__ __forceinline__ void unpack8(u32x4 w, f32x4& a, f32x4& b) {
    a[0] = __uint_as_float(w.x << 16); a[1] = __uint_as_float(w.x & 0xffff0000u); a[2] = __uint_as_float(w.y << 16); a[3] = __uint_as_float(w.y & 0xffff0000u);
    b[0] = __uint_as_float(w.z << 16); b[1] = __uint_as_float(w.z & 0xffff0000u); b[2] = __uint_as_float(w.w << 16); b[3] = __uint_as_float(w.w & 0xffff0000u); }

__device__ __forceinline__ int map_in(int n) {
    if (n < 3072) return n;
    if (n < C_DV) { const int isK = n >= C_DK; const int j = n - (isK ? C_DK : C_DQ); const int head = j >> 6, p = j & 63; return (isK ? 3856 : 3088) + head * 64 + (p >> 1) + 32 * (p & 1); }
    if (n < C_GA) return 4624 + (n - C_DV);
    if (n < C_GB) return 5392 + (n - C_GA);
    if (n < C_GLR) return 6416 + (n - C_GB);
    if (n < C_END) return 3072 + (n - C_GLR);
    return -1;
}
__device__ __forceinline__ int map_up(int n) { const int q = n >> 3, e = n & 7; return e < 4 ? 4 * q + e : DFF + 4 * q + e - 4; }

__device__ __forceinline__ void tr_tile(const float* __restrict__ W, int ldw, bf16_t* __restrict__ Bt, int K, int n0, int k0, int mapid, unsigned char* smem) {
    unsigned short* t = (unsigned short*)smem;
    const int tid = threadIdx.x, lane = tid & 63, w8 = tid >> 6;
    const int n = n0 + lane; const int src = mapid == 0 ? n : (mapid == 1 ? map_in(n) : map_up(n));
#pragma unroll
    for (int j = 0; j < 8; ++j) { const int kk = w8 + 8 * j; const float v = src >= 0 ? W[(size_t)(k0 + kk) * ldw + src] : 0.f; t[kk * 66 + lane] = f2bf(v); }
    __syncthreads();
#pragma unroll
    for (int j = 0; j < 8; ++j) { const int nn = w8 + 8 * j; Bt[(size_t)(n0 + nn) * K + k0 + lane] = t[lane * 66 + nn]; }
    __syncthreads();
}

__device__ void phase_prep(const Params& p, unsigned char* smem) {
    const int G = gridDim.x;
    for (int ti = blockIdx.x; ti < 6144; ti += G) {
        const float* W; int ldw, K, kT, mapid, base; bf16_t* Bt;
        if (ti < 1536)      { W = p.in[10]; ldw = NADA; K = D;   kT = 16; mapid = 0; base = 0;    Bt = (bf16_t*)(p.ws + WS_WADA); }
        else if (ti < 3456) { W = p.in[12]; ldw = 7440; K = D;   kT = 16; mapid = 1; base = 1536; Bt = (bf16_t*)(p.ws + WS_WIN); }
        else if (ti < 3712) { W = p.in[17]; ldw = D;    K = D;   kT = 16; mapid = 0; base = 3456; Bt = (bf16_t*)(p.ws + WS_WPA); }
        else if (ti < 3776) { W = p.in[18]; ldw = D;    K = 256; kT = 4;  mapid = 0; base = 3712; Bt = (bf16_t*)(p.ws + WS_WPB); }
        else if (ti < 4032) { W = p.in[19]; ldw = D;    K = D;   kT = 16; mapid = 0; base = 3776; Bt = (bf16_t*)(p.ws + WS_WOUT); }
        else if (ti < 5440) { W = p.in[20]; ldw = NUP;  K = D;   kT = 16; mapid = 2; base = 4032; Bt = (bf16_t*)(p.ws + WS_WUP); }
        else                { W = p.in[21]; ldw = D;    K = DFF; kT = 44; mapid = 0; base = 5440; Bt = (bf16_t*)(p.ws + WS_WDN); }
        const int li = ti - base, nt = li / kT, kt = li % kT;
        tr_tile(W, ldw, Bt, K, nt * 64, kt * 64, mapid, smem);
    }
    const int gtid = blockIdx.x * 512 + threadIdx.x, gsz = G * 512;
    float* bin = (float*)(p.ws + WS_BIN);
    for (int n = gtid; n < NIN; n += gsz) { const int m = map_in(n); bin[n] = m >= 0 ? p.in[13][m] : 0.f; }
    bf16_t* sc = (bf16_t*)(p.ws + WS_SC);
    for (int i = gtid; i < 256 * D; i += gsz) { const int r = i >> 10, c = i & 1023; float v = 0.f;
        if (r < 4) v = p.in[6][r * D + c]; else if (r < 132) v = p.in[7][(r - 4) * D + c];
        sc[i] = f2bf(silu_f(v)); }
    f32x2* rope = (f32x2*)(p.ws + WS_ROPE);
    for (int i = gtid; i < 4100 * 32; i += gsz) { const int pi = i >> 5, fi = i & 31; const int pos = pi < 4096 ? pi : 8192 + (pi - 4096);
        double inv = 1.0; for (int q = 0; q < fi; ++q) inv *= 0.74989420933245582730;
        const float invf = (float)inv; const float ang = (float)pos * invf;
        const double rev = (double)ang * 0.15915494309189533577; const float fr = (float)(rev - __builtin_rint(rev));
        f32x2 cs; cs.x = __builtin_amdgcn_cosf(fr); cs.y = __builtin_amdgcn_sinf(fr); rope[i] = cs; }
}

template <class F> struct EpiF {
    static constexpr bool PERM = true, AFTER_DRAIN = false;
    F f;
    __device__ __forceinline__ void operator()(const f32x4 (&acc)[2][2][4][2], const pg8::Unit& u, int wr, int wc, int fr, int fq) const {
#pragma unroll
        for (int ai = 0; ai < 2; ++ai)
#pragma unroll
            for (int m = 0; m < 4; ++m) {
                const int row = u.pm * 256 + ai * 128 + wr * 64 + m * 16 + fr;
#pragma unroll
                for (int bj = 0; bj < 2; ++bj) { const int col = u.pn * 256 + bj * 128 + wc * 32 + 8 * fq; f(row, col, acc[ai][bj][m][0], acc[ai][bj][m][1]); asm volatile("" ::: "memory"); }
            }
    }
};

struct FMod { float* mod; const float* bias;
    __device__ __forceinline__ void operator()(int row, int col, f32x4 a, f32x4 b) const {
        a += *(const f32x4*)(bias + col); b += *(const f32x4*)(bias + col + 4);
        float* d = mod + (size_t)row * NADA + col; *(f32x4*)d = a; *(f32x4*)(d + 4) = b; } };

struct FIn { bf16_t* proj; float* glr; const float* bias; const f32x2* rope; float* out;
    __device__ __forceinline__ void kvout(int row, int g, int hh, int kv, int f, f32x4 v) const {
        const int W = 128 << (2 * g);
        if (row < TP) { const int t = row & 4095, b = row >> 12; if (t >= T - W) { float* d = out + okvp(g) + ((size_t)(b * W + t - (T - W)) * 2 + kv) * 256 + hh * 64 + f; *(f32x4*)d = v; } }
        else { const int r = row - TP, db = r >> 2, s = r & 3; float* d = out + okvs(g) + ((size_t)(db * W + W - 4 + s) * 2 + kv) * 256 + hh * 64 + f; *(f32x4*)d = v; }
    }
    __device__ __forceinline__ void operator()(int row, int col, f32x4 a, f32x4 b) const {
        if (col >= C_END) return;
        a += *(const f32x4*)(bias + col); b += *(const f32x4*)(bias + col + 4);
        if (col >= C_GLR) { float* d = glr + (size_t)row * 16 + (col - C_GLR); *(f32x4*)d = a; *(f32x4*)(d + 4) = b; return; }
        if (col >= C_GR && col < C_DQ) {
#pragma unroll
            for (int j = 0; j < 4; ++j) { a[j] = silu_f(a[j]); b[j] = silu_f(b[j]); }
        } else if (col >= C_GA) {
#pragma unroll
            for (int j = 0; j < 4; ++j) { a[j] = sigm_f(a[j]); b[j] = sigm_f(b[j]); }
        } else if (col >= C_DQ && col < C_DV) {
            const int isK = col >= C_DK; const int j = col - (isK ? C_DK : C_DQ); const int head = j >> 6, i0 = (j & 63) >> 1;
            const int pi = row < TP ? (row & 4095) : 4096 + ((row - TP) & 3);
            const f32x4 cs0 = *(const f32x4*)(rope + pi * 32 + i0), cs1 = *(const f32x4*)(rope + pi * 32 + i0 + 2);
            f32x4 ra, rb;
            ra[0] = a[0] * cs0[0] - a[1] * cs0[1]; ra[1] = a[1] * cs0[0] + a[0] * cs0[1];
            ra[2] = a[2] * cs0[2] - a[3] * cs0[3]; ra[3] = a[3] * cs0[2] + a[2] * cs0[3];
            rb[0] = b[0] * cs1[0] - b[1] * cs1[1]; rb[1] = b[1] * cs1[0] + b[0] * cs1[1];
            rb[2] = b[2] * cs1[2] - b[3] * cs1[3]; rb[3] = b[3] * cs1[2] + b[2] * cs1[3];
            a = ra; b = rb;
            if (isK) { f32x4 x1, x2; x1[0] = a[0]; x1[1] = a[2]; x1[2] = b[0]; x1[3] = b[2]; x2[0] = a[1]; x2[1] = a[3]; x2[2] = b[1]; x2[3] = b[3];
                kvout(row, head >> 2, head & 3, 0, i0, x1); kvout(row, head >> 2, head & 3, 0, 32 + i0, x2); }
        } else if (col >= C_DV && col < C_GA) {
            const int j = col - C_DV, head = j >> 6, f = j & 63;
            kvout(row, head >> 2, head & 3, 1, f, a); kvout(row, head >> 2, head & 3, 1, f + 4, b);
        }
        *(u32x4*)(proj + (size_t)row * NIN + col) = pack8(a, b);
    } };

struct FPa { bf16_t* mg; const bf16_t* proj;
    __device__ __forceinline__ void operator()(int row, int col, f32x4 a, f32x4 b) const {
        f32x4 g0, g1; unpack8(*(const u32x4*)(proj + (size_t)row * NIN + C_GA + col), g0, g1);
        *(u32x4*)(mg + (size_t)row * D + col) = pack8(a * g0, b * g1); } };
struct FPb { bf16_t* mg; const bf16_t* proj;
    __device__ __forceinline__ void operator()(int row, int col, f32x4 a, f32x4 b) const {
        f32x4 g0, g1, m0, m1; unpack8(*(const u32x4*)(proj + (size_t)row * NIN + C_GB + col), g0, g1);
        unpack8(*(const u32x4*)(mg + (size_t)row * D + col), m0, m1);
        *(u32x4*)(mg + (size_t)row * D + col) = pack8(m0 + a * g0, m1 + b * g1); } };
struct FOut { float* x1; const float* xp; const float* xs; const float* mod;
    __device__ __forceinline__ void operator()(int row, int col, f32x4 a, f32x4 b) const {
        const float* xr = row < TP ? xp + (size_t)row * D + col : xs + (size_t)(row - TP) * D + col;
        const float* g = mod + (size_t)brow_of(row) * NADA + 2 * D + col;
        float* d = x1 + (size_t)row * D + col;
        *(f32x4*)d = *(const f32x4*)xr + *(const f32x4*)g * a; *(f32x4*)(d + 4) = *(const f32x4*)(xr + 4) + *(const f32x4*)(g + 4) * b; } };
struct FUp { bf16_t* act;
    __device__ __forceinline__ void operator()(int row, int col, f32x4 a, f32x4 b) const {
        u32x2 w; w.x = pk2(silu_f(a[0]) * b[0], silu_f(a[1]) * b[1]); w.y = pk2(silu_f(a[2]) * b[2], silu_f(a[3]) * b[3]);
        *(u32x2*)(act + (size_t)row * DFF + (col >> 1)) = w; } };
struct FDown { float* x1; const float* mod;
    __device__ __forceinline__ void operator()(int row, int col, f32x4 a, f32x4 b) const {
        const float* g = mod + (size_t)brow_of(row) * NADA + 5 * D + col;
        float* d = x1 + (size_t)row * D + col;
        *(f32x4*)d = *(const f32x4*)d + *(const f32x4*)g * a; *(f32x4*)(d + 4) = *(const f32x4*)(d + 4) + *(const f32x4*)(g + 4) * b; } };

template <class F> __device__ __forceinline__ void run_gemm(unsigned char* smem, const bf16_t* A, const bf16_t* Bt, int Mm, int Nn, int Kk, const F& f) {
    asm volatile("" : "+s"(Kk));
    pg8::Gemm g{A, Bt, Mm, Nn, Kk}; pg8::StaticOrder S; S.init(Mm, Nn, (int)gridDim.x, (int)blockIdx.x);
    EpiF<F> E{f};
    pg8::gemm_phase<EpiF<F>, pg8::StaticOrder, false>((PG8_LAS unsigned char*)smem, g, S, E, nullptr);
}

__device__ void phase_norm(const float* xa, const float* xb, const float* gain, const float* mod, int sh_i, int sc_i, bf16_t* ob, float* of, int mode) {
    const int lane = threadIdx.x & 63, gw = blockIdx.x * 8 + (threadIdx.x >> 6), nw = gridDim.x * 8;
    for (int row = gw; row < M; row += nw) {
        const float* xr = row < TP ? xa + (size_t)row * D : xb + (size_t)(row - TP) * D;
        f32x4 v[4]; float ss = 0.f;
#pragma unroll
        for (int j = 0; j < 4; ++j) { v[j] = *(const f32x4*)(xr + j * 256 + lane * 4); ss += v[j][0] * v[j][0] + v[j][1] * v[j][1] + v[j][2] * v[j][2] + v[j][3] * v[j][3]; }
#pragma unroll
        for (int o = 32; o >= 1; o >>= 1) ss += __shfl_xor(ss, o);
        const float rstd = rsqrtf(ss * (1.f / D) + EPS);
        const float* mr = mod + (size_t)brow_of(row) * NADA;
#pragma unroll
        for (int j = 0; j < 4; ++j) { const int c = j * 256 + lane * 4; f32x4 y = v[j] * rstd * *(const f32x4*)(gain + c);
            if (mode == 0) { y = y * (*(const f32x4*)(mr + sc_i * D + c) + 1.f) + *(const f32x4*)(mr + sh_i * D + c);
                u32x2 w; w.x = pk2(y[0], y[1]); w.y = pk2(y[2], y[3]); *(u32x2*)(ob + (size_t)row * D + c) = w; }
            else *(f32x4*)(of + (size_t)row * D + c) = y; }
    }
}

__device__ __forceinline__ void gla_front(const Params& p, int row0, int h, float* LA) {
    const int tid = threadIdx.x; const float* glr = (const float*)(p.ws + WS_GLR);
    const float* wa = p.in[14]; const int ch = tid & 127, tg = tid >> 7;
    float w[16];
#pragma unroll
    for (int r = 0; r < 16; ++r) w[r] = wa[r * 512 + h * 128 + ch];
    const float bb = p.in[15][h * 128 + ch];
    for (int i = 0; i < 16; ++i) { const int tok = tg * 16 + i; const float* g = glr + (size_t)(row0 + tok) * 16; float z = bb;
#pragma unroll
        for (int r4 = 0; r4 < 4; ++r4) { const f32x4 g4 = *(const f32x4*)(g + r4 * 4); z += g4[0] * w[r4 * 4] + g4[1] * w[r4 * 4 + 1] + g4[2] * w[r4 * 4 + 2] + g4[3] * w[r4 * 4 + 3]; }
        const float ls = fminf(z, 0.f) - __logf(1.f + __expf(-fabsf(z)));
        LA[tok * 132 + ch] = ls * (1.f / 16.f); }
    __syncthreads();
    if (tid < 128) { float s = 0.f; for (int t = 0; t < 64; ++t) { s += LA[t * 132 + tid]; LA[t * 132 + tid] = s; } }
    __syncthreads();
}
__device__ __forceinline__ void gla_load_vt(const bf16_t* proj, int row0, int h, unsigned short* VT) {
    const int tid = threadIdx.x;
#pragma unroll
    for (int it = 0; it < 4; ++it) { const int idx = tid + it * 512, tok = idx & 63, vg = idx >> 6;
        const bf16x8 vv = *(const bf16x8*)(proj + (size_t)(row0 + tok) * NIN + C_GV + h * 256 + vg * 8);
#pragma unroll
        for (int e = 0; e < 8; ++e) VT[(vg * 8 + e) * 72 + tok] = (unsigned short)vv[e]; }
}

__device__ void gla_passA(const Params& p, unsigned char* smem, int item) {
    const int tid = threadIdx.x, lane = tid & 63, wid = tid >> 6, l15 = lane & 15, quad = lane >> 4;
    const int bh = item >> 6, n = item & 63, b = bh >> 2, h = bh & 3, row0 = b * T + n * 64;
    float* LA = (float*)smem; unsigned short* KLT = (unsigned short*)(smem + 33792); unsigned short* VT = (unsigned short*)(smem + 33792 + 18432);
    const bf16_t* proj = (const bf16_t*)(p.ws + WS_PROJ);
    gla_front(p, row0, h, LA);
#pragma unroll
    for (int it = 0; it < 2; ++it) { const int idx = tid + it * 512, tok = idx & 63, cgp = idx >> 6;
        const bf16x8 kv = *(const bf16x8*)(proj + (size_t)(row0 + tok) * NIN + C_GK + h * 128 + cgp * 8);
#pragma unroll
        for (int e = 0; e < 8; ++e) { const int ch = cgp * 8 + e; KLT[ch * 72 + tok] = f2bf(bf2f((unsigned short)kv[e]) * __expf(LA[63 * 132 + ch] - LA[tok * 132 + ch])); } }
    gla_load_vt(proj, row0, h, VT);
    if (tid < 128) ((float*)(p.ws + WS_DEC))[item * 128 + tid] = __expf(LA[63 * 132 + tid]);
    __syncthreads();
    f32x4 acc[2][8];
#pragma unroll
    for (int i = 0; i < 2; ++i)
#pragma unroll
        for (int j = 0; j < 8; ++j) acc[i][j] = (f32x4){0.f, 0.f, 0.f, 0.f};
#pragma unroll
    for (int ks = 0; ks < 2; ++ks) { bf16x8 a[2];
#pragma unroll
        for (int mt = 0; mt < 2; ++mt) a[mt] = *(const bf16x8*)(VT + (32 * wid + 16 * mt + l15) * 72 + ks * 32 + quad * 8);
#pragma unroll
        for (int nt = 0; nt < 8; ++nt) { const bf16x8 bb = *(const bf16x8*)(KLT + (16 * nt + l15) * 72 + ks * 32 + quad * 8);
#pragma unroll
            for (int mt = 0; mt < 2; ++mt) acc[mt][nt] = mfma16(a[mt], bb, acc[mt][nt]); } }
    float* U = (float*)(p.ws + WS_U) + (size_t)item * 32768;
#pragma unroll
    for (int mt = 0; mt < 2; ++mt)
#pragma unroll
        for (int nt = 0; nt < 8; ++nt)
#pragma unroll
            for (int e = 0; e < 4; ++e) U[(32 * wid + 16 * mt + quad * 4 + e) * 128 + 16 * nt + l15] = acc[mt][nt][e];
    __syncthreads();
}

__device__ void gla_passC(const Params& p, unsigned char* smem, int item) {
    const int tid = threadIdx.x, lane = tid & 63, wid = tid >> 6, l15 = lane & 15, quad = lane >> 4;
    const int bh = item >> 6, n = item & 63, b = bh >> 2, h = bh & 3, row0 = b * T + n * 64;
    float* LA = (float*)smem; unsigned short* QG = (unsigned short*)(smem + 33792); unsigned short* KD = (unsigned short*)(smem + 51200);
    unsigned short* VT = (unsigned short*)(smem + 68608); unsigned short* ATT = (unsigned short*)(smem + 105472); float* RED = (float*)(smem + 114688);
    const bf16_t* proj = (const bf16_t*)(p.ws + WS_PROJ);
    gla_front(p, row0, h, LA);
#pragma unroll
    for (int it = 0; it < 2; ++it) { const int idx = tid + it * 512, cgp = idx & 15, tok = idx >> 4;
        const bf16x8 q8 = *(const bf16x8*)(proj + (size_t)(row0 + tok) * NIN + C_GQ + h * 128 + cgp * 8);
        const bf16x8 k8 = *(const bf16x8*)(proj + (size_t)(row0 + tok) * NIN + C_GK + h * 128 + cgp * 8);
        f32x4 qa, qb, ka, kb;
#pragma unroll
        for (int e = 0; e < 8; ++e) { const float bc = LA[tok * 132 + cgp * 8 + e];
            const float qf = bf2f((unsigned short)q8[e]) * 0.08838834764831845f * __expf(bc), kf = bf2f((unsigned short)k8[e]) * __expf(-bc);
            if (e < 4) { qa[e] = qf; ka[e] = kf; } else { qb[e - 4] = qf; kb[e - 4] = kf; } }
        *(u32x4*)(QG + tok * 136 + cgp * 8) = pack8(qa, qb); *(u32x4*)(KD + tok * 136 + cgp * 8) = pack8(ka, kb); }
    gla_load_vt(proj, row0, h, VT);
    __syncthreads();
    { const int mt = wid >> 1; f32x4 c2[2] = {(f32x4){0.f, 0.f, 0.f, 0.f}, (f32x4){0.f, 0.f, 0.f, 0.f}};
#pragma unroll
        for (int ks = 0; ks < 4; ++ks) { const bf16x8 a = *(const bf16x8*)(QG + (16 * mt + l15) * 136 + ks * 32 + quad * 8);
#pragma unroll
            for (int j = 0; j < 2; ++j) { const int nt = 2 * (wid & 1) + j; const bf16x8 bb = *(const bf16x8*)(KD + (16 * nt + l15) * 136 + ks * 32 + quad * 8); c2[j] = mfma16(a, bb, c2[j]); } }
#pragma unroll
        for (int j = 0; j < 2; ++j)
#pragma unroll
            for (int e = 0; e < 4; ++e) { const int c = 16 * mt + quad * 4 + e, s = 16 * (2 * (wid & 1) + j) + l15; ATT[c * 72 + s] = f2bf(s <= c ? c2[j][e] : 0.f); } }
    __syncthreads();
    f32x4 o[4][2];
#pragma unroll
    for (int i = 0; i < 4; ++i)
#pragma unroll
        for (int j = 0; j < 2; ++j) o[i][j] = (f32x4){0.f, 0.f, 0.f, 0.f};
#pragma unroll
    for (int ks = 0; ks < 2; ++ks) { bf16x8 bv[2];
#pragma unroll
        for (int nt = 0; nt < 2; ++nt) bv[nt] = *(const bf16x8*)(VT + (32 * wid + 16 * nt + l15) * 72 + ks * 32 + quad * 8);
#pragma unroll
        for (int mt = 0; mt < 4; ++mt) { const bf16x8 a = *(const bf16x8*)(ATT + (16 * mt + l15) * 72 + ks * 32 + quad * 8);
#pragma unroll
            for (int nt = 0; nt < 2; ++nt) o[mt][nt] = mfma16(a, bv[nt], o[mt][nt]); } }
    const bf16_t* sst = (const bf16_t*)(p.ws + WS_SST) + (size_t)item * 32768;
#pragma unroll
    for (int ks = 0; ks < 4; ++ks) { bf16x8 bs[2];
#pragma unroll
        for (int nt = 0; nt < 2; ++nt) bs[nt] = *(const bf16x8*)(sst + (32 * wid + 16 * nt + l15) * 128 + ks * 32 + quad * 8);
#pragma unroll
        for (int mt = 0; mt < 4; ++mt) { const bf16x8 a = *(const bf16x8*)(QG + (16 * mt + l15) * 136 + ks * 32 + quad * 8);
#pragma unroll
            for (int nt = 0; nt < 2; ++nt) o[mt][nt] = mfma16(a, bs[nt], o[mt][nt]); } }
#pragma unroll
    for (int mt = 0; mt < 4; ++mt)
#pragma unroll
        for (int e = 0; e < 4; ++e) { float ss = o[mt][0][e] * o[mt][0][e] + o[mt][1][e] * o[mt][1][e];
            ss += __shfl_xor(ss, 1); ss += __shfl_xor(ss, 2); ss += __shfl_xor(ss, 4); ss += __shfl_xor(ss, 8);
            if (l15 == 0) RED[(16 * mt + quad * 4 + e) * 8 + wid] = ss; }
    __syncthreads();
    bf16_t* oa = (bf16_t*)(p.ws + WS_OA); const float* gng = p.in[16];
#pragma unroll
    for (int mt = 0; mt < 4; ++mt)
#pragma unroll
        for (int e = 0; e < 4; ++e) { const int c = 16 * mt + quad * 4 + e; const f32x4 r0 = *(const f32x4*)(RED + c * 8), r1 = *(const f32x4*)(RED + c * 8 + 4);
            const float tot = (r0[0] + r0[1]) + (r0[2] + r0[3]) + (r1[0] + r1[1]) + (r1[2] + r1[3]); const float rstd = rsqrtf(tot * (1.f / 256.f) + EPS);
#pragma unroll
            for (int nt = 0; nt < 2; ++nt) { const int dv = 32 * wid + 16 * nt + l15;
                const float val = o[mt][nt][e] * rstd * gng[dv] * bf2f(proj[(size_t)(row0 + c) * NIN + C_GR + h * 256 + dv]);
                oa[(size_t)(row0 + c) * D + h * 256 + dv] = f2bf(val); } }
    __syncthreads();
}

__device__ void gla_passB(const Params& p) {
    const int gtid = blockIdx.x * 512 + threadIdx.x, gsz = gridDim.x * 512;
    const float* U = (const float*)(p.ws + WS_U); const float* DEC = (const float*)(p.ws + WS_DEC); bf16_t* SST = (bf16_t*)(p.ws + WS_SST);
    for (int e4 = gtid; e4 < 131072; e4 += gsz) {
        const int bh = e4 >> 13, dv = (e4 >> 5) & 255, dk4 = (e4 & 31) * 4;
        f32x4 S = (f32x4){0.f, 0.f, 0.f, 0.f};
#pragma unroll 4
        for (int n = 0; n < 64; ++n) { const int item = bh * 64 + n; const size_t off = (size_t)item * 32768 + dv * 128 + dk4;
            u32x2 w; w.x = pk2(S[0], S[1]); w.y = pk2(S[2], S[3]); *(u32x2*)(SST + off) = w;
            const f32x4 u4 = *(const f32x4*)(U + off), d4 = *(const f32x4*)(DEC + item * 128 + dk4); S = d4 * S + u4; }
#pragma unroll
        for (int j = 0; j < 4; ++j) p.out[O_SGP + ((size_t)(bh * 128 + dk4 + j)) * 256 + dv] = S[j];
    }
}

__device__ void gla_sample(const Params& p, unsigned char* smem, int item) {
    const int tid = threadIdx.x, lane = tid & 63, wid = tid >> 6;
    const int db = item >> 2, h = item & 3, row0 = TP + db * 4;
    float* BC = (float*)smem;
    float* QG = BC + 512; float* KD = QG + 512; float* KL = KD + 512; float* DECs = KL + 512;
    float* V = DECs + 128;
    float* ATT = V + 1024;
    float* RS = ATT + 16;
    float* RED = RS + 16;
    const bf16_t* proj = (const bf16_t*)(p.ws + WS_PROJ); const float* glr = (const float*)(p.ws + WS_GLR);
    const int tok = tid >> 7, ch = tid & 127;
    { float z = p.in[15][h * 128 + ch]; const float* g = glr + (size_t)(row0 + tok) * 16;
#pragma unroll
        for (int r = 0; r < 16; ++r) z += g[r] * p.in[14][r * 512 + h * 128 + ch];
        BC[tok * 128 + ch] = (fminf(z, 0.f) - __logf(1.f + __expf(-fabsf(z)))) * (1.f / 16.f); }
    __syncthreads();
    if (tid < 128) { float s = 0.f;
#pragma unroll
        for (int t = 0; t < 4; ++t) { s += BC[t * 128 + tid]; BC[t * 128 + tid] = s; } }
    __syncthreads();
    { const float bc = BC[tok * 128 + ch], bl = BC[3 * 128 + ch];
        const float q = bf2f(proj[(size_t)(row0 + tok) * NIN + C_GQ + h * 128 + ch]), k = bf2f(proj[(size_t)(row0 + tok) * NIN + C_GK + h * 128 + ch]);
        QG[tok * 128 + ch] = q * 0.08838834764831845f * __expf(bc); KD[tok * 128 + ch] = k * __expf(-bc); KL[tok * 128 + ch] = k * __expf(bl - bc);
        if (tok == 0) DECs[ch] = __expf(bl);
#pragma unroll
        for (int j = 0; j < 2; ++j) { const int i = tid + j * 512, t2 = i >> 8, dv = i & 255; V[i] = bf2f(proj[(size_t)(row0 + t2) * NIN + C_GV + h * 256 + dv]); } }
    __syncthreads();
    {
#pragma unroll
        for (int j = 0; j < 2; ++j) { const int pr = wid + 8 * j, c = pr >> 2, s = pr & 3;
            float d = QG[c * 128 + lane] * KD[s * 128 + lane] + QG[c * 128 + 64 + lane] * KD[s * 128 + 64 + lane];
#pragma unroll
            for (int o = 32; o >= 1; o >>= 1) d += __shfl_xor(d, o);
            if (lane == 0) ATT[pr] = s <= c ? d : 0.f; } }
    __syncthreads();
    const int dvq = lane * 4;
    f32x4 v4[4], inter[4];
#pragma unroll
    for (int t = 0; t < 4; ++t) { v4[t] = *(const f32x4*)(V + t * 256 + dvq); inter[t] = (f32x4){0.f, 0.f, 0.f, 0.f}; }
    const float* S0 = p.in[2] + (size_t)(db * 4 + h) * 32768; float* S1 = p.out + O_SGS + (size_t)(db * 4 + h) * 32768;
#pragma unroll 4
    for (int it = 0; it < 16; ++it) { const int dk = it * 8 + wid;
        const f32x4 s4 = __builtin_nontemporal_load((const f32x4*)(S0 + dk * 256 + dvq));
        f32x4 nw = s4 * DECs[dk];
#pragma unroll
        for (int t = 0; t < 4; ++t) { inter[t] += s4 * QG[t * 128 + dk]; nw += v4[t] * KL[t * 128 + dk]; }
        __builtin_nontemporal_store(nw, (f32x4*)(S1 + dk * 256 + dvq)); }
#pragma unroll
    for (int t = 0; t < 4; ++t) *(f32x4*)(RED + (wid * 4 + t) * 256 + dvq) = inter[t];
    __syncthreads();
    { const int dv2 = (tid & 127) * 2; float o0 = 0.f, o1 = 0.f;
#pragma unroll
        for (int w = 0; w < 8; ++w) { const f32x2 r = *(const f32x2*)(RED + (w * 4 + tok) * 256 + dv2); o0 += r[0]; o1 += r[1]; }
#pragma unroll
        for (int s = 0; s < 4; ++s) { const float a = ATT[tok * 4 + s]; o0 += a * V[s * 256 + dv2]; o1 += a * V[s * 256 + dv2 + 1]; }
        float ss = o0 * o0 + o1 * o1;
#pragma unroll
        for (int o = 32; o >= 1; o >>= 1) ss += __shfl_xor(ss, o);
        if (lane == 0) RS[wid] = ss;
        __syncthreads();
        const float rstd = rsqrtf((RS[2 * tok] + RS[2 * tok + 1]) * (1.f / 256.f) + EPS);
        const int row = row0 + tok; const float* gng = p.in[16];
        const float y0 = o0 * rstd * gng[dv2] * bf2f(proj[(size_t)row * NIN + C_GR + h * 256 + dv2]);
        const float y1 = o1 * rstd * gng[dv2 + 1] * bf2f(proj[(size_t)row * NIN + C_GR + h * 256 + dv2 + 1]);
        *(unsigned*)((bf16_t*)(p.ws + WS_OA) + (size_t)row * D + h * 256 + dv2) = pk2(y0, y1); }
    __syncthreads();
}

__device__ void dsw_prompt(const Params& p, unsigned char* smem, int item) {
    const int tid = threadIdx.x, lane = tid & 63, wid = tid >> 6, l15 = lane & 15, quad = lane >> 4;
    const int blk = item & 31, gh = (item >> 5) % 12, b = item / 384;
    const int g = gh >> 2, dil = 1 << (2 * g), nbc = 32 >> (2 * g);
    const int r = blk / nbc, l0 = (blk % nbc) * 128;
    unsigned short* KS = (unsigned short*)smem;
    unsigned short* VT = (unsigned short*)(smem + 39168);
    unsigned short* PS = (unsigned short*)(smem + 75008) + wid * (16 * 168);
    const bf16_t* proj = (const bf16_t*)(p.ws + WS_PROJ);
    for (int idx = tid; idx < 2176; idx += 512) { const int i = idx >> 3, c8 = idx & 7, l = l0 - 144 + i; u32x4 v = (u32x4){0u, 0u, 0u, 0u};
        if (l >= 0) v = *(const u32x4*)(proj + (size_t)(b * T + l * dil + r) * NIN + C_DK + gh * 64 + c8 * 8);
        *(u32x4*)(KS + i * 72 + c8 * 8) = v; }
    for (int idx = tid; idx < 2176; idx += 512) { const int c8 = idx / 272, i = idx - c8 * 272, l = l0 - 144 + i; bf16x8 v = (bf16x8){0, 0, 0, 0, 0, 0, 0, 0};
        if (l >= 0) v = *(const bf16x8*)(proj + (size_t)(b * T + l * dil + r) * NIN + C_DV + gh * 64 + c8 * 8);
#pragma unroll
        for (int e = 0; e < 8; ++e) VT[(c8 * 8 + e) * 280 + i] = (unsigned short)v[e]; }
    __syncthreads();
    const int qrow = b * T + (l0 + 16 * wid + l15) * dil + r;
    bf16x8 qa[2];
#pragma unroll
    for (int ks = 0; ks < 2; ++ks) qa[ks] = *(const bf16x8*)(proj + (size_t)qrow * NIN + C_DQ + gh * 64 + ks * 32 + quad * 8);
    f32x4 s[9];
#pragma unroll
    for (int kt = 0; kt < 9; ++kt) { s[kt] = (f32x4){0.f, 0.f, 0.f, 0.f};
#pragma unroll
        for (int ks = 0; ks < 2; ++ks) { const bf16x8 bb = *(const bf16x8*)(KS + (16 * wid + 16 * (kt + 1) + l15) * 72 + ks * 32 + quad * 8); s[kt] = mfma16(qa[ks], bb, s[kt]); } }
    float mx[4] = {-INFINITY, -INFINITY, -INFINITY, -INFINITY};
#pragma unroll
    for (int kt = 0; kt < 9; ++kt)
#pragma unroll
        for (int e = 0; e < 4; ++e) { const int dist = 144 + quad * 4 + e - 16 * (kt + 1) - l15, lk = l0 - 144 + 16 * wid + 16 * (kt + 1) + l15;
            const bool valid = dist >= 0 && dist <= 128 && lk >= 0; const float v = valid ? s[kt][e] * 0.125f : -INFINITY; s[kt][e] = v; mx[e] = fmaxf(mx[e], v); }
#pragma unroll
    for (int e = 0; e < 4; ++e) { mx[e] = fmaxf(mx[e], __shfl_xor(mx[e], 1)); mx[e] = fmaxf(mx[e], __shfl_xor(mx[e], 2)); mx[e] = fmaxf(mx[e], __shfl_xor(mx[e], 4)); mx[e] = fmaxf(mx[e], __shfl_xor(mx[e], 8)); }
    float den[4] = {0.f, 0.f, 0.f, 0.f};
#pragma unroll
    for (int e = 0; e < 4; ++e) PS[(quad * 4 + e) * 168 + l15] = 0;
#pragma unroll
    for (int kt = 0; kt < 9; ++kt)
#pragma unroll
        for (int e = 0; e < 4; ++e) { const float pe = __expf(s[kt][e] - mx[e]); den[e] += pe; PS[(quad * 4 + e) * 168 + 16 * (kt + 1) + l15] = f2bf(pe); }
#pragma unroll
    for (int e = 0; e < 4; ++e) { den[e] += __shfl_xor(den[e], 1); den[e] += __shfl_xor(den[e], 2); den[e] += __shfl_xor(den[e], 4); den[e] += __shfl_xor(den[e], 8); }
    __syncthreads();
    f32x4 o[4];
#pragma unroll
    for (int dt = 0; dt < 4; ++dt) o[dt] = (f32x4){0.f, 0.f, 0.f, 0.f};
#pragma unroll
    for (int ks = 0; ks < 5; ++ks) { const bf16x8 a = *(const bf16x8*)(PS + l15 * 168 + ks * 32 + quad * 8);
#pragma unroll
        for (int dt = 0; dt < 4; ++dt) { const bf16x8 bb = *(const bf16x8*)(VT + (16 * dt + l15) * 280 + 16 * wid + ks * 32 + quad * 8); o[dt] = mfma16(a, bb, o[dt]); } }
    bf16_t* og = (bf16_t*)(p.ws + WS_OG); float* lse = (float*)(p.ws + WS_LSE);
#pragma unroll
    for (int e = 0; e < 4; ++e) { const int tk = b * T + (l0 + 16 * wid + quad * 4 + e) * dil + r; const float inv = 1.f / den[e];
#pragma unroll
        for (int dt = 0; dt < 4; ++dt) og[(size_t)tk * 768 + gh * 64 + 16 * dt + l15] = f2bf(o[dt][e] * inv);
        if (l15 == 0) lse[tk * 12 + gh] = mx[e] + __logf(den[e]); }
    __syncthreads();
}

__device__ void dsw_combine(const Params& p) {
    const int gtid = blockIdx.x * 512 + threadIdx.x, gsz = gridDim.x * 512;
    const bf16_t* og = (const bf16_t*)(p.ws + WS_OG); const float* lse = (const float*)(p.ws + WS_LSE); bf16_t* ob = (bf16_t*)(p.ws + WS_OB);
    for (int idx = gtid; idx < TP * 32; idx += gsz) { const int d8 = idx & 7, hh = (idx >> 3) & 3, tk = idx >> 5;
        const float l0 = lse[tk * 12 + hh], l1 = lse[tk * 12 + 4 + hh], l2 = lse[tk * 12 + 8 + hh];
        const float mx = fmaxf(l0, fmaxf(l1, l2)); float w0 = __expf(l0 - mx), w1 = __expf(l1 - mx), w2 = __expf(l2 - mx); const float inv = 1.f / (w0 + w1 + w2); w0 *= inv; w1 *= inv; w2 *= inv;
        f32x4 a0, b0, a1, b1, a2, b2;
        unpack8(*(const u32x4*)(og + (size_t)tk * 768 + hh * 64 + d8 * 8), a0, b0);
        unpack8(*(const u32x4*)(og + (size_t)tk * 768 + (4 + hh) * 64 + d8 * 8), a1, b1);
        unpack8(*(const u32x4*)(og + (size_t)tk * 768 + (8 + hh) * 64 + d8 * 8), a2, b2);
        *(u32x4*)(ob + (size_t)tk * 256 + hh * 64 + d8 * 8) = pack8(a0 * w0 + a1 * w1 + a2 * w2, b0 * w0 + b1 * w1 + b2 * w2); }
}

__device__ void dsw_sample(const Params& p, unsigned char* smem, int witem) {
    const int lane = threadIdx.x & 63, wid = threadIdx.x >> 6;
    float* qs = (float*)smem + wid * 256; float* ps = qs + 64;
    const int s = witem & 3, hh = (witem >> 2) & 3, db = witem >> 4, row = TP + db * 4 + s;
    const bf16_t* proj = (const bf16_t*)(p.ws + WS_PROJ);
    float rmx = -INFINITY, rws = 0.f, racc = 0.f;
#pragma unroll 1
    for (int g = 0; g < 3; ++g) {
        const int W = 128 << (2 * g), dil = 1 << (2 * g);
        const float* cache = p.in[3 + g] + (size_t)db * W * 512 + hh * 64;
        const float* kvn = p.out + okvs(g) + (size_t)(db * W + W - 4) * 512 + hh * 64;
        qs[lane] = bf2f(proj[(size_t)row * NIN + C_DQ + (g * 4 + hh) * 64 + 2 * (lane & 31) + (lane >> 5)]);
        __builtin_amdgcn_wave_barrier();
        float sc[3]; float m = -INFINITY;
#pragma unroll
        for (int jj = 0; jj < 3; ++jj) { const int j = lane + 64 * jj; sc[jj] = -INFINITY;
            if (j <= 128) { const int idx = W + s - j * dil; const float* kr = idx >= W ? kvn + (size_t)(idx - W) * 512 : cache + (size_t)idx * 512; float dot = 0.f;
#pragma unroll 4
                for (int c = 0; c < 16; ++c) { const f32x4 k4 = *(const f32x4*)(kr + c * 4), q4 = *(const f32x4*)(qs + c * 4); dot += k4[0] * q4[0] + k4[1] * q4[1] + k4[2] * q4[2] + k4[3] * q4[3]; }
                sc[jj] = dot * 0.125f; }
            m = fmaxf(m, sc[jj]); asm volatile("" ::: "memory"); }
#pragma unroll
        for (int o = 32; o >= 1; o >>= 1) m = fmaxf(m, __shfl_xor(m, o));
        float den = 0.f;
#pragma unroll
        for (int jj = 0; jj < 3; ++jj) { const int j = lane + 64 * jj; if (j <= 128) { const float e = __expf(sc[jj] - m); den += e; ps[j] = e; } }
#pragma unroll
        for (int o = 32; o >= 1; o >>= 1) den += __shfl_xor(den, o);
        __builtin_amdgcn_wave_barrier();
        float o = 0.f;
#pragma unroll 4
        for (int j = 0; j <= 128; ++j) { const int idx = W + s - j * dil; const float* vr = (idx >= W ? kvn + (size_t)(idx - W) * 512 : cache + (size_t)idx * 512) + 256; o += ps[j] * vr[lane]; }
        const float lg = m + __logf(den), nm = fmaxf(rmx, lg), sc_old = __expf(rmx - nm), wg = __expf(lg - nm);
        racc = racc * sc_old + wg * (o / den); rws = rws * sc_old + wg; rmx = nm;
        __builtin_amdgcn_wave_barrier();
    }
    ((bf16_t*)(p.ws + WS_OB))[(size_t)row * 256 + hh * 64 + lane] = f2bf(racc / rws);
}

__device__ void cache_copy(const Params& p) {
    const size_t gtid = (size_t)blockIdx.x * 512 + threadIdx.x, gsz = (size_t)gridDim.x * 512;
#pragma unroll
    for (int g = 0; g < 3; ++g) { const int W = 128 << (2 * g); const size_t per = (size_t)(W - 4) * 128, total = 128 * per;
        const float* src = p.in[3 + g]; float* dst = p.out + okvs(g);
        for (size_t i = gtid; i < total; i += gsz) { const size_t db = i / per, rr = i - db * per;
            const f32x4 v = __builtin_nontemporal_load((const f32x4*)(src + (db * W + 4) * 512) + rr);
            __builtin_nontemporal_store(v, (f32x4*)(dst + db * W * 512) + rr); } }
}

__global__ void __launch_bounds__(512) fwd(Params p) {
    extern __shared__ __attribute__((aligned(16))) unsigned char smem[];
    cg::grid_group grid = cg::this_grid();
    const int G = gridDim.x, bid = blockIdx.x;
    unsigned char* ws = p.ws;
    bf16_t* H = (bf16_t*)(ws + WS_H); bf16_t* PROJ = (bf16_t*)(ws + WS_PROJ); float* MOD = (float*)(ws + WS_MOD); float* X1 = (float*)(ws + WS_X1);
    if (PHMASK & 1) phase_prep(p, smem);
    grid.sync();
    if (PHMASK & 2) run_gemm(smem, (const bf16_t*)(ws + WS_SC), (const bf16_t*)(ws + WS_WADA), 256, NADA, D, FMod{MOD, p.in[11]});
    grid.sync();
    if (PHMASK & 4) phase_norm(p.in[0], p.in[1], p.in[8], MOD, 0, 1, H, nullptr, 0);
    grid.sync();
    if (PHMASK & 8) run_gemm(smem, H, (const bf16_t*)(ws + WS_WIN), M, NIN, D, FIn{PROJ, (float*)(ws + WS_GLR), (const float*)(ws + WS_BIN), (const f32x2*)(ws + WS_ROPE), p.out});
    grid.sync();
    if (PHMASK & 16) for (int it = bid; it < 1024; it += G) gla_passA(p, smem, it);
    if (PHMASK & 32) for (int it = bid; it < 1536; it += G) dsw_prompt(p, smem, it);
    if (PHMASK & 64) for (int it = bid; it < 512; it += G) gla_sample(p, smem, it);
    if (PHMASK & 128) for (int it = bid * 8 + (int)(threadIdx.x >> 6); it < 2048; it += G * 8) dsw_sample(p, smem, it);
    if (PHMASK & 256) cache_copy(p);
    grid.sync();
    if (PHMASK & 512) gla_passB(p);
    if (PHMASK & 1024) dsw_combine(p);
    grid.sync();
    if (PHMASK & 2048) for (int it = bid; it < 1024; it += G) gla_passC(p, smem, it);
    grid.sync();
    if (PHMASK & 4096) run_gemm(smem, (const bf16_t*)(ws + WS_OA), (const bf16_t*)(ws + WS_WPA), M, D, D, FPa{(bf16_t*)(ws + WS_MG), PROJ});
    if (PHMASK & 8192) run_gemm(smem, (const bf16_t*)(ws + WS_OB), (const bf16_t*)(ws + WS_WPB), M, D, 256, FPb{(bf16_t*)(ws + WS_MG), PROJ});
    grid.sync();
    if (PHMASK & 16384) run_gemm(smem, (const bf16_t*)(ws + WS_MG), (const bf16_t*)(ws + WS_WOUT), M, D, D, FOut{X1, p.in[0], p.in[1], MOD});
    grid.sync();
    if (PHMASK & 32768) phase_norm(X1, X1 + (size_t)TP * D, p.in[9], MOD, 3, 4, H, nullptr, 0);
    grid.sync();
    if (PHMASK & 65536) run_gemm(smem, H, (const bf16_t*)(ws + WS_WUP), M, NUP, D, FUp{(bf16_t*)(ws + WS_ACT)});
    grid.sync();
    if (PHMASK & 131072) run_gemm(smem, (const bf16_t*)(ws + WS_ACT), (const bf16_t*)(ws + WS_WDN), M, D, DFF, FDown{X1, MOD});
    grid.sync();
    if (PHMASK & 262144) phase_norm(X1, X1 + (size_t)TP * D, p.in[22], MOD, 0, 0, nullptr, p.out + O_Y, 1);
}
}

extern "C" void kernel_launch(void* const* d_in, const int* in_sizes, int n_in, void* d_out, int out_size, void* d_ws, size_t ws_size, hipStream_t stream) {
    static int grid = 0;
    if (grid == 0) {
        int dev = 0, cus = 0, per_cu = 0;
        hipGetDevice(&dev);
        hipDeviceGetAttribute(&cus, hipDeviceAttributeMultiprocessorCount, dev);
        if (hipFuncSetAttribute((const void*)mk::fwd, hipFuncAttributeMaxDynamicSharedMemorySize, mk::LDS_BYTES) != hipSuccess) fprintf(stderr, "kernel_launch: hipFuncSetAttribute failed\n");
        if (hipOccupancyMaxActiveBlocksPerMultiprocessor(&per_cu, (const void*)mk::fwd, 512, mk::LDS_BYTES) != hipSuccess || per_cu < 1) { fprintf(stderr, "kernel_launch: occupancy query says %d blocks per CU\n", per_cu); per_cu = 1; }
        (void)hipGetLastError();
        grid = cus > 0 ? cus : 256;
        if (n_in != 23 || (size_t)out_size != mk::O_END || ws_size < mk::WS_END) fprintf(stderr, "kernel_launch: unexpected sizes n_in %d out %d ws %zu (need %zu)\n", n_in, out_size, ws_size, (size_t)mk::WS_END);
    }
    mk::Params p{};
    for (int i = 0; i < 23; ++i) p.in[i] = (const float*)d_in[i];
    p.out = (float*)d_out; p.ws = (unsigned char*)d_ws;
    void* args[] = {&p};
    hipError_t e = hipLaunchCooperativeKernel((const void*)mk::fwd, dim3(grid), dim3(512), args, mk::LDS_BYTES, stream);
    if (e != hipSuccess) fprintf(stderr, "cooperative launch failed: %s (grid %d)\n", hipGetErrorString(e), grid);
}
```

```cpp
#include <hip/hip_runtime.h>
#include <hip/hip_cooperative_groups.h>
#include <cstdio>
namespace cg = cooperative_groups;
namespace pg8 {
#define PG8_LAS __attribute__((address_space(3)))
typedef unsigned short bf16_t;
typedef short bf16x8 __attribute__((ext_vector_type(8)));
typedef float f32x4 __attribute__((ext_vector_type(4)));
typedef unsigned u32x4 __attribute__((ext_vector_type(4)));
constexpr int BM = 256, BK = 64, HALF = 128, HTB = HALF * BK * 2  , STAGE_BYTES = 8 * HTB, NXCD = 8, WGM = 8;

__host__ __device__ __forceinline__ int lds_byte(int r, int c) { const int st = (r >> 4) * 2 + (c >> 5), rr = r & 15, cc = c & 31, ob = rr * 64 + cc * 2; return st * 1024 + (ob ^ (((ob >> 9) & 1) << 5)); }
__host__ __device__ __forceinline__ void stage_rc(int b, int& R, int& C) { const int st = b / 1024, sb = b % 1024, swz = sb ^ (((sb >> 9) & 1) << 5); R = (st >> 1) * 16 + swz / 64; C = (st & 1) * 32 + (swz % 64) / 2; }
__host__ __device__ __forceinline__ int perm32(int rho) { const int n = rho >> 4, i = rho & 15; return 8 * (i >> 2) + 4 * n + (i & 3); }

struct Unit { int pm, pn; };
struct Gemm { const bf16_t* A; const bf16_t* Bt; int M, N, K; };

struct StaticOrder {
    int nM, nN, nwg, G, c;
    __host__ __device__ void init(int M, int N, int G_, int c_) { nM = M / BM; nN = N / BM; nwg = nM * nN; G = G_; c = c_; }
    __host__ __device__ bool next(int i, Unit& u) const {
        const long L = (long)i * G + c; if (L >= nwg) return false;
        int wgid = (int)L; { const int q = nwg / NXCD, r = nwg % NXCD, xcd = wgid % NXCD, off = wgid / NXCD; wgid = (xcd < r ? xcd * (q + 1) : r * (q + 1) + (xcd - r) * q) + off; }
        const int nig = WGM * nN, gid = wgid / nig, fm = gid * WGM, gsz = (nM - fm) < WGM ? (nM - fm) : WGM;
        u.pm = fm + ((wgid % nig) % gsz); u.pn = (wgid % nig) / gsz; return true;
    }
    __device__ __forceinline__ void a_ready(const Unit&) const {}
    __device__ __forceinline__ void done(const Unit&) const {}
};
__device__ __forceinline__ unsigned cvt_pk_bf16(float lo, float hi) { unsigned r; asm volatile("v_cvt_pk_bf16_f32 %0, %1, %2" : "=v"(r) : "v"(lo), "v"(hi)); return r; }
typedef float f32x2 __attribute__((ext_vector_type(2)));
template <class Epi, class Sched, bool STAMP = false>
__device__ __forceinline__ void gemm_phase(PG8_LAS unsigned char* lds, const Gemm g, const Sched& S, const Epi& E, unsigned long long* stamps) {
    const int tid = threadIdx.x, wid = __builtin_amdgcn_readfirstlane(tid >> 6), lane = tid & 63, wr = wid >> 2, wc = wid & 3, fr = lane & 15, fq = lane >> 4;
    const int K = g.K, nt = K / BK;
    int ts_lo = 0, ts_hi = 0, nts = 0; const unsigned long long rt_entry = STAMP ? (unsigned long long)wall_clock64() : 0ull;
#define PG8_STAMP() do { if (STAMP && wid == 0 && nts < 64) { const unsigned long long _c = (unsigned long long)clock64(); \
        ts_lo = (lane == nts) ? (int)(unsigned)_c : ts_lo; ts_hi = (lane == nts) ? (int)(unsigned)(_c >> 32) : ts_hi; ++nts; } } while (0)
    PG8_STAMP();
    unsigned voffA[2], voffB[2];
#pragma unroll
    for (int i = 0; i < 2; ++i) { int R, C; stage_rc(tid * 16 + i * 8192, R, C); const int Rb = Epi::PERM ? ((R & ~31) + perm32(R & 31)) : R;
        voffA[i] = (unsigned)(R * K + C) * 2u; voffB[i] = (unsigned)(Rb * K + C) * 2u; }
    const size_t kstep = (size_t)(BK * 2);
    const size_t hstep = (size_t)HALF * K * 2;
    const size_t tstep = 2 * hstep;
    const unsigned ldsw = (unsigned)wid * 1024u;
    const int aoff = lds_byte(wr * 64 + fr, fq * 8), boff = lds_byte(wc * 32 + fr, fq * 8);
#define PG8_SA(b, h) (((b) * 2 + (h)) * HTB)
#define PG8_SB(b, h) ((4 + (b) * 2 + (h)) * HTB)
#define PG8_STAGE(bufoff, gbase, voff) do { _Pragma("unroll") for (int _i = 0; _i < 2; ++_i) \
        __builtin_amdgcn_global_load_lds((const unsigned*)((const char*)(gbase) + (voff)[_i]), (PG8_LAS unsigned*)(lds + (bufoff) + ldsw + _i * 8192), 16, 0, 0); } while (0)
#define PG8_LDA(dst, b, h) do { _Pragma("unroll") for (int m = 0; m < 4; ++m) _Pragma("unroll") for (int k = 0; k < 2; ++k) dst[m][k] = *(const PG8_LAS bf16x8*)(lds + PG8_SA(b, h) + aoff + m * 2048 + k * 1024); } while (0)
#define PG8_LDB(dst, b, h) do { _Pragma("unroll") for (int n = 0; n < 2; ++n) _Pragma("unroll") for (int k = 0; k < 2; ++k) dst[n][k] = *(const PG8_LAS bf16x8*)(lds + PG8_SB(b, h) + boff + n * 2048 + k * 1024); } while (0)
#define PG8_MMA(ai, bj, At, Bt) do { __builtin_amdgcn_s_setprio(1); _Pragma("unroll") for (int m = 0; m < 4; ++m) _Pragma("unroll") for (int n = 0; n < 2; ++n) _Pragma("unroll") for (int k = 0; k < 2; ++k) \
        acc[ai][bj][m][n] = __builtin_amdgcn_mfma_f32_16x16x32_bf16(Bt[n][k], At[m][k], acc[ai][bj][m][n], 0, 0, 0); __builtin_amdgcn_s_setprio(0); } while (0)
#define PG8_WAIT_V(n) asm volatile("s_waitcnt vmcnt(" #n ")" ::: "memory")
#define PG8_WAIT_L(n) asm volatile("s_waitcnt lgkmcnt(" #n ")" ::: "memory")
#define PG8_BAR __builtin_amdgcn_s_barrier()
#define PG8_SCHED __builtin_amdgcn_sched_barrier(0)
    Unit cur, nxt; int ui = 0;
    if (!S.next(0, cur)) return;
    f32x4 acc[2][2][4][2];
#pragma unroll
    for (int a = 0; a < 2; ++a)
#pragma unroll
        for (int b = 0; b < 2; ++b)
#pragma unroll
            for (int m = 0; m < 4; ++m)
#pragma unroll
                for (int n = 0; n < 2; ++n) acc[a][b][m][n] = (f32x4){0.f, 0.f, 0.f, 0.f};
    bf16x8 At[4][2], B0[2][2], B1[2][2];
    const char* cA = (const char*)g.A + (size_t)cur.pm * tstep; const char* cB = (const char*)g.Bt + (size_t)cur.pn * tstep;
    S.a_ready(cur);
    PG8_STAGE(PG8_SB(0, 0), cB, voffB); PG8_STAGE(PG8_SA(0, 0), cA, voffA); PG8_STAGE(PG8_SB(0, 1), cB + hstep, voffB); PG8_STAGE(PG8_SA(0, 1), cA + hstep, voffA);
    if (wr == 1) PG8_BAR;
    PG8_WAIT_V(4); PG8_BAR;
    PG8_STAGE(PG8_SB(1, 0), cB + kstep, voffB); PG8_STAGE(PG8_SA(1, 0), cA + kstep, voffA); PG8_STAGE(PG8_SB(1, 1), cB + hstep + kstep, voffB);
    PG8_WAIT_V(6); PG8_BAR;
    PG8_STAMP();
    for (;;) {
        const bool has_next = S.next(ui + 1, nxt);
        const char* nA = has_next ? (const char*)g.A + (size_t)nxt.pm * tstep : cA; const char* nB = has_next ? (const char*)g.Bt + (size_t)nxt.pn * tstep : cB;
        for (int t = 0; t < nt; t += 2) {
            const bool last = (t == nt - 2);
            const char* a1 = cA + (size_t)(t + 1) * kstep;
            const char* a2 = last ? nA : cA + (size_t)(t + 2) * kstep; const char* b2 = last ? nB : cB + (size_t)(t + 2) * kstep;
            const char* a3 = a2 + kstep; const char* b3 = b2 + kstep;
            if (last && has_next) S.a_ready(nxt);
            PG8_LDB(B0, 0, 0); PG8_SCHED; PG8_LDA(At, 0, 0); PG8_STAGE(PG8_SA(1, 1), a1 + hstep, voffA);
            PG8_WAIT_L(8); PG8_BAR; PG8_WAIT_L(0); PG8_MMA(0, 0, At, B0); PG8_BAR; PG8_SCHED;
            PG8_LDB(B1, 0, 1); PG8_STAGE(PG8_SB(0, 0), b2, voffB);
            PG8_BAR; PG8_WAIT_L(0); PG8_MMA(0, 1, At, B1); PG8_BAR;
            PG8_LDA(At, 0, 1); PG8_STAGE(PG8_SA(0, 0), a2, voffA);
            PG8_BAR; PG8_WAIT_L(0); PG8_MMA(1, 0, At, B0); PG8_BAR; PG8_SCHED;
            PG8_STAGE(PG8_SB(0, 1), b2 + hstep, voffB);
            PG8_WAIT_V(6); PG8_BAR; PG8_MMA(1, 1, At, B1); PG8_BAR;
            PG8_LDB(B0, 1, 0); PG8_SCHED; PG8_LDA(At, 1, 0); PG8_STAGE(PG8_SA(0, 1), a2 + hstep, voffA);
            PG8_WAIT_L(8); PG8_BAR; PG8_WAIT_L(0); PG8_MMA(0, 0, At, B0); PG8_BAR; PG8_SCHED;
            PG8_LDB(B1, 1, 1); PG8_STAGE(PG8_SB(1, 0), b3, voffB);
            PG8_BAR; PG8_WAIT_L(0); PG8_MMA(0, 1, At, B1); PG8_BAR;
            PG8_LDA(At, 1, 1); PG8_STAGE(PG8_SA(1, 0), a3, voffA);
            PG8_BAR; PG8_WAIT_L(0); PG8_MMA(1, 0, At, B0); PG8_BAR; PG8_SCHED;
            PG8_STAGE(PG8_SB(1, 1), b3 + hstep, voffB);
            PG8_WAIT_V(6); PG8_BAR; PG8_MMA(1, 1, At, B1); PG8_BAR;
        }
        PG8_STAMP();
        if constexpr (!Epi::AFTER_DRAIN) { E(acc, cur, wr, wc, fr, fq); S.done(cur); }
        PG8_STAMP();
        if (!has_next) break;
#pragma unroll
        for (int a = 0; a < 2; ++a)
#pragma unroll
            for (int b = 0; b < 2; ++b)
#pragma unroll
                for (int m = 0; m < 4; ++m)
#pragma unroll
                    for (int n = 0; n < 2; ++n) acc[a][b][m][n] = (f32x4){0.f, 0.f, 0.f, 0.f};
        cur = nxt; cA = nA; cB = nB; ++ui;
    }
    PG8_WAIT_V(0);
    if (wr == 0) PG8_BAR;
    PG8_BAR;
    if constexpr (Epi::AFTER_DRAIN) { E.fused(acc, cur, wr, wc, fr, fq, lds, wid, lane); S.done(cur); }
    PG8_STAMP();
    if (STAMP && wid == 0) { stamps[lane] = lane < nts ? (((unsigned long long)(unsigned)ts_hi << 32) | (unsigned)ts_lo) : 0ull;
        if (lane == 62) stamps[62] = rt_entry; if (lane == 63) stamps[63] = (unsigned long long)wall_clock64(); }
#undef PG8_STAMP
#undef PG8_SA
#undef PG8_SB
#undef PG8_STAGE
#undef PG8_LDA
#undef PG8_LDB
#undef PG8_MMA
#undef PG8_WAIT_V
#undef PG8_WAIT_L
#undef PG8_BAR
#undef PG8_SCHED
}
}

#define XB_TMO      128
#define XB_XCNT(j)  (256  + 64 * (j))
#define XB_XSUB(j)  (1280 + 64 * (j))
#define XB_XGEN(j)  (2304 + 64 * (j))
#define XB_TOP      3328
#define XB_TOPGEN   3392
#define XCD_BAR_WORDS 3456
#define XB_SPIN_CAP (1u << 18)
#define LAS __attribute__((address_space(3)))

__device__ __forceinline__ unsigned xb_ld(unsigned* p)              { return __hip_atomic_load(p, __ATOMIC_RELAXED, __HIP_MEMORY_SCOPE_AGENT); }
__device__ __forceinline__ unsigned xb_add(unsigned* p, unsigned v) { return __hip_atomic_fetch_add(p, v, __ATOMIC_RELAXED, __HIP_MEMORY_SCOPE_AGENT); }
__device__ __forceinline__ unsigned xb_xcc_id() { return (unsigned)__builtin_amdgcn_s_getreg((3 << 11) | 20) & 0xFu; }
#define XB_SPIN(cond, bar) do { unsigned _sp = 0; while (cond) { __builtin_amdgcn_s_sleep(1); \
    if ((++_sp & 255u) == 0u) { if (xb_ld(&(bar)[XB_TMO])) break; if (_sp > XB_SPIN_CAP) { atomicAdd(&(bar)[XB_TMO], 1u); break; } } } } while (0)

struct XcdBarrier {
    unsigned* bar; unsigned x;
    volatile LAS unsigned* st;
};

__device__ __forceinline__ XcdBarrier xcd_barrier_post(unsigned* bar, volatile LAS unsigned* st) {
    XcdBarrier b; b.bar = bar; b.x = xb_xcc_id(); b.st = st;
    if (threadIdx.x == 0) (void)xb_add(&bar[XB_XCNT(b.x)], 1u);
    return b;
}
__device__ __forceinline__ void xcd_barrier_complete(unsigned* bar, unsigned x, unsigned& nloc, unsigned& nx) {
    const unsigned G = gridDim.x * gridDim.y * gridDim.z;
    unsigned sum, cnt, mine, sp = 0u;
    for (;;) {
        sum = 0u; cnt = 0u; mine = 0u;
#pragma unroll
        for (unsigned j = 0; j < 16; ++j) { const unsigned c = xb_ld(&bar[XB_XCNT(j)]); sum += c; cnt += (c > 0u) ? 1u : 0u; mine = (j == x) ? c : mine; }
        if (sum == G) break;
        __builtin_amdgcn_s_sleep(1);
        if ((++sp & 255u) == 0u) { if (xb_ld(&bar[XB_TMO])) break; if (sp > XB_SPIN_CAP) { atomicAdd(&bar[XB_TMO], 1u); break; } }
    }
    nloc = mine > 0u ? mine : 1u; nx = cnt > 0u ? cnt : 1u;
}

__device__ __forceinline__ void xcd_barrier(const XcdBarrier& b) {
    asm volatile("s_waitcnt vmcnt(0)" ::: "memory");
    __syncthreads();
    if (threadIdx.x == 0) {
        unsigned* bar = b.bar;
        __builtin_amdgcn_s_waitcnt(0);
        unsigned nloc = b.st[0], nx = b.st[1];
        if (nloc == 0u) { xcd_barrier_complete(bar, b.x, nloc, nx); b.st[0] = nloc; b.st[1] = nx; }
        const unsigned old = xb_add(&bar[XB_XSUB(b.x)], 1u);
        const unsigned gen = old / nloc;
        if (old + 1u == (gen + 1u) * nloc) {
            __builtin_amdgcn_fence(__ATOMIC_RELEASE, "agent");
            asm volatile("s_waitcnt vmcnt(0)" ::: "memory");
            const unsigned og = xb_add(&bar[XB_TOP], 1u);
            const unsigned tg = og / nx;
            if (og + 1u == (tg + 1u) * nx) xb_add(&bar[XB_TOPGEN], 1u);
            else XB_SPIN(xb_ld(&bar[XB_TOPGEN]) == tg, bar);
            __builtin_amdgcn_fence(__ATOMIC_ACQUIRE, "agent");
            xb_add(&bar[XB_XGEN(b.x)], 1u);
            asm volatile("s_waitcnt vmcnt(0)" ::: "memory");
        } else {
            XB_SPIN(xb_ld(&bar[XB_XGEN(b.x)]) == gen, bar);
            __builtin_amdgcn_fence(__ATOMIC_ACQUIRE, "agent");
            asm volatile("s_waitcnt vmcnt(0)" ::: "memory");
        }
    }
    __syncthreads();
}

#ifndef PHMASK
#define PHMASK 0x7FFFF
#endif
namespace mk {
using pg8::bf16_t; using pg8::bf16x8; using pg8::f32x4; using pg8::u32x4;
typedef unsigned u32x2 __attribute__((ext_vector_type(2)));
typedef float f32x2 __attribute__((ext_vector_type(2)));

constexpr int D = 1024, T = 4096, NB = 4, TP = NB * T, DBATCH = 128, SS = 4, TS = DBATCH * SS, M = TP + TS;
constexpr int NIN = 7680, NADA = 6144, NUP = 5632, DFF = 2816;
constexpr int C_GQ = 0, C_GK = 512, C_GV = 1024, C_GR = 2048, C_DQ = 3072, C_DK = 3840, C_DV = 4608, C_GA = 5376, C_GB = 6400, C_GLR = 7424, C_END = 7440;
constexpr int LDS_XTRA = 131072 + 16;
constexpr int LDS_BYTES = LDS_XTRA + (7680 + 32) * 4;
constexpr float EPS = 1e-6f;

constexpr size_t al(size_t x) { return (x + 255) & ~(size_t)255; }
constexpr size_t WS_WADA = 0;
constexpr size_t WS_WIN = WS_WADA + al((size_t)NADA * D * 2);
constexpr size_t WS_WPA = WS_WIN + al((size_t)NIN * D * 2);
constexpr size_t WS_WPB = WS_WPA + al((size_t)D * D * 2);
constexpr size_t WS_WOUT = WS_WPB + al((size_t)D * 256 * 2);
constexpr size_t WS_WUP = WS_WOUT + al((size_t)D * D * 2);
constexpr size_t WS_WDN = WS_WUP + al((size_t)NUP * D * 2);
constexpr size_t WS_BIN = WS_WDN + al((size_t)D * DFF * 2);
constexpr size_t WS_SC = WS_BIN + al((size_t)NIN * 4);
constexpr size_t WS_ROPE = WS_SC + al((size_t)256 * D * 2);
constexpr size_t WS_MOD = WS_ROPE + al((size_t)4100 * 32 * 8);
constexpr size_t WS_H = WS_MOD + al((size_t)256 * NADA * 4);
constexpr size_t WS_PROJ = WS_H + al((size_t)M * D * 2);
constexpr size_t WS_GLR = WS_PROJ + al((size_t)M * NIN * 2);
constexpr size_t WS_U = WS_GLR + al((size_t)M * 16 * 4);
constexpr size_t WS_DEC = WS_U + al((size_t)1024 * 32768 * 4);
constexpr size_t WS_SST = WS_DEC + al((size_t)1024 * 128 * 4);
constexpr size_t WS_OG = WS_SST + al((size_t)1024 * 32768 * 2);
constexpr size_t WS_LSE = WS_OG + al((size_t)TP * 768 * 2);
constexpr size_t WS_OA = WS_LSE + al((size_t)TP * 12 * 4);
constexpr size_t WS_OB = WS_OA + al((size_t)M * D * 2);
constexpr size_t WS_MG = WS_OB + al((size_t)M * 256 * 2);
constexpr size_t WS_X1 = WS_MG + al((size_t)M * D * 2);
constexpr size_t WS_ACT = WS_X1 + al((size_t)M * D * 4);
constexpr size_t WS_CTL = WS_ACT + al((size_t)M * DFF * 2);
constexpr size_t WS_BAR = WS_CTL + 4096;
constexpr size_t WS_END = WS_BAR + 16384;

constexpr size_t O_Y = 0;
constexpr size_t O_SGP = O_Y + (size_t)M * D;
constexpr size_t O_KVP0 = O_SGP + (size_t)4 * 4 * 128 * 256;
constexpr size_t O_KVP1 = O_KVP0 + (size_t)4 * 128 * 512;
constexpr size_t O_KVP2 = O_KVP1 + (size_t)4 * 512 * 512;
constexpr size_t O_SGS = O_KVP2 + (size_t)4 * 2048 * 512;
constexpr size_t O_KVS0 = O_SGS + (size_t)128 * 4 * 128 * 256;
constexpr size_t O_KVS1 = O_KVS0 + (size_t)128 * 128 * 512;
constexpr size_t O_KVS2 = O_KVS1 + (size_t)128 * 512 * 512;
constexpr size_t O_END = O_KVS2 + (size_t)128 * 2048 * 512;

struct Params { const float* in[23]; float* out; unsigned char* ws; };
typedef const __attribute__((address_space(4))) Params* KP;
__device__ __forceinline__ KP kargs() { KP k = (KP)__builtin_amdgcn_kernarg_segment_ptr(); asm volatile("" : "+s"(k)); return k; }

__device__ __forceinline__ float bf2f(unsigned short b) { return __uint_as_float(((unsigned)b) << 16); }
__device__ __forceinline__ unsigned short f2bf(float f) { unsigned u = __float_as_uint(f); u += 0x7FFFu + ((u >> 16) & 1u); return (unsigned short)(u >> 16); }
__device__ __forceinline__ unsigned pk2(float lo, float hi) { unsigned r; asm("v_cvt_pk_bf16_f32 %0, %1, %2" : "=v"(r) : "v"(lo), "v"(hi)); return r; }
__device__ __forceinline__ float silu_f(float x) { return x * __builtin_amdgcn_rcpf(1.f + __expf(-x)); }
__device__ __forceinline__ float sigm_f(float x) { return __builtin_amdgcn_rcpf(1.f + __expf(-x)); }
__device__ __forceinline__ int brow_of(int row) { return row < TP ? (row >> 12) : 4 + ((row - TP) >> 2); }
__device__ __forceinline__ size_t okvp(int g) { return g == 0 ? O_KVP0 : (g == 1 ? O_KVP1 : O_KVP2); }
__device__ __forceinline__ size_t okvs(int g) { return g == 0 ? O_KVS0 : (g == 1 ? O_KVS1 : O_KVS2); }
__device__ __forceinline__ f32x4 mfma16(bf16x8 a, bf16x8 b, f32x4 c) { return __builtin_amdgcn_mfma_f32_16x16x32_bf16(a, b, c, 0, 0, 0); }
__device__ __forceinline__ u32x4 pack8(f32x4 a, f32x4 b) { u32x4 w; w.x = pk2(a[0], a[1]); w.y = pk2(a[2], a[3]); w.z = pk2(b[0], b[1]); w.w = pk2(b[2], b[3]); return w; }
__device__ __forceinline__ void unpack8(u32x4 w, f32x4& a, f32x4& b) {
    a[0] = __uint_as_float(w.x << 16); a[1] = __uint_as_float(w.x & 0xffff0000u); a[2] = __uint_as_float(w.y << 16); a[3] = __uint_as_float(w.y & 0xffff0000u);
    b[0] = __uint_as_float(w.z << 16); b[1] = __uint_as_float(w.z & 0xffff0000u); b[2] = __uint_as_float(w.w << 16); b[3] = __uint_as_float(w.w & 0xffff0000u); }

__device__ __forceinline__ int map_in(int n) {
    if (n < 3072) return n;
    if (n < C_DV) { const int isK = n >= C_DK; const int j = n - (isK ? C_DK : C_DQ); const int head = j >> 6, p = j & 63; return (isK ? 3856 : 3088) + head * 64 + (p >> 1) + 32 * (p & 1); }
    if (n < C_GA) return 4624 + (n - C_DV);
    if (n < C_GB) return 5392 + (n - C_GA);
    if (n < C_GLR) return 6416 + (n - C_GB);
    if (n < C_END) return 3072 + (n - C_GLR);
    return -1;
}
__device__ __forceinline__ int map_up(int n) { const int q = n >> 3, e = n & 7; return e < 4 ? 4 * q + e : DFF + 4 * q + e - 4; }

__device__ __forceinline__ void tr_tile(const float* __restrict__ W, int ldw, bf16_t* __restrict__ Bt, int K, int n0, int k0, int mapid, unsigned char* smem) {
    unsigned short* t = (unsigned short*)smem;
    const int tid = threadIdx.x, lane = tid & 63, w8 = tid >> 6;
    const int n = n0 + lane; const int src = mapid == 0 ? n : (mapid == 1 ? map_in(n) : map_up(n));
#pragma unroll
    for (int j = 0; j < 8; ++j) { const int kk = w8 + 8 * j; const float v = src >= 0 ? W[(size_t)(k0 + kk) * ldw + src] : 0.f; t[kk * 66 + lane] = f2bf(v); }
    __syncthreads();
#pragma unroll
    for (int j = 0; j < 8; ++j) { const int nn = w8 + 8 * j; Bt[(size_t)(n0 + nn) * K + k0 + lane] = t[lane * 66 + nn]; }
    __syncthreads();
}

__device__ void phase_prep(KP p, unsigned char* smem) {
    const int G = gridDim.x;
    for (int ti = blockIdx.x; ti < 6144; ti += G) {
        const float* W; int ldw, K, kT, mapid, base; bf16_t* Bt;
        if (ti < 1536)      { W = p->in[10]; ldw = NADA; K = D;   kT = 16; mapid = 0; base = 0;    Bt = (bf16_t*)(p->ws + WS_WADA); }
        else if (ti < 3456) { W = p->in[12]; ldw = 7440; K = D;   kT = 16; mapid = 1; base = 1536; Bt = (bf16_t*)(p->ws + WS_WIN); }
        else if (ti < 3712) { W = p->in[17]; ldw = D;    K = D;   kT = 16; mapid = 0; base = 3456; Bt = (bf16_t*)(p->ws + WS_WPA); }
        else if (ti < 3776) { W = p->in[18]; ldw = D;    K = 256; kT = 4;  mapid = 0; base = 3712; Bt = (bf16_t*)(p->ws + WS_WPB); }
        else if (ti < 4032) { W = p->in[19]; ldw = D;    K = D;   kT = 16; mapid = 0; base = 3776; Bt = (bf16_t*)(p->ws + WS_WOUT); }
        else if (ti < 5440) { W = p->in[20]; ldw = NUP;  K = D;   kT = 16; mapid = 2; base = 4032; Bt = (bf16_t*)(p->ws + WS_WUP); }
        else                { W = p->in[21]; ldw = D;    K = DFF; kT = 44; mapid = 0; base = 5440; Bt = (bf16_t*)(p->ws + WS_WDN); }
        const int li = ti - base, nt = li / kT, kt = li % kT;
        tr_tile(W, ldw, Bt, K, nt * 64, kt * 64, mapid, smem);
    }
    const int gtid = blockIdx.x * 512 + threadIdx.x, gsz = G * 512;
    float* bin = (float*)(p->ws + WS_BIN);
    for (int n = gtid; n < NIN; n += gsz) { const int m = map_in(n); bin[n] = m >= 0 ? p->in[13][m] : 0.f; }
    bf16_t* sc = (bf16_t*)(p->ws + WS_SC);
    for (int i = gtid; i < 256 * D; i += gsz) { const int r = i >> 10, c = i & 1023; float v = 0.f;
        if (r < 4) v = p->in[6][r * D + c]; else if (r < 132) v = p->in[7][(r - 4) * D + c];
        sc[i] = f2bf(silu_f(v)); }
}

template <class F> struct EpiF {
    static constexpr bool PERM = true, AFTER_DRAIN = false;
    F f;
    __device__ __forceinline__ void operator()(const f32x4 (&acc)[2][2][4][2], const pg8::Unit& u, int wr, int wc, int fr, int fq) const {
#pragma unroll
        for (int ai = 0; ai < 2; ++ai)
#pragma unroll
            for (int m = 0; m < 4; ++m) {
                const int row = u.pm * 256 + ai * 128 + wr * 64 + m * 16 + fr;
#pragma unroll
                for (int bj = 0; bj < 2; ++bj) { const int col = u.pn * 256 + bj * 128 + wc * 32 + 8 * fq; f(row, col, acc[ai][bj][m][0], acc[ai][bj][m][1]); }
            }
    }
};

template <class F> struct EpiG {
    static constexpr bool PERM = true, AFTER_DRAIN = false;
    F f;
    __device__ __forceinline__ void operator()(const f32x4 (&acc)[2][2][4][2], const pg8::Unit& u, int wr, int wc, int fr, int fq) const {
        const bool uni = u.pm < 64;
#pragma unroll
        for (int bj = 0; bj < 2; ++bj) {
            const int col = u.pn * 256 + bj * 128 + wc * 32 + 8 * fq;
            f32x4 g0 = (f32x4){0.f, 0.f, 0.f, 0.f}, g1 = g0;
            if (uni) { const float* g = f.gate(u.pm >> 4, col); g0 = *(const f32x4*)g; g1 = *(const f32x4*)(g + 4); }
#pragma unroll
            for (int ai = 0; ai < 2; ++ai)
#pragma unroll
                for (int m = 0; m < 4; ++m) { const int row = u.pm * 256 + ai * 128 + wr * 64 + m * 16 + fr;
                    f32x4 h0 = g0, h1 = g1;
                    if (!uni) { const float* g = f.gate(brow_of(row), col); h0 = *(const f32x4*)g; h1 = *(const f32x4*)(g + 4); }
                    f.run(row, col, acc[ai][bj][m][0], acc[ai][bj][m][1], h0, h1); }
        }
    }
};
struct FMod { float* mod; const float* bias;
    __device__ __forceinline__ void operator()(int row, int col, f32x4 a, f32x4 b) const {
        a += *(const f32x4*)(bias + col); b += *(const f32x4*)(bias + col + 4);
        float* d = mod + (size_t)row * NADA + col; *(f32x4*)d = a; *(f32x4*)(d + 4) = b; } };

struct FIn { bf16_t* proj; float* glr; const LAS float* lb; float* out;
    __device__ __forceinline__ void kvout(int row, int g, int hh, int kv, int f, f32x4 v) const {
        const int W = 128 << (2 * g);
        if (row < TP) { const int t = row & 4095, b = row >> 12; if (t >= T - W) { float* d = out + okvp(g) + ((size_t)(b * W + t - (T - W)) * 2 + kv) * 256 + hh * 64 + f; *(f32x4*)d = v; } }
        else { const int r = row - TP, db = r >> 2, s = r & 3; float* d = out + okvs(g) + ((size_t)(db * W + W - 4 + s) * 2 + kv) * 256 + hh * 64 + f; *(f32x4*)d = v; }
    }
    __device__ __forceinline__ void operator()(int row, int col, f32x4 a, f32x4 b) const {
        if (col >= C_END) return;
        a += *(const LAS f32x4*)(lb + col); b += *(const LAS f32x4*)(lb + col + 4);
        if (col >= C_GLR) { float* d = glr + (size_t)row * 16 + (col - C_GLR); *(f32x4*)d = a; *(f32x4*)(d + 4) = b; return; }
        if (col >= C_GA) {
#pragma unroll
            for (int j = 0; j < 4; ++j) { a[j] = sigm_f(a[j]); b[j] = sigm_f(b[j]); }
        } else if (col >= C_DQ && col < C_DV) {
            const int isK = col >= C_DK; const int j = col - (isK ? C_DK : C_DQ); const int head = j >> 6, i0 = (j & 63) >> 1;
            const float posf = (float)(row < TP ? (row & 4095) : 8192 + ((row - TP) & 3));
            const f32x4 inv4 = *(const LAS f32x4*)(lb + NIN + i0);
            f32x4 cs0, cs1;
            { const float r0 = __builtin_amdgcn_fractf(posf * inv4[0] * 0.15915494309189535f), r1 = __builtin_amdgcn_fractf(posf * inv4[1] * 0.15915494309189535f),
                          r2 = __builtin_amdgcn_fractf(posf * inv4[2] * 0.15915494309189535f), r3 = __builtin_amdgcn_fractf(posf * inv4[3] * 0.15915494309189535f);
              cs0[0] = __builtin_amdgcn_cosf(r0); cs0[1] = __builtin_amdgcn_sinf(r0); cs0[2] = __builtin_amdgcn_cosf(r1); cs0[3] = __builtin_amdgcn_sinf(r1);
              cs1[0] = __builtin_amdgcn_cosf(r2); cs1[1] = __builtin_amdgcn_sinf(r2); cs1[2] = __builtin_amdgcn_cosf(r3); cs1[3] = __builtin_amdgcn_sinf(r3); }
            f32x4 ra, rb;
            ra[0] = a[0] * cs0[0] - a[1] * cs0[1]; ra[1] = a[1] * cs0[0] + a[0] * cs0[1];
            ra[2] = a[2] * cs0[2] - a[3] * cs0[3]; ra[3] = a[3] * cs0[2] + a[2] * cs0[3];
            rb[0] = b[0] * cs1[0] - b[1] * cs1[1]; rb[1] = b[1] * cs1[0] + b[0] * cs1[1];
            rb[2] = b[2] * cs1[2] - b[3] * cs1[3]; rb[3] = b[3] * cs1[2] + b[2] * cs1[3];
            a = ra; b = rb;
            if (isK) { f32x4 x1, x2; x1[0] = a[0]; x1[1] = a[2]; x1[2] = b[0]; x1[3] = b[2]; x2[0] = a[1]; x2[1] = a[3]; x2[2] = b[1]; x2[3] = b[3];
                kvout(row, head >> 2, head & 3, 0, i0, x1); kvout(row, head >> 2, head & 3, 0, 32 + i0, x2); }
        } else if (col >= C_DV && col < C_GA) {
            const int j = col - C_DV, head = j >> 6, f = j & 63;
            kvout(row, head >> 2, head & 3, 1, f, a); kvout(row, head >> 2, head & 3, 1, f + 4, b);
        }
        *(u32x4*)(proj + (size_t)row * NIN + col) = pack8(a, b);
    } };

struct FPa { bf16_t* mg; const bf16_t* proj;
    __device__ __forceinline__ void operator()(int row, int col, f32x4 a, f32x4 b) const {
        f32x4 g0, g1; unpack8(*(const u32x4*)(proj + (size_t)row * NIN + C_GA + col), g0, g1);
        *(u32x4*)(mg + (size_t)row * D + col) = pack8(a * g0, b * g1); } };
struct FPb { bf16_t* mg; const bf16_t* proj;
    __device__ __forceinline__ void operator()(int row, int col, f32x4 a, f32x4 b) const {
        f32x4 g0, g1, m0, m1; unpack8(*(const u32x4*)(proj + (size_t)row * NIN + C_GB + col), g0, g1);
        unpack8(*(const u32x4*)(mg + (size_t)row * D + col), m0, m1);
        *(u32x4*)(mg + (size_t)row * D + col) = pack8(m0 + a * g0, m1 + b * g1); } };
struct FOut { bf16_t* x1; const float* xp; const float* xs; const float* mod;
    __device__ __forceinline__ const float* gate(int br, int col) const { return mod + (size_t)br * NADA + 2 * D + col; }
    __device__ __forceinline__ void run(int row, int col, f32x4 a, f32x4 b, f32x4 g0, f32x4 g1) const {
        const float* xr = row < TP ? xp + (size_t)row * D + col : xs + (size_t)(row - TP) * D + col;
        *(u32x4*)(x1 + (size_t)row * D + col) = pack8(*(const f32x4*)xr + g0 * a, *(const f32x4*)(xr + 4) + g1 * b); } };
struct FUp { bf16_t* act;
    __device__ __forceinline__ void operator()(int row, int col, f32x4 a, f32x4 b) const {
        u32x2 w; w.x = pk2(silu_f(a[0]) * b[0], silu_f(a[1]) * b[1]); w.y = pk2(silu_f(a[2]) * b[2], silu_f(a[3]) * b[3]);
        *(u32x2*)(act + (size_t)row * DFF + (col >> 1)) = w; } };
struct FDown { bf16_t* x1; const float* mod;
    __device__ __forceinline__ const float* gate(int br, int col) const { return mod + (size_t)br * NADA + 5 * D + col; }
    __device__ __forceinline__ void run(int row, int col, f32x4 a, f32x4 b, f32x4 g0, f32x4 g1) const {
        bf16_t* d = x1 + (size_t)row * D + col; f32x4 x0, x4; unpack8(*(const u32x4*)d, x0, x4);
        *(u32x4*)d = pack8(x0 + g0 * a, x4 + g1 * b); } };

template <class F> __device__ __forceinline__ void run_gemm_g(unsigned char* smem, const bf16_t* A, const bf16_t* Bt, int Mm, int Nn, int Kk, const F& f, int Gg, int cc) {
    asm volatile("" : "+s"(Kk));
    pg8::Gemm g{A, Bt, Mm, Nn, Kk}; pg8::StaticOrder S; S.init(Mm, Nn, Gg, cc);
    EpiG<F> E{f};
    pg8::gemm_phase<EpiG<F>, pg8::StaticOrder, false>((PG8_LAS unsigned char*)smem, g, S, E, nullptr);
}
template <class F> __device__ __forceinline__ void run_gemm(unsigned char* smem, const bf16_t* A, const bf16_t* Bt, int Mm, int Nn, int Kk, const F& f, int Gg, int cc) {
    asm volatile("" : "+s"(Kk));
    pg8::Gemm g{A, Bt, Mm, Nn, Kk}; pg8::StaticOrder S; S.init(Mm, Nn, Gg, cc);
    EpiF<F> E{f};
    pg8::gemm_phase<EpiF<F>, pg8::StaticOrder, false>((PG8_LAS unsigned char*)smem, g, S, E, nullptr);
}

__device__ void phase_norm(const float* xa, const float* xb, const float* gain, const float* mod, int sh_i, int sc_i, bf16_t* ob, float* of, int mode, const bf16_t* xh) {
    const int lane = threadIdx.x & 63, gw = blockIdx.x * 8 + (threadIdx.x >> 6), nw = gridDim.x * 8;
    for (int row = gw; row < M; row += nw) {
        const float* xr = row < TP ? xa + (size_t)row * D : xb + (size_t)(row - TP) * D;
        f32x4 v[4]; float ss = 0.f;
#pragma unroll
        for (int j = 0; j < 4; ++j) { if (xh) { const u32x2 w = *(const u32x2*)(xh + (size_t)row * D + j * 256 + lane * 4); v[j][0] = __uint_as_float(w.x << 16); v[j][1] = __uint_as_float(w.x & 0xffff0000u); v[j][2] = __uint_as_float(w.y << 16); v[j][3] = __uint_as_float(w.y & 0xffff0000u); }
            else v[j] = *(const f32x4*)(xr + j * 256 + lane * 4);
            ss += v[j][0] * v[j][0] + v[j][1] * v[j][1] + v[j][2] * v[j][2] + v[j][3] * v[j][3]; }
#pragma unroll
        for (int o = 32; o >= 1; o >>= 1) ss += __shfl_xor(ss, o);
        const float rstd = rsqrtf(ss * (1.f / D) + EPS);
        const float* mr = mod + (size_t)brow_of(row) * NADA;
#pragma unroll
        for (int j = 0; j < 4; ++j) { const int c = j * 256 + lane * 4; f32x4 y = v[j] * rstd * *(const f32x4*)(gain + c);
            if (mode == 0) { y = y * (*(const f32x4*)(mr + sc_i * D + c) + 1.f) + *(const f32x4*)(mr + sh_i * D + c);
                u32x2 w; w.x = pk2(y[0], y[1]); w.y = pk2(y[2], y[3]); *(u32x2*)(ob + (size_t)row * D + c) = w; }
            else *(f32x4*)(of + (size_t)row * D + c) = y; }
    }
}

__device__ __forceinline__ void gla_front(KP p, int row0, int h, float* LA, float* SEG) {
    const int tid = threadIdx.x; const float* glr = (const float*)(p->ws + WS_GLR);
    const float* wa = p->in[14]; const int ch = tid & 127, tg = tid >> 7;
    float* GL = SEG + 512;
    const f32x2 g2 = *(const f32x2*)(glr + (size_t)row0 * 16 + tid * 2);
    float w[16];
#pragma unroll
    for (int r = 0; r < 16; ++r) w[r] = wa[r * 512 + h * 128 + ch];
    const float bb = p->in[15][h * 128 + ch];
    *(f32x2*)(GL + tid * 2) = g2;
    __syncthreads();
    float run = 0.f;
#pragma unroll 4
    for (int i = 0; i < 16; ++i) { const int tok = tg * 16 + i; const float* g = GL + tok * 16; float z = bb;
#pragma unroll
        for (int r4 = 0; r4 < 4; ++r4) { const f32x4 g4 = *(const f32x4*)(g + r4 * 4); z += g4[0] * w[r4 * 4] + g4[1] * w[r4 * 4 + 1] + g4[2] * w[r4 * 4 + 2] + g4[3] * w[r4 * 4 + 3]; }
        const float ls = fminf(z, 0.f) - __logf(1.f + __expf(-fabsf(z)));
        run += ls * (1.f / 16.f); LA[tok * 132 + ch] = run; }
    SEG[tg * 128 + ch] = run;
    __syncthreads();
    if (tg > 0) { float off = SEG[ch]; if (tg > 1) off += SEG[128 + ch]; if (tg > 2) off += SEG[256 + ch];
#pragma unroll 4
        for (int i = 0; i < 16; ++i) LA[(tg * 16 + i) * 132 + ch] += off; }
    __syncthreads();
}
struct VRows { bf16x8 r[4]; };
__device__ __forceinline__ VRows gla_fetch_v(const bf16_t* proj, int row0, int h) {
    const int tid = threadIdx.x, t4 = tid & 15, vg = tid >> 4; VRows v;
#pragma unroll
    for (int j = 0; j < 4; ++j) v.r[j] = *(const bf16x8*)(proj + (size_t)(row0 + 4 * t4 + j) * NIN + C_GV + h * 256 + vg * 8);
    return v;
}
__device__ __forceinline__ void gla_put_vt(const VRows& v, unsigned short* VT) {
    const int tid = threadIdx.x, t4 = tid & 15, vg = tid >> 4;
#pragma unroll
    for (int e = 0; e < 8; ++e) { u32x2 w; w.x = (unsigned)(unsigned short)v.r[0][e] | ((unsigned)(unsigned short)v.r[1][e] << 16); w.y = (unsigned)(unsigned short)v.r[2][e] | ((unsigned)(unsigned short)v.r[3][e] << 16);
        *(u32x2*)(VT + (vg * 8 + e) * 72 + 4 * t4) = w; }
}

__device__ void gla_passA(KP p, unsigned char* smem, int item) {
    const int tid = threadIdx.x, lane = tid & 63, wid = tid >> 6, l15 = lane & 15, quad = lane >> 4;
    const int bh = item >> 6, n = item & 63, b = bh >> 2, h = bh & 3, row0 = b * T + n * 64;
    float* LA = (float*)smem; unsigned short* KLT = (unsigned short*)(smem + 33792); unsigned short* VT = (unsigned short*)(smem + 33792 + 18432);
    const bf16_t* proj = (const bf16_t*)(p->ws + WS_PROJ);
    const VRows vrows = gla_fetch_v(proj, row0, h);
    bf16x8 r[4];
    { const int t4 = tid & 15, cgp = (tid >> 4) & 15;
#pragma unroll
        for (int j = 0; j < 4; ++j) r[j] = *(const bf16x8*)(proj + (size_t)(row0 + 4 * t4 + j) * NIN + C_GK + h * 128 + cgp * 8); }
    gla_front(p, row0, h, LA, (float*)(smem + 118784));
    if (tid < 256) { const int t4 = tid & 15, cgp = tid >> 4;
#pragma unroll
        for (int e = 0; e < 8; ++e) { const int ch = cgp * 8 + e; const float bl = LA[63 * 132 + ch]; float kf[4];
#pragma unroll
            for (int j = 0; j < 4; ++j) kf[j] = bf2f((unsigned short)r[j][e]) * __expf(bl - LA[(4 * t4 + j) * 132 + ch]);
            u32x2 w; w.x = pk2(kf[0], kf[1]); w.y = pk2(kf[2], kf[3]); *(u32x2*)(KLT + ch * 72 + 4 * t4) = w; } }
    gla_put_vt(vrows, VT);
    if (tid < 128) ((float*)(p->ws + WS_DEC))[item * 128 + tid] = __expf(LA[63 * 132 + tid]);
    __syncthreads();
    f32x4 acc[2][8];
#pragma unroll
    for (int i = 0; i < 2; ++i)
#pragma unroll
        for (int j = 0; j < 8; ++j) acc[i][j] = (f32x4){0.f, 0.f, 0.f, 0.f};
#pragma unroll
    for (int ks = 0; ks < 2; ++ks) { bf16x8 a[2];
#pragma unroll
        for (int mt = 0; mt < 2; ++mt) a[mt] = *(const bf16x8*)(VT + (32 * wid + 16 * mt + l15) * 72 + ks * 32 + quad * 8);
#pragma unroll
        for (int nt = 0; nt < 8; ++nt) { const bf16x8 bb = *(const bf16x8*)(KLT + (16 * nt + l15) * 72 + ks * 32 + quad * 8);
#pragma unroll
            for (int mt = 0; mt < 2; ++mt) acc[mt][nt] = mfma16(a[mt], bb, acc[mt][nt]); } }
    bf16_t* U = (bf16_t*)(p->ws + WS_U) + (size_t)item * 32768;
#pragma unroll
    for (int mt = 0; mt < 2; ++mt)
#pragma unroll
        for (int nt = 0; nt < 8; ++nt)
#pragma unroll
            for (int e = 0; e < 4; ++e) U[(32 * wid + 16 * mt + quad * 4 + e) * 128 + 16 * nt + l15] = f2bf(acc[mt][nt][e]);
    __syncthreads();
}

__device__ void gla_passC(KP p, unsigned char* smem, int item) {
    const int tid = threadIdx.x, lane = tid & 63, wid = tid >> 6, l15 = lane & 15, quad = lane >> 4;
    const int bh = item >> 6, n = item & 63, b = bh >> 2, h = bh & 3, row0 = b * T + n * 64;
    float* LA = (float*)smem; unsigned short* QG = (unsigned short*)(smem + 33792); unsigned short* KD = (unsigned short*)(smem + 51200);
    unsigned short* VT = (unsigned short*)(smem + 68608); unsigned short* ATT = (unsigned short*)(smem + 105472); float* RED = (float*)(smem + 114688);
    const bf16_t* proj = (const bf16_t*)(p->ws + WS_PROJ);
    const VRows vrows = gla_fetch_v(proj, row0, h);
    bf16x8 q8s[2], k8s[2];
#pragma unroll
    for (int it = 0; it < 2; ++it) { const int idx = tid + it * 512, cgp = idx & 15, tok = idx >> 4;
        q8s[it] = *(const bf16x8*)(proj + (size_t)(row0 + tok) * NIN + C_GQ + h * 128 + cgp * 8); k8s[it] = *(const bf16x8*)(proj + (size_t)(row0 + tok) * NIN + C_GK + h * 128 + cgp * 8); }
    const bf16_t* sst = (const bf16_t*)(p->ws + WS_SST) + (size_t)item * 32768;
    bf16x8 bsall[4][2];
#pragma unroll
    for (int ks = 0; ks < 4; ++ks)
#pragma unroll
        for (int nt = 0; nt < 2; ++nt) bsall[ks][nt] = *(const bf16x8*)(sst + (32 * wid + 16 * nt + l15) * 128 + ks * 32 + quad * 8);
    gla_front(p, row0, h, LA, (float*)(smem + 118784));
#pragma unroll
    for (int it = 0; it < 2; ++it) { const int idx = tid + it * 512, cgp = idx & 15, tok = idx >> 4;
        const bf16x8 q8 = q8s[it], k8 = k8s[it];
        f32x4 qa, qb, ka, kb;
#pragma unroll
        for (int e = 0; e < 8; ++e) { const float bc = LA[tok * 132 + cgp * 8 + e];
            const float qf = bf2f((unsigned short)q8[e]) * 0.08838834764831845f * __expf(bc), kf = bf2f((unsigned short)k8[e]) * __expf(-bc);
            if (e < 4) { qa[e] = qf; ka[e] = kf; } else { qb[e - 4] = qf; kb[e - 4] = kf; } }
        *(u32x4*)(QG + tok * 136 + cgp * 8) = pack8(qa, qb); *(u32x4*)(KD + tok * 136 + cgp * 8) = pack8(ka, kb); }
    gla_put_vt(vrows, VT);
    __syncthreads();
    { const int mt = wid >> 1; f32x4 c2[2] = {(f32x4){0.f, 0.f, 0.f, 0.f}, (f32x4){0.f, 0.f, 0.f, 0.f}};
#pragma unroll
        for (int ks = 0; ks < 4; ++ks) { const bf16x8 a = *(const bf16x8*)(QG + (16 * mt + l15) * 136 + ks * 32 + quad * 8);
#pragma unroll
            for (int j = 0; j < 2; ++j) { const int nt = 2 * (wid & 1) + j; const bf16x8 bb = *(const bf16x8*)(KD + (16 * nt + l15) * 136 + ks * 32 + quad * 8); c2[j] = mfma16(a, bb, c2[j]); } }
#pragma unroll
        for (int j = 0; j < 2; ++j)
#pragma unroll
            for (int e = 0; e < 4; ++e) { const int c = 16 * mt + quad * 4 + e, s = 16 * (2 * (wid & 1) + j) + l15; ATT[c * 72 + s] = f2bf(s <= c ? c2[j][e] : 0.f); } }
    __syncthreads();
    f32x4 o[4][2];
#pragma unroll
    for (int i = 0; i < 4; ++i)
#pragma unroll
        for (int j = 0; j < 2; ++j) o[i][j] = (f32x4){0.f, 0.f, 0.f, 0.f};
#pragma unroll
    for (int ks = 0; ks < 2; ++ks) { bf16x8 bv[2];
#pragma unroll
        for (int nt = 0; nt < 2; ++nt) bv[nt] = *(const bf16x8*)(VT + (32 * wid + 16 * nt + l15) * 72 + ks * 32 + quad * 8);
#pragma unroll
        for (int mt = 0; mt < 4; ++mt) { const bf16x8 a = *(const bf16x8*)(ATT + (16 * mt + l15) * 72 + ks * 32 + quad * 8);
#pragma unroll
            for (int nt = 0; nt < 2; ++nt) o[mt][nt] = mfma16(a, bv[nt], o[mt][nt]); } }
#pragma unroll
    for (int ks = 0; ks < 4; ++ks) { bf16x8 bs[2];
#pragma unroll
        for (int nt = 0; nt < 2; ++nt) bs[nt] = bsall[ks][nt];
#pragma unroll
        for (int mt = 0; mt < 4; ++mt) { const bf16x8 a = *(const bf16x8*)(QG + (16 * mt + l15) * 136 + ks * 32 + quad * 8);
#pragma unroll
            for (int nt = 0; nt < 2; ++nt) o[mt][nt] = mfma16(a, bs[nt], o[mt][nt]); } }
#pragma unroll
    for (int mt = 0; mt < 4; ++mt)
#pragma unroll
        for (int e = 0; e < 4; ++e) { float ss = o[mt][0][e] * o[mt][0][e] + o[mt][1][e] * o[mt][1][e];
            ss += __shfl_xor(ss, 1); ss += __shfl_xor(ss, 2); ss += __shfl_xor(ss, 4); ss += __shfl_xor(ss, 8);
            if (l15 == 0) RED[(16 * mt + quad * 4 + e) * 8 + wid] = ss; }
    __syncthreads();
    bf16_t* oa = (bf16_t*)(p->ws + WS_OA); const float* gng = p->in[16];
    unsigned short* OS = (unsigned short*)smem;
#pragma unroll
    for (int mt = 0; mt < 4; ++mt)
#pragma unroll
        for (int e = 0; e < 4; ++e) { const int c = 16 * mt + quad * 4 + e; const f32x4 r0 = *(const f32x4*)(RED + c * 8), r1 = *(const f32x4*)(RED + c * 8 + 4);
            const float tot = (r0[0] + r0[1]) + (r0[2] + r0[3]) + (r1[0] + r1[1]) + (r1[2] + r1[3]); const float rstd = rsqrtf(tot * (1.f / 256.f) + EPS);
#pragma unroll
            for (int nt = 0; nt < 2; ++nt) OS[c * 264 + 32 * wid + 16 * nt + l15] = f2bf(o[mt][nt][e] * rstd); }
    __syncthreads();
#pragma unroll
    for (int it = 0; it < 4; ++it) { const int idx = tid + it * 512, c = idx >> 5, d8 = (idx & 31) * 8;
        f32x4 o0, o1, s0, s1; unpack8(*(const u32x4*)(OS + c * 264 + d8), o0, o1);
        unpack8(*(const u32x4*)(proj + (size_t)(row0 + c) * NIN + C_GR + h * 256 + d8), s0, s1);
        const f32x4 g0 = *(const f32x4*)(gng + d8), g1 = *(const f32x4*)(gng + d8 + 4);
#pragma unroll
        for (int j = 0; j < 4; ++j) { s0[j] = silu_f(s0[j]); s1[j] = silu_f(s1[j]); }
        *(u32x4*)(oa + (size_t)(row0 + c) * D + h * 256 + d8) = pack8(o0 * g0 * s0, o1 * g1 * s1); }
    __syncthreads();
}

__device__ void gla_passB(KP p) {
    const int gtid = blockIdx.x * 512 + threadIdx.x, gsz = gridDim.x * 512;
    const bf16_t* U = (const bf16_t*)(p->ws + WS_U); const float* DEC = (const float*)(p->ws + WS_DEC); bf16_t* SST = (bf16_t*)(p->ws + WS_SST);
    for (int e4 = gtid; e4 < 131072; e4 += gsz) {
        const int bh = e4 >> 13, dv = (e4 >> 5) & 255, dk4 = (e4 & 31) * 4;
        f32x4 S = (f32x4){0.f, 0.f, 0.f, 0.f};
#pragma unroll 4
        for (int n = 0; n < 64; ++n) { const int item = bh * 64 + n; const size_t off = (size_t)item * 32768 + dv * 128 + dk4;
            u32x2 w; w.x = pk2(S[0], S[1]); w.y = pk2(S[2], S[3]); *(u32x2*)(SST + off) = w;
            const u32x2 ub = *(const u32x2*)(U + off); const f32x4 d4 = *(const f32x4*)(DEC + item * 128 + dk4);
            f32x4 u4; u4[0] = __uint_as_float(ub.x << 16); u4[1] = __uint_as_float(ub.x & 0xffff0000u); u4[2] = __uint_as_float(ub.y << 16); u4[3] = __uint_as_float(ub.y & 0xffff0000u);
            S = d4 * S + u4; }
#pragma unroll
        for (int j = 0; j < 4; ++j) p->out[O_SGP + ((size_t)(bh * 128 + dk4 + j)) * 256 + dv] = S[j];
    }
}

__device__ void gla_sample(KP p, unsigned char* smem, int item) {
    const int tid = threadIdx.x, lane = tid & 63, wid = tid >> 6;
    const int db = item >> 2, h = item & 3, row0 = TP + db * 4;
    float* BC = (float*)smem;
    float* QG = BC + 512; float* KD = QG + 512; float* KL = KD + 512; float* DECs = KL + 512;
    float* V = DECs + 128;
    float* ATT = V + 1024;
    float* RS = ATT + 16;
    float* RED = RS + 16;
    const bf16_t* proj = (const bf16_t*)(p->ws + WS_PROJ); const float* glr = (const float*)(p->ws + WS_GLR);
    const int tok = tid >> 7, ch = tid & 127;
    { float z = p->in[15][h * 128 + ch]; const float* g = glr + (size_t)(row0 + tok) * 16;
#pragma unroll
        for (int r = 0; r < 16; ++r) z += g[r] * p->in[14][r * 512 + h * 128 + ch];
        BC[tok * 128 + ch] = (fminf(z, 0.f) - __logf(1.f + __expf(-fabsf(z)))) * (1.f / 16.f); }
    __syncthreads();
    if (tid < 128) { float s = 0.f;
#pragma unroll
        for (int t = 0; t < 4; ++t) { s += BC[t * 128 + tid]; BC[t * 128 + tid] = s; } }
    __syncthreads();
    { const float bc = BC[tok * 128 + ch], bl = BC[3 * 128 + ch];
        const float q = bf2f(proj[(size_t)(row0 + tok) * NIN + C_GQ + h * 128 + ch]), k = bf2f(proj[(size_t)(row0 + tok) * NIN + C_GK + h * 128 + ch]);
        QG[tok * 128 + ch] = q * 0.08838834764831845f * __expf(bc); KD[tok * 128 + ch] = k * __expf(-bc); KL[tok * 128 + ch] = k * __expf(bl - bc);
        if (tok == 0) DECs[ch] = __expf(bl);
#pragma unroll
        for (int j = 0; j < 2; ++j) { const int i = tid + j * 512, t2 = i >> 8, dv = i & 255; V[i] = bf2f(proj[(size_t)(row0 + t2) * NIN + C_GV + h * 256 + dv]); } }
    __syncthreads();
    {
#pragma unroll
        for (int j = 0; j < 2; ++j) { const int pr = wid + 8 * j, c = pr >> 2, s = pr & 3;
            float d = QG[c * 128 + lane] * KD[s * 128 + lane] + QG[c * 128 + 64 + lane] * KD[s * 128 + 64 + lane];
#pragma unroll
            for (int o = 32; o >= 1; o >>= 1) d += __shfl_xor(d, o);
            if (lane == 0) ATT[pr] = s <= c ? d : 0.f; } }
    __syncthreads();
    const int dvq = lane * 4;
    f32x4 v4[4], inter[4];
#pragma unroll
    for (int t = 0; t < 4; ++t) { v4[t] = *(const f32x4*)(V + t * 256 + dvq); inter[t] = (f32x4){0.f, 0.f, 0.f, 0.f}; }
    const float* S0 = p->in[2] + (size_t)(db * 4 + h) * 32768; float* S1 = p->out + O_SGS + (size_t)(db * 4 + h) * 32768;
#pragma unroll 4
    for (int it = 0; it < 16; ++it) { const int dk = it * 8 + wid;
        const f32x4 s4 = __builtin_nontemporal_load((const f32x4*)(S0 + dk * 256 + dvq));
        f32x4 nw = s4 * DECs[dk];
#pragma unroll
        for (int t = 0; t < 4; ++t) { inter[t] += s4 * QG[t * 128 + dk]; nw += v4[t] * KL[t * 128 + dk]; }
        __builtin_nontemporal_store(nw, (f32x4*)(S1 + dk * 256 + dvq)); }
#pragma unroll
    for (int t = 0; t < 4; ++t) *(f32x4*)(RED + (wid * 4 + t) * 256 + dvq) = inter[t];
    __syncthreads();
    { const int dv2 = (tid & 127) * 2; float o0 = 0.f, o1 = 0.f;
#pragma unroll
        for (int w = 0; w < 8; ++w) { const f32x2 r = *(const f32x2*)(RED + (w * 4 + tok) * 256 + dv2); o0 += r[0]; o1 += r[1]; }
#pragma unroll
        for (int s = 0; s < 4; ++s) { const float a = ATT[tok * 4 + s]; o0 += a * V[s * 256 + dv2]; o1 += a * V[s * 256 + dv2 + 1]; }
        float ss = o0 * o0 + o1 * o1;
#pragma unroll
        for (int o = 32; o >= 1; o >>= 1) ss += __shfl_xor(ss, o);
        if (lane == 0) RS[wid] = ss;
        __syncthreads();
        const float rstd = rsqrtf((RS[2 * tok] + RS[2 * tok + 1]) * (1.f / 256.f) + EPS);
        const int row = row0 + tok; const float* gng = p->in[16];
        const float y0 = o0 * rstd * gng[dv2] * silu_f(bf2f(proj[(size_t)row * NIN + C_GR + h * 256 + dv2]));
        const float y1 = o1 * rstd * gng[dv2 + 1] * silu_f(bf2f(proj[(size_t)row * NIN + C_GR + h * 256 + dv2 + 1]));
        *(unsigned*)((bf16_t*)(p->ws + WS_OA) + (size_t)row * D + h * 256 + dv2) = pk2(y0, y1); }
    __syncthreads();
}

__device__ void dsw_prompt(KP p, unsigned char* smem, int item) {
    const int tid = threadIdx.x, lane = tid & 63, wid = tid >> 6, l15 = lane & 15, quad = lane >> 4;
    const int blk = item & 31, gh = (item >> 5) % 12, b = item / 384;
    const int g = gh >> 2, dil = 1 << (2 * g), nbc = 32 >> (2 * g);
    const int r = blk / nbc, l0 = (blk % nbc) * 128;
    unsigned short* KS = (unsigned short*)smem;
    unsigned short* VT = (unsigned short*)(smem + 39168);
    unsigned short* PS = (unsigned short*)(smem + 75008) + wid * (16 * 168);
    const bf16_t* proj = (const bf16_t*)(p->ws + WS_PROJ);
    const int qrow = b * T + (l0 + 16 * wid + l15) * dil + r;
    bf16x8 qa[2];
#pragma unroll
    for (int ks = 0; ks < 2; ++ks) qa[ks] = *(const bf16x8*)(proj + (size_t)qrow * NIN + C_DQ + gh * 64 + ks * 32 + quad * 8);
    u32x4 kreg[5];
#pragma unroll
    for (int it = 0; it < 5; ++it) { const int idx = tid + it * 512, i = idx >> 3, c8 = idx & 7, l = l0 - 144 + i; kreg[it] = (u32x4){0u, 0u, 0u, 0u};
        if (idx < 2176 && l >= 0) kreg[it] = *(const u32x4*)(proj + (size_t)(b * T + l * dil + r) * NIN + C_DK + gh * 64 + c8 * 8); }
    bf16x8 vreg[2][4];
#pragma unroll
    for (int it = 0; it < 2; ++it) { const int idx = tid + it * 512, c8 = idx / 68, i = 4 * (idx - c8 * 68), l = l0 - 144 + i;
#pragma unroll
        for (int j = 0; j < 4; ++j) { vreg[it][j] = (bf16x8){0, 0, 0, 0, 0, 0, 0, 0}; if (idx < 544 && l >= 0) vreg[it][j] = *(const bf16x8*)(proj + (size_t)(b * T + (l + j) * dil + r) * NIN + C_DV + gh * 64 + c8 * 8); } }
#pragma unroll
    for (int it = 0; it < 5; ++it) { const int idx = tid + it * 512, i = idx >> 3, c8 = idx & 7; if (idx < 2176) *(u32x4*)(KS + i * 72 + c8 * 8) = kreg[it]; }
#pragma unroll
    for (int it = 0; it < 2; ++it) { const int idx = tid + it * 512, c8 = idx / 68, i = 4 * (idx - c8 * 68);
        if (idx < 544) {
#pragma unroll
            for (int e = 0; e < 8; ++e) { u32x2 w; w.x = (unsigned)(unsigned short)vreg[it][0][e] | ((unsigned)(unsigned short)vreg[it][1][e] << 16); w.y = (unsigned)(unsigned short)vreg[it][2][e] | ((unsigned)(unsigned short)vreg[it][3][e] << 16);
                *(u32x2*)(VT + (c8 * 8 + e) * 280 + i) = w; } } }
    __syncthreads();
    f32x4 s[9];
#pragma unroll
    for (int kt = 0; kt < 9; ++kt) { s[kt] = (f32x4){0.f, 0.f, 0.f, 0.f};
#pragma unroll
        for (int ks = 0; ks < 2; ++ks) { const bf16x8 bb = *(const bf16x8*)(KS + (16 * wid + 16 * (kt + 1) + l15) * 72 + ks * 32 + quad * 8); s[kt] = mfma16(qa[ks], bb, s[kt]); } }
    float mx[4] = {-INFINITY, -INFINITY, -INFINITY, -INFINITY};
#pragma unroll
    for (int kt = 0; kt < 9; ++kt)
#pragma unroll
        for (int e = 0; e < 4; ++e) { const int dist = 144 + quad * 4 + e - 16 * (kt + 1) - l15, lk = l0 - 144 + 16 * wid + 16 * (kt + 1) + l15;
            const bool valid = dist >= 0 && dist <= 128 && lk >= 0; const float v = valid ? s[kt][e] * 0.125f : -INFINITY; s[kt][e] = v; mx[e] = fmaxf(mx[e], v); }
#pragma unroll
    for (int e = 0; e < 4; ++e) { mx[e] = fmaxf(mx[e], __shfl_xor(mx[e], 1)); mx[e] = fmaxf(mx[e], __shfl_xor(mx[e], 2)); mx[e] = fmaxf(mx[e], __shfl_xor(mx[e], 4)); mx[e] = fmaxf(mx[e], __shfl_xor(mx[e], 8)); }
    float den[4] = {0.f, 0.f, 0.f, 0.f};
#pragma unroll
    for (int e = 0; e < 4; ++e) PS[(quad * 4 + e) * 168 + l15] = 0;
#pragma unroll
    for (int kt = 0; kt < 9; ++kt)
#pragma unroll
        for (int e = 0; e < 4; ++e) { const float pe = __expf(s[kt][e] - mx[e]); den[e] += pe; PS[(quad * 4 + e) * 168 + 16 * (kt + 1) + l15] = f2bf(pe); }
#pragma unroll
    for (int e = 0; e < 4; ++e) { den[e] += __shfl_xor(den[e], 1); den[e] += __shfl_xor(den[e], 2); den[e] += __shfl_xor(den[e], 4); den[e] += __shfl_xor(den[e], 8); }
    __syncthreads();
    f32x4 o[4];
#pragma unroll
    for (int dt = 0; dt < 4; ++dt) o[dt] = (f32x4){0.f, 0.f, 0.f, 0.f};
#pragma unroll
    for (int ks = 0; ks < 5; ++ks) { const bf16x8 a = *(const bf16x8*)(PS + l15 * 168 + ks * 32 + quad * 8);
#pragma unroll
        for (int dt = 0; dt < 4; ++dt) { const bf16x8 bb = *(const bf16x8*)(VT + (16 * dt + l15) * 280 + 16 * wid + ks * 32 + quad * 8); o[dt] = mfma16(a, bb, o[dt]); } }
    bf16_t* og = (bf16_t*)(p->ws + WS_OG); float* lse = (float*)(p->ws + WS_LSE);
#pragma unroll
    for (int e = 0; e < 4; ++e) { const int tk = b * T + (l0 + 16 * wid + quad * 4 + e) * dil + r; const float inv = 1.f / den[e];
#pragma unroll
        for (int dt = 0; dt < 4; ++dt) og[(size_t)tk * 768 + gh * 64 + 16 * dt + l15] = f2bf(o[dt][e] * inv);
        if (l15 == 0) lse[tk * 12 + gh] = mx[e] + __logf(den[e]); }
    __syncthreads();
}

__device__ void dsw_combine(KP p) {
    const int gtid = blockIdx.x * 512 + threadIdx.x, gsz = gridDim.x * 512;
    const bf16_t* og = (const bf16_t*)(p->ws + WS_OG); const float* lse = (const float*)(p->ws + WS_LSE); bf16_t* ob = (bf16_t*)(p->ws + WS_OB);
    for (int idx = gtid; idx < TP * 32; idx += gsz) { const int d8 = idx & 7, hh = (idx >> 3) & 3, tk = idx >> 5;
        const float l0 = lse[tk * 12 + hh], l1 = lse[tk * 12 + 4 + hh], l2 = lse[tk * 12 + 8 + hh];
        const float mx = fmaxf(l0, fmaxf(l1, l2)); float w0 = __expf(l0 - mx), w1 = __expf(l1 - mx), w2 = __expf(l2 - mx); const float inv = 1.f / (w0 + w1 + w2); w0 *= inv; w1 *= inv; w2 *= inv;
        f32x4 a0, b0, a1, b1, a2, b2;
        unpack8(*(const u32x4*)(og + (size_t)tk * 768 + hh * 64 + d8 * 8), a0, b0);
        unpack8(*(const u32x4*)(og + (size_t)tk * 768 + (4 + hh) * 64 + d8 * 8), a1, b1);
        unpack8(*(const u32x4*)(og + (size_t)tk * 768 + (8 + hh) * 64 + d8 * 8), a2, b2);
        *(u32x4*)(ob + (size_t)tk * 256 + hh * 64 + d8 * 8) = pack8(a0 * w0 + a1 * w1 + a2 * w2, b0 * w0 + b1 * w1 + b2 * w2); }
}

__device__ void dsw_sample(KP p, unsigned char* smem, int witem) {
    const int lane = threadIdx.x & 63, wid = threadIdx.x >> 6;
    float* qs = (float*)smem + wid * 256; float* ps = qs + 64;
    const int s = witem & 3, hh = (witem >> 2) & 3, db = witem >> 4, row = TP + db * 4 + s;
    const bf16_t* proj = (const bf16_t*)(p->ws + WS_PROJ);
    float rmx = -INFINITY, rws = 0.f; f32x4 racc = (f32x4){0.f, 0.f, 0.f, 0.f};
    const int ksl = lane >> 2, part = lane & 3, kq = lane >> 4, d4 = (lane & 15) * 4;
#pragma unroll 1
    for (int g = 0; g < 3; ++g) {
        const int W = 128 << (2 * g), dil = 1 << (2 * g);
        const float* cache = p->in[3 + g] + (size_t)db * W * 512 + hh * 64;
        const float* kvn = p->out + okvs(g) + (size_t)(db * W + W - 4) * 512 + hh * 64;
        qs[lane] = bf2f(proj[(size_t)row * NIN + C_DQ + (g * 4 + hh) * 64 + 2 * (lane & 31) + (lane >> 5)]);
        __builtin_amdgcn_wave_barrier();
        f32x4 q4[4];
#pragma unroll
        for (int c = 0; c < 4; ++c) q4[c] = *(const f32x4*)(qs + part * 16 + c * 4);
#pragma unroll 5
        for (int pi = 0; pi < 9; ++pi) { const int j = pi * 16 + ksl; float dot = 0.f;
            if (j <= 128) { const int idx = W + s - j * dil; const float* kr = (idx >= W ? kvn + (size_t)(idx - W) * 512 : cache + (size_t)idx * 512) + part * 16;
#pragma unroll
                for (int c = 0; c < 4; ++c) { const f32x4 k4 = *(const f32x4*)(kr + c * 4); dot += k4[0] * q4[c][0] + k4[1] * q4[c][1] + k4[2] * q4[c][2] + k4[3] * q4[c][3]; } }
            dot += __shfl_xor(dot, 1); dot += __shfl_xor(dot, 2);
            if (part == 0 && j <= 128) ps[j] = dot * 0.125f; }
        __builtin_amdgcn_wave_barrier();
        float sc[3]; float m = -INFINITY;
#pragma unroll
        for (int jj = 0; jj < 3; ++jj) { const int j = lane + 64 * jj; sc[jj] = j <= 128 ? ps[j] : -INFINITY; m = fmaxf(m, sc[jj]); }
#pragma unroll
        for (int o = 32; o >= 1; o >>= 1) m = fmaxf(m, __shfl_xor(m, o));
        float den = 0.f;
        __builtin_amdgcn_wave_barrier();
#pragma unroll
        for (int jj = 0; jj < 3; ++jj) { const int j = lane + 64 * jj; if (j <= 128) { const float e = __expf(sc[jj] - m); den += e; ps[j] = e; } }
#pragma unroll
        for (int o = 32; o >= 1; o >>= 1) den += __shfl_xor(den, o);
        __builtin_amdgcn_wave_barrier();
        f32x4 o = (f32x4){0.f, 0.f, 0.f, 0.f};
#pragma unroll 17
        for (int jt = 0; jt < 33; ++jt) { const int j = jt * 4 + kq;
            if (j <= 128) { const int idx = W + s - j * dil; const float* vr = (idx >= W ? kvn + (size_t)(idx - W) * 512 : cache + (size_t)idx * 512) + 256 + d4;
                o += *(const f32x4*)vr * ps[j]; } }
#pragma unroll
        for (int c = 0; c < 4; ++c) { o[c] += __shfl_xor(o[c], 16); o[c] += __shfl_xor(o[c], 32); }
        const float lg = m + __logf(den), nm = fmaxf(rmx, lg), sc_old = __expf(rmx - nm), wg = __expf(lg - nm);
        racc = racc * sc_old + o * (wg / den); rws = rws * sc_old + wg; rmx = nm;
        __builtin_amdgcn_wave_barrier();
    }
    if (lane < 16) { const float inv = 1.f / rws; u32x2 w; w.x = pk2(racc[0] * inv, racc[1] * inv); w.y = pk2(racc[2] * inv, racc[3] * inv);
        *(u32x2*)((bf16_t*)(p->ws + WS_OB) + (size_t)row * 256 + hh * 64 + d4) = w; }
}

constexpr unsigned NCH0 = 496, NCH1 = 2032, NCH2 = 8176, NCHUNK = NCH0 + NCH1 + NCH2;
__device__ __forceinline__ void half_where(KP p, unsigned c, const f32x4*& src, f32x4*& dst, unsigned& cl, unsigned& per) {
    if (c < NCH0) { src = (const f32x4*)p->in[3]; dst = (f32x4*)(p->out + O_KVS0); cl = c; per = 124u * 128u; }
    else if (c < NCH0 + NCH1) { src = (const f32x4*)p->in[4]; dst = (f32x4*)(p->out + O_KVS1); cl = c - NCH0; per = 508u * 128u; }
    else { src = (const f32x4*)p->in[5]; dst = (f32x4*)(p->out + O_KVS2); cl = c - NCH0 - NCH1; per = 2044u * 128u; }
}
#define HALF_LOAD(H, c) do { const f32x4* src_; f32x4* dst_; unsigned cl_, per_; half_where(p, (c), src_, dst_, cl_, per_); \
    const unsigned i0_ = cl_ * 4096u + threadIdx.x, db0_ = i0_ / per_, rem0_ = i0_ - db0_ * per_; \
    _Pragma("unroll") for (int u = 0; u < 8; ++u) { const unsigned rem_ = rem0_ + u * 512u; H##d[u] = i0_ + u * 512u + 512u * (db0_ + (rem_ >= per_ ? 1u : 0u)); H##v[u] = __builtin_nontemporal_load(src_ + H##d[u] + 512u); } } while (0)
#define HALF_STORE(H, c) do { const f32x4* src_; f32x4* dst_; unsigned cl_, per_; half_where(p, (c), src_, dst_, cl_, per_); \
    _Pragma("unroll") for (int u = 0; u < 8; ++u) __builtin_nontemporal_store(H##v[u], dst_ + H##d[u]); } while (0)
__device__ __forceinline__ unsigned copier_claim(unsigned* ctl, int done_slot, unsigned need) {
    const bool stop = need != 0u && __hip_atomic_load(ctl + 32 * done_slot, __ATOMIC_RELAXED, __HIP_MEMORY_SCOPE_AGENT) >= need;
    return stop ? 0xffffffffu : __hip_atomic_fetch_add(ctl, 1u, __ATOMIC_RELAXED, __HIP_MEMORY_SCOPE_AGENT);
}
__device__ void copier(KP p, int done_slot, unsigned need, unsigned char* smem) {
    unsigned* ctl = (unsigned*)(p->ws + WS_CTL); volatile unsigned* sh = (volatile unsigned*)smem;
    f32x4 Av[8], Bv[8]; unsigned Ad[8], Bd[8];
    __syncthreads();
    if (threadIdx.x == 0) sh[0] = copier_claim(ctl, done_slot, need);
    __syncthreads();
    unsigned ca = sh[0];
    if (ca >= NCHUNK) return;
    HALF_LOAD(A, ca);
    for (;;) {
        __syncthreads();
        if (threadIdx.x == 0) sh[0] = copier_claim(ctl, done_slot, need);
        __syncthreads();
        const unsigned cb = sh[0];
        if (cb < NCHUNK) HALF_LOAD(B, cb);
        HALF_STORE(A, ca);
        if (cb >= NCHUNK) break;
        __syncthreads();
        if (threadIdx.x == 0) sh[0] = copier_claim(ctl, done_slot, need);
        __syncthreads();
        ca = sh[0];
        if (ca < NCHUNK) HALF_LOAD(A, ca);
        HALF_STORE(B, cb);
        if (ca >= NCHUNK) break;
    }
}
__device__ __forceinline__ void gemm_done(KP p, int done_slot) {
    __syncthreads();
    if (threadIdx.x == 0) __hip_atomic_fetch_add((unsigned*)(p->ws + WS_CTL) + 32 * done_slot, 1u, __ATOMIC_RELAXED, __HIP_MEMORY_SCOPE_AGENT);
}

__global__ void __launch_bounds__(512) fwd(Params pv) {
    extern __shared__ __attribute__((aligned(16))) unsigned char smem[];
    cg::grid_group grid = cg::this_grid();
    const int G = gridDim.x, bid = blockIdx.x;
    constexpr int C3 = 8, C10 = 8, CN = 120;
#define WSP(T, off) ((T*)(p->ws + (off)))
    if (threadIdx.x < 4) ((volatile LAS unsigned*)(smem + 131072))[threadIdx.x] = 0u;
    __syncthreads();
    const XcdBarrier xbar = xcd_barrier_post((unsigned*)(pv.ws + WS_BAR), (volatile LAS unsigned*)(smem + 131072));
    if (pv.ws == nullptr) grid.sync();
    { KP p = kargs(); if (PHMASK & 1) phase_prep(p, smem); }
    xcd_barrier(xbar);
    { KP p = kargs(); if (bid < 24) { run_gemm(smem, WSP(const bf16_t, WS_SC), WSP(const bf16_t, WS_WADA), 256, NADA, D, FMod{WSP(float, WS_MOD), p->in[11]}, 24, bid); gemm_done(p, 1); } else copier(p, 1, 1u, smem); }
    xcd_barrier(xbar);
    { KP p = kargs(); if (PHMASK & 4) phase_norm(p->in[0], p->in[1], p->in[8], WSP(const float, WS_MOD), 0, 1, WSP(bf16_t, WS_H), nullptr, 0, nullptr); }
    xcd_barrier(xbar);
    { KP p = kargs(); if (bid >= C3) {
        LAS float* lb = (LAS float*)(smem + LDS_XTRA);
        for (int i = threadIdx.x; i < NIN + 32; i += 512) { float v;
            if (i < NIN) v = WSP(const float, WS_BIN)[i];
            else { double inv = 1.0; for (int q = 0; q < i - NIN; ++q) inv *= 0.74989420933245582730; v = (float)inv; }
            lb[i] = v; }
        __syncthreads();
        run_gemm(smem, WSP(const bf16_t, WS_H), WSP(const bf16_t, WS_WIN), M, NIN, D, FIn{WSP(bf16_t, WS_PROJ), WSP(float, WS_GLR), lb, p->out}, G - C3, bid - C3); gemm_done(p, 2); } else copier(p, 2, 5u, smem); }
    xcd_barrier(xbar);
    { KP p = kargs();
      unsigned* qctr = (unsigned*)(p->ws + WS_CTL) + 32 * 7; volatile unsigned* shq = (volatile unsigned*)(smem + 131072 + 8);
      for (;;) {
          __syncthreads();
          if (threadIdx.x == 0) shq[0] = __hip_atomic_fetch_add(qctr, 1u, __ATOMIC_RELAXED, __HIP_MEMORY_SCOPE_AGENT);
          __syncthreads();
          const int k = (int)shq[0]; if (k >= 3328) break;
          const int q = k / 13, r = k - q * 13;
          if ((r & 3) == 0 && r < 12) { const int si = 3 * q + (r >> 2);
              if (si < 256) dsw_sample(p, smem, si * 8 + (int)(threadIdx.x >> 6)); else gla_sample(p, smem, si - 256); }
          else { const int pi = 10 * q + r - ((r + 3) >> 2);
              if (pi < 1536) dsw_prompt(p, smem, pi); else gla_passA(p, smem, pi - 1536); }
      } }
    xcd_barrier(xbar);
    { KP p = kargs(); if (PHMASK & 512) gla_passB(p); }
    { KP p = kargs(); if (PHMASK & 1024) dsw_combine(p); }
    xcd_barrier(xbar);
    { KP p = kargs(); if (PHMASK & 2048) for (int it = bid; it < 1024; it += G) gla_passC(p, smem, it); }
    xcd_barrier(xbar);
    { KP p = kargs(); if (bid >= CN) { run_gemm(smem, WSP(const bf16_t, WS_OA), WSP(const bf16_t, WS_WPA), M, D, D, FPa{WSP(bf16_t, WS_MG), WSP(const bf16_t, WS_PROJ)}, G - CN, bid - CN); } }
    { KP p = kargs(); if (bid >= CN) { run_gemm(smem, WSP(const bf16_t, WS_OB), WSP(const bf16_t, WS_WPB), M, D, 256, FPb{WSP(bf16_t, WS_MG), WSP(const bf16_t, WS_PROJ)}, G - CN, bid - CN); gemm_done(p, 3); } else copier(p, 3, 9u, smem); }
    xcd_barrier(xbar);
    { KP p = kargs(); if (bid >= CN) { run_gemm_g(smem, WSP(const bf16_t, WS_MG), WSP(const bf16_t, WS_WOUT), M, D, D, FOut{WSP(bf16_t, WS_X1), p->in[0], p->in[1], WSP(const float, WS_MOD)}, G - CN, bid - CN); gemm_done(p, 4); } else copier(p, 4, 9u, smem); }
    xcd_barrier(xbar);
    { KP p = kargs(); if (PHMASK & 32768) phase_norm(nullptr, nullptr, p->in[9], WSP(const float, WS_MOD), 3, 4, WSP(bf16_t, WS_H), nullptr, 0, WSP(const bf16_t, WS_X1)); }
    xcd_barrier(xbar);
    { KP p = kargs(); if (bid >= C10) { run_gemm(smem, WSP(const bf16_t, WS_H), WSP(const bf16_t, WS_WUP), M, NUP, D, FUp{WSP(bf16_t, WS_ACT)}, G - C10, bid - C10); gemm_done(p, 5); } else copier(p, 5, 37u, smem); }
    xcd_barrier(xbar);
    { KP p = kargs(); if (bid >= CN) { run_gemm_g(smem, WSP(const bf16_t, WS_ACT), WSP(const bf16_t, WS_WDN), M, D, DFF, FDown{WSP(bf16_t, WS_X1), WSP(const float, WS_MOD)}, G - CN, bid - CN); gemm_done(p, 6); } else copier(p, 6, 9u, smem); }
    xcd_barrier(xbar);
    { KP p = kargs(); if (PHMASK & 262144) phase_norm(nullptr, nullptr, p->in[22], WSP(const float, WS_MOD), 0, 0, nullptr, p->out + O_Y, 1, WSP(const bf16_t, WS_X1));
      copier(p, 0, 0u, smem); }
#undef WSP
}
}

extern "C" void kernel_launch(void* const* d_in, const int* in_sizes, int n_in, void* d_out, int out_size, void* d_ws, size_t ws_size, hipStream_t stream) {
    static int grid = 0;
    if (grid == 0) {
        int dev = 0, cus = 0, per_cu = 0;
        hipGetDevice(&dev);
        hipDeviceGetAttribute(&cus, hipDeviceAttributeMultiprocessorCount, dev);
        if (hipFuncSetAttribute((const void*)mk::fwd, hipFuncAttributeMaxDynamicSharedMemorySize, mk::LDS_BYTES) != hipSuccess) fprintf(stderr, "kernel_launch: hipFuncSetAttribute failed\n");
        if (hipOccupancyMaxActiveBlocksPerMultiprocessor(&per_cu, (const void*)mk::fwd, 512, mk::LDS_BYTES) != hipSuccess || per_cu < 1) { fprintf(stderr, "kernel_launch: occupancy query says %d blocks per CU\n", per_cu); per_cu = 1; }
        (void)hipGetLastError();
        grid = cus > 0 ? cus : 256;
        if (n_in != 23 || (size_t)out_size != mk::O_END || ws_size < mk::WS_END) fprintf(stderr, "kernel_launch: unexpected sizes n_in %d out %d ws %zu (need %zu)\n", n_in, out_size, ws_size, (size_t)mk::WS_END);
    }
    if (hipMemsetAsync((char*)d_ws + mk::WS_CTL, 0, 4096 + 16384, stream) != hipSuccess) fprintf(stderr, "kernel_launch: memset of control words failed\n");
    mk::Params p{};
    for (int i = 0; i < 23; ++i) p.in[i] = (const float*)d_in[i];
    p.out = (float*)d_out; p.ws = (unsigned char*)d_ws;
    void* args[] = {&p};
    hipError_t e = hipLaunchCooperativeKernel((const void*)mk::fwd, dim3(grid), dim3(512), args, mk::LDS_BYTES, stream);
    if (e != hipSuccess) fprintf(stderr, "cooperative launch failed: %s (grid %d)\n", hipGetErrorString(e), grid);
}
```

```cpp
#include <hip/hip_runtime.h>
#include <hip/hip_cooperative_groups.h>
#include <cstdio>
namespace cg = cooperative_groups;
namespace pg8 {
#define PG8_LAS __attribute__((address_space(3)))
typedef unsigned short bf16_t;
typedef short bf16x8 __attribute__((ext_vector_type(8)));
typedef float f32x4 __attribute__((ext_vector_type(4)));
typedef unsigned u32x4 __attribute__((ext_vector_type(4)));
constexpr int BM = 256, BK = 64, HALF = 128, HTB = HALF * BK * 2  , STAGE_BYTES = 8 * HTB, NXCD = 8, WGM = 8;

__host__ __device__ __forceinline__ int lds_byte(int r, int c) { const int st = (r >> 4) * 2 + (c >> 5), rr = r & 15, cc = c & 31, ob = rr * 64 + cc * 2; return st * 1024 + (ob ^ (((ob >> 9) & 1) << 5)); }
__host__ __device__ __forceinline__ void stage_rc(int b, int& R, int& C) { const int st = b / 1024, sb = b % 1024, swz = sb ^ (((sb >> 9) & 1) << 5); R = (st >> 1) * 16 + swz / 64; C = (st & 1) * 32 + (swz % 64) / 2; }
__host__ __device__ __forceinline__ int perm32(int rho) { const int n = rho >> 4, i = rho & 15; return 8 * (i >> 2) + 4 * n + (i & 3); }

struct Unit { int pm, pn; };
struct Gemm { const bf16_t* A; const bf16_t* Bt; int M, N, K; };

struct StaticOrder {
    int nM, nN, nwg, G, c;
    __host__ __device__ void init(int M, int N, int G_, int c_) { nM = M / BM; nN = N / BM; nwg = nM * nN; G = G_; c = c_; }
    __host__ __device__ bool next(int i, Unit& u) const {
        const long L = (long)i * G + c; if (L >= nwg) return false;
        int wgid = (int)L; { const int q = nwg / NXCD, r = nwg % NXCD, xcd = wgid % NXCD, off = wgid / NXCD; wgid = (xcd < r ? xcd * (q + 1) : r * (q + 1) + (xcd - r) * q) + off; }
        const int nig = WGM * nN, gid = wgid / nig, fm = gid * WGM, gsz = (nM - fm) < WGM ? (nM - fm) : WGM;
        u.pm = fm + ((wgid % nig) % gsz); u.pn = (wgid % nig) / gsz; return true;
    }
    __device__ __forceinline__ void a_ready(const Unit&) const {}
    __device__ __forceinline__ void done(const Unit&) const {}
};
__device__ __forceinline__ unsigned cvt_pk_bf16(float lo, float hi) { unsigned r; asm volatile("v_cvt_pk_bf16_f32 %0, %1, %2" : "=v"(r) : "v"(lo), "v"(hi)); return r; }
typedef float f32x2 __attribute__((ext_vector_type(2)));
template <class Epi, class Sched, bool STAMP = false>
__device__ __forceinline__ void gemm_phase(PG8_LAS unsigned char* lds, const Gemm g, const Sched& S, const Epi& E, unsigned long long* stamps) {
    const int tid = threadIdx.x, wid = __builtin_amdgcn_readfirstlane(tid >> 6), lane = tid & 63, wr = wid >> 2, wc = wid & 3, fr = lane & 15, fq = lane >> 4;
    const int K = g.K, nt = K / BK;
    int ts_lo = 0, ts_hi = 0, nts = 0; const unsigned long long rt_entry = STAMP ? (unsigned long long)wall_clock64() : 0ull;
#define PG8_STAMP() do { if (STAMP && wid == 0 && nts < 64) { const unsigned long long _c = (unsigned long long)clock64(); \
        ts_lo = (lane == nts) ? (int)(unsigned)_c : ts_lo; ts_hi = (lane == nts) ? (int)(unsigned)(_c >> 32) : ts_hi; ++nts; } } while (0)
    PG8_STAMP();
    unsigned voffA[2], voffB[2];
#pragma unroll
    for (int i = 0; i < 2; ++i) { int R, C; stage_rc(tid * 16 + i * 8192, R, C); const int Rb = Epi::PERM ? ((R & ~31) + perm32(R & 31)) : R;
        voffA[i] = (unsigned)(R * K + C) * 2u; voffB[i] = (unsigned)(Rb * K + C) * 2u; }
    const size_t kstep = (size_t)(BK * 2);
    const size_t hstep = (size_t)HALF * K * 2;
    const size_t tstep = 2 * hstep;
    const unsigned ldsw = (unsigned)wid * 1024u;
    const int aoff = lds_byte(wr * 64 + fr, fq * 8), boff = lds_byte(wc * 32 + fr, fq * 8);
#define PG8_SA(b, h) (((b) * 2 + (h)) * HTB)
#define PG8_SB(b, h) ((4 + (b) * 2 + (h)) * HTB)
#define PG8_STAGE(bufoff, gbase, voff) do { _Pragma("unroll") for (int _i = 0; _i < 2; ++_i) \
        __builtin_amdgcn_global_load_lds((const unsigned*)((const char*)(gbase) + (voff)[_i]), (PG8_LAS unsigned*)(lds + (bufoff) + ldsw + _i * 8192), 16, 0, 0); } while (0)
#define PG8_LDA(dst, b, h) do { _Pragma("unroll") for (int m = 0; m < 4; ++m) _Pragma("unroll") for (int k = 0; k < 2; ++k) dst[m][k] = *(const PG8_LAS bf16x8*)(lds + PG8_SA(b, h) + aoff + m * 2048 + k * 1024); } while (0)
#define PG8_LDB(dst, b, h) do { _Pragma("unroll") for (int n = 0; n < 2; ++n) _Pragma("unroll") for (int k = 0; k < 2; ++k) dst[n][k] = *(const PG8_LAS bf16x8*)(lds + PG8_SB(b, h) + boff + n * 2048 + k * 1024); } while (0)
#define PG8_MMA(ai, bj, At, Bt) do { __builtin_amdgcn_s_setprio(1); _Pragma("unroll") for (int m = 0; m < 4; ++m) _Pragma("unroll") for (int n = 0; n < 2; ++n) _Pragma("unroll") for (int k = 0; k < 2; ++k) \
        acc[ai][bj][m][n] = __builtin_amdgcn_mfma_f32_16x16x32_bf16(Bt[n][k], At[m][k], acc[ai][bj][m][n], 0, 0, 0); __builtin_amdgcn_s_setprio(0); } while (0)
#define PG8_WAIT_V(n) asm volatile("s_waitcnt vmcnt(" #n ")" ::: "memory")
#define PG8_WAIT_L(n) asm volatile("s_waitcnt lgkmcnt(" #n ")" ::: "memory")
#define PG8_BAR __builtin_amdgcn_s_barrier()
#define PG8_SCHED __builtin_amdgcn_sched_barrier(0)
    Unit cur, nxt; int ui = 0;
    if (!S.next(0, cur)) return;
    f32x4 acc[2][2][4][2];
#pragma unroll
    for (int a = 0; a < 2; ++a)
#pragma unroll
        for (int b = 0; b < 2; ++b)
#pragma unroll
            for (int m = 0; m < 4; ++m)
#pragma unroll
                for (int n = 0; n < 2; ++n) acc[a][b][m][n] = (f32x4){0.f, 0.f, 0.f, 0.f};
    bf16x8 At[4][2], B0[2][2], B1[2][2];
    const char* cA = (const char*)g.A + (size_t)cur.pm * tstep; const char* cB = (const char*)g.Bt + (size_t)cur.pn * tstep;
    S.a_ready(cur);
    PG8_STAGE(PG8_SB(0, 0), cB, voffB); PG8_STAGE(PG8_SA(0, 0), cA, voffA); PG8_STAGE(PG8_SB(0, 1), cB + hstep, voffB); PG8_STAGE(PG8_SA(0, 1), cA + hstep, voffA);
    if (wr == 1) PG8_BAR;
    PG8_WAIT_V(4); PG8_BAR;
    PG8_STAGE(PG8_SB(1, 0), cB + kstep, voffB); PG8_STAGE(PG8_SA(1, 0), cA + kstep, voffA); PG8_STAGE(PG8_SB(1, 1), cB + hstep + kstep, voffB);
    PG8_WAIT_V(6); PG8_BAR;
    PG8_STAMP();
    for (;;) {
        const bool has_next = S.next(ui + 1, nxt);
        const char* nA = has_next ? (const char*)g.A + (size_t)nxt.pm * tstep : cA; const char* nB = has_next ? (const char*)g.Bt + (size_t)nxt.pn * tstep : cB;
        for (int t = 0; t < nt; t += 2) {
            const bool last = (t == nt - 2);
            const char* a1 = cA + (size_t)(t + 1) * kstep;
            const char* a2 = last ? nA : cA + (size_t)(t + 2) * kstep; const char* b2 = last ? nB : cB + (size_t)(t + 2) * kstep;
            const char* a3 = a2 + kstep; const char* b3 = b2 + kstep;
            if (last && has_next) S.a_ready(nxt);
            PG8_LDB(B0, 0, 0); PG8_SCHED; PG8_LDA(At, 0, 0); PG8_STAGE(PG8_SA(1, 1), a1 + hstep, voffA);
            PG8_WAIT_L(8); PG8_BAR; PG8_WAIT_L(0); PG8_MMA(0, 0, At, B0); PG8_BAR; PG8_SCHED;
            PG8_LDB(B1, 0, 1); PG8_STAGE(PG8_SB(0, 0), b2, voffB);
            PG8_BAR; PG8_WAIT_L(0); PG8_MMA(0, 1, At, B1); PG8_BAR;
            PG8_LDA(At, 0, 1); PG8_STAGE(PG8_SA(0, 0), a2, voffA);
            PG8_BAR; PG8_WAIT_L(0); PG8_MMA(1, 0, At, B0); PG8_BAR; PG8_SCHED;
            PG8_STAGE(PG8_SB(0, 1), b2 + hstep, voffB);
            PG8_WAIT_V(6); PG8_BAR; PG8_MMA(1, 1, At, B1); PG8_BAR;
            PG8_LDB(B0, 1, 0); PG8_SCHED; PG8_LDA(At, 1, 0); PG8_STAGE(PG8_SA(0, 1), a2 + hstep, voffA);
            PG8_WAIT_L(8); PG8_BAR; PG8_WAIT_L(0); PG8_MMA(0, 0, At, B0); PG8_BAR; PG8_SCHED;
            PG8_LDB(B1, 1, 1); PG8_STAGE(PG8_SB(1, 0), b3, voffB);
            PG8_BAR; PG8_WAIT_L(0); PG8_MMA(0, 1, At, B1); PG8_BAR;
            PG8_LDA(At, 1, 1); PG8_STAGE(PG8_SA(1, 0), a3, voffA);
            PG8_BAR; PG8_WAIT_L(0); PG8_MMA(1, 0, At, B0); PG8_BAR; PG8_SCHED;
            PG8_STAGE(PG8_SB(1, 1), b3 + hstep, voffB);
            PG8_WAIT_V(6); PG8_BAR; PG8_MMA(1, 1, At, B1); PG8_BAR;
        }
        PG8_STAMP();
        if constexpr (!Epi::AFTER_DRAIN) { E(acc, cur, wr, wc, fr, fq); S.done(cur); }
        PG8_STAMP();
        if (!has_next) break;
#pragma unroll
        for (int a = 0; a < 2; ++a)
#pragma unroll
            for (int b = 0; b < 2; ++b)
#pragma unroll
                for (int m = 0; m < 4; ++m)
#pragma unroll
                    for (int n = 0; n < 2; ++n) acc[a][b][m][n] = (f32x4){0.f, 0.f, 0.f, 0.f};
        cur = nxt; cA = nA; cB = nB; ++ui;
    }
    PG8_WAIT_V(0);
    if (wr == 0) PG8_BAR;
    PG8_BAR;
    if constexpr (Epi::AFTER_DRAIN) { E.fused(acc, cur, wr, wc, fr, fq, lds, wid, lane); S.done(cur); }
    PG8_STAMP();
    if (STAMP && wid == 0) { stamps[lane] = lane < nts ? (((unsigned long long)(unsigned)ts_hi << 32) | (unsigned)ts_lo) : 0ull;
        if (lane == 62) stamps[62] = rt_entry; if (lane == 63) stamps[63] = (unsigned long long)wall_clock64(); }
#undef PG8_STAMP
#undef PG8_SA
#undef PG8_SB
#undef PG8_STAGE
#undef PG8_LDA
#undef PG8_LDB
#undef PG8_MMA
#undef PG8_WAIT_V
#undef PG8_WAIT_L
#undef PG8_BAR
#undef PG8_SCHED
}
}

#define XB_TMO      128
#define XB_XCNT(j)  (256  + 64 * (j))
#define XB_XSUB(j)  (1280 + 64 * (j))
#define XB_XGEN(j)  (2304 + 64 * (j))
#define XB_TOP      3328
#define XB_TOPGEN   3392
#define XCD_BAR_WORDS 3456
#define XB_SPIN_CAP (1u << 18)
#define LAS __attribute__((address_space(3)))

__device__ __forceinline__ unsigned xb_ld(unsigned* p)              { return __hip_atomic_load(p, __ATOMIC_RELAXED, __HIP_MEMORY_SCOPE_AGENT); }
__device__ __forceinline__ unsigned xb_add(unsigned* p, unsigned v) { return __hip_atomic_fetch_add(p, v, __ATOMIC_RELAXED, __HIP_MEMORY_SCOPE_AGENT); }
__device__ __forceinline__ unsigned xb_xcc_id() { return (unsigned)__builtin_amdgcn_s_getreg((3 << 11) | 20) & 0xFu; }
#define XB_SPIN(cond, bar) do { unsigned _sp = 0; while (cond) { __builtin_amdgcn_s_sleep(1); \
    if ((++_sp & 255u) == 0u) { if (xb_ld(&(bar)[XB_TMO])) break; if (_sp > XB_SPIN_CAP) { atomicAdd(&(bar)[XB_TMO], 1u); break; } } } } while (0)

struct XcdBarrier {
    unsigned* bar; unsigned x;
    volatile LAS unsigned* st;
};

__device__ __forceinline__ XcdBarrier xcd_barrier_post(unsigned* bar, volatile LAS unsigned* st) {
    XcdBarrier b; b.bar = bar; b.x = xb_xcc_id(); b.st = st;
    if (threadIdx.x == 0) (void)xb_add(&bar[XB_XCNT(b.x)], 1u);
    return b;
}
__device__ __forceinline__ void xcd_barrier_complete(unsigned* bar, unsigned x, unsigned& nloc, unsigned& nx) {
    const unsigned G = gridDim.x * gridDim.y * gridDim.z;
    unsigned sum, cnt, mine, sp = 0u;
    for (;;) {
        sum = 0u; cnt = 0u; mine = 0u;
#pragma unroll
        for (unsigned j = 0; j < 16; ++j) { const unsigned c = xb_ld(&bar[XB_XCNT(j)]); sum += c; cnt += (c > 0u) ? 1u : 0u; mine = (j == x) ? c : mine; }
        if (sum == G) break;
        __builtin_amdgcn_s_sleep(1);
        if ((++sp & 255u) == 0u) { if (xb_ld(&bar[XB_TMO])) break; if (sp > XB_SPIN_CAP) { atomicAdd(&bar[XB_TMO], 1u); break; } }
    }
    nloc = mine > 0u ? mine : 1u; nx = cnt > 0u ? cnt : 1u;
}

__device__ __forceinline__ void xcd_barrier(const XcdBarrier& b) {
    asm volatile("s_waitcnt vmcnt(0)" ::: "memory");
    __syncthreads();
    if (threadIdx.x == 0) {
        unsigned* bar = b.bar;
        __builtin_amdgcn_s_waitcnt(0);
        unsigned nloc = b.st[0], nx = b.st[1];
        if (nloc == 0u) { xcd_barrier_complete(bar, b.x, nloc, nx); b.st[0] = nloc; b.st[1] = nx; }
        const unsigned old = xb_add(&bar[XB_XSUB(b.x)], 1u);
        const unsigned gen = old / nloc;
        if (old + 1u == (gen + 1u) * nloc) {
            __builtin_amdgcn_fence(__ATOMIC_RELEASE, "agent");
            asm volatile("s_waitcnt vmcnt(0)" ::: "memory");
            const unsigned og = xb_add(&bar[XB_TOP], 1u);
            const unsigned tg = og / nx;
            if (og + 1u == (tg + 1u) * nx) xb_add(&bar[XB_TOPGEN], 1u);
            else XB_SPIN(xb_ld(&bar[XB_TOPGEN]) == tg, bar);
            __builtin_amdgcn_fence(__ATOMIC_ACQUIRE, "agent");
            xb_add(&bar[XB_XGEN(b.x)], 1u);
            asm volatile("s_waitcnt vmcnt(0)" ::: "memory");
        } else {
            XB_SPIN(xb_ld(&bar[XB_XGEN(b.x)]) == gen, bar);
            __builtin_amdgcn_fence(__ATOMIC_ACQUIRE, "agent");
            asm volatile("s_waitcnt vmcnt(0)" ::: "memory");
        }
    }
    __syncthreads();
}

#ifndef PHMASK
#define PHMASK 0x7FFFF
#endif
namespace mk {
using pg8::bf16_t; using pg8::bf16x8; using pg8::f32x4; using pg8::u32x4;
typedef unsigned u32x2 __attribute__((ext_vector_type(2)));
typedef float f32x2 __attribute__((ext_vector_type(2)));

constexpr int D = 1024, T = 4096, NB = 4, TP = NB * T, DBATCH = 128, SS = 4, TS = DBATCH * SS, M = TP + TS;
constexpr int NIN = 7680, NADA = 6144, NUP = 5632, DFF = 2816;
constexpr int C_GQ = 0, C_GK = 512, C_GV = 1024, C_GR = 2048, C_DQ = 3072, C_DK = 3840, C_DV = 4608, C_GA = 5376, C_GB = 6400, C_GLR = 7424, C_END = 7440;
constexpr int LDS_XTRA = 131072 + 16;
constexpr int LDS_BYTES = LDS_XTRA + (7680 + 32) * 4;
constexpr float EPS = 1e-6f;

constexpr size_t al(size_t x) { return (x + 255) & ~(size_t)255; }
constexpr size_t WS_WADA = 0;
constexpr size_t WS_WIN = WS_WADA + al((size_t)NADA * D * 2);
constexpr size_t WS_WPA = WS_WIN + al((size_t)NIN * D * 2);
constexpr size_t WS_WPB = WS_WPA + al((size_t)D * D * 2);
constexpr size_t WS_WOUT = WS_WPB + al((size_t)D * 256 * 2);
constexpr size_t WS_WUP = WS_WOUT + al((size_t)D * D * 2);
constexpr size_t WS_WDN = WS_WUP + al((size_t)NUP * D * 2);
constexpr size_t WS_BIN = WS_WDN + al((size_t)D * DFF * 2);
constexpr size_t WS_SC = WS_BIN + al((size_t)NIN * 4);
constexpr size_t WS_ROPE = WS_SC + al((size_t)256 * D * 2);
constexpr size_t WS_MOD = WS_ROPE + al((size_t)4100 * 32 * 8);
constexpr size_t WS_H = WS_MOD + al((size_t)256 * NADA * 4);
constexpr size_t WS_PROJ = WS_H + al((size_t)M * D * 2);
constexpr size_t WS_GLR = WS_PROJ + al((size_t)M * NIN * 2);
constexpr size_t WS_U = WS_GLR + al((size_t)M * 16 * 4);
constexpr size_t WS_DEC = WS_U + al((size_t)1024 * 32768 * 4);
constexpr size_t WS_SST = WS_DEC + al((size_t)1024 * 128 * 4);
constexpr size_t WS_OG = WS_SST + al((size_t)1024 * 32768 * 2);
constexpr size_t WS_LSE = WS_OG + al((size_t)TP * 768 * 2);
constexpr size_t WS_OA = WS_LSE + al((size_t)TP * 12 * 4);
constexpr size_t WS_OB = WS_OA + al((size_t)M * D * 2);
constexpr size_t WS_MG = WS_OB + al((size_t)M * 256 * 2);
constexpr size_t WS_X1 = WS_MG + al((size_t)M * D * 2);
constexpr size_t WS_ACT = WS_X1 + al((size_t)M * D * 4);
constexpr size_t WS_CTL = WS_ACT + al((size_t)M * DFF * 2);
constexpr size_t WS_BAR = WS_CTL + 4096;
constexpr size_t WS_END = WS_BAR + 16384;

constexpr size_t O_Y = 0;
constexpr size_t O_SGP = O_Y + (size_t)M * D;
constexpr size_t O_KVP0 = O_SGP + (size_t)4 * 4 * 128 * 256;
constexpr size_t O_KVP1 = O_KVP0 + (size_t)4 * 128 * 512;
constexpr size_t O_KVP2 = O_KVP1 + (size_t)4 * 512 * 512;
constexpr size_t O_SGS = O_KVP2 + (size_t)4 * 2048 * 512;
constexpr size_t O_KVS0 = O_SGS + (size_t)128 * 4 * 128 * 256;
constexpr size_t O_KVS1 = O_KVS0 + (size_t)128 * 128 * 512;
constexpr size_t O_KVS2 = O_KVS1 + (size_t)128 * 512 * 512;
constexpr size_t O_END = O_KVS2 + (size_t)128 * 2048 * 512;

struct Params { const float* in[23]; float* out; unsigned char* ws; };
typedef const __attribute__((address_space(4))) Params* KP;
__device__ __forceinline__ KP kargs() { KP k = (KP)__builtin_amdgcn_kernarg_segment_ptr(); asm volatile("" : "+s"(k)); return k; }

__device__ __forceinline__ float bf2f(unsigned short b) { return __uint_as_float(((unsigned)b) << 16); }
__device__ __forceinline__ unsigned short f2bf(float f) { unsigned u = __float_as_uint(f); u += 0x7FFFu + ((u >> 16) & 1u); return (unsigned short)(u >> 16); }
__device__ __forceinline__ unsigned pk2(float lo, float hi) { unsigned r; asm("v_cvt_pk_bf16_f32 %0, %1, %2" : "=v"(r) : "v"(lo), "v"(hi)); return r; }
__device__ __forceinline__ float silu_f(float x) { return x * __builtin_amdgcn_rcpf(1.f + __expf(-x)); }
__device__ __forceinline__ float sigm_f(float x) { return __builtin_amdgcn_rcpf(1.f + __expf(-x)); }
__device__ __forceinline__ int brow_of(int row) { return row < TP ? (row >> 12) : 4 + ((row - TP) >> 2); }
__device__ __forceinline__ size_t okvp(int g) { return g == 0 ? O_KVP0 : (g == 1 ? O_KVP1 : O_KVP2); }
__device__ __forceinline__ size_t okvs(int g) { return g == 0 ? O_KVS0 : (g == 1 ? O_KVS1 : O_KVS2); }
__device__ __forceinline__ f32x4 mfma16(bf16x8 a, bf16x8 b, f32x4 c) { return __builtin_amdgcn_mfma_f32_16x16x32_bf16(a, b, c, 0, 0, 0); }
__device__ __forceinline__ u32x4 pack8(f32x4 a, f32x4 b) { u32x4 w; w.x = pk2(a[0], a[1]); w.y = pk2(a[2], a[3]); w.z = pk2(b[0], b[1]); w.w = pk2(b[2], b[3]); return w; }
__device__ __forceinline__ void unpack8(u32x4 w, f32x4& a, f32x4& b) {
    a[0] = __uint_as_float(w.x << 16); a[1] = __uint_as_float(w.x & 0xffff0000u); a[2] = __uint_as_float(w.y << 16); a[3] = __uint_as_float(w.y & 0xffff0000u);
    b[0] = __uint_as_float(w.z << 16); b[1] = __uint_as_float(w.z & 0xffff0000u); b[2] = __uint_as_float(w.w << 16); b[3] = __uint_as_float(w.w & 0xffff0000u); }

__device__ __forceinline__ int map_in(int n) {
    if (n < 3072) return n;
    if (n < C_DV) { const int isK = n >= C_DK; const int j = n - (isK ? C_DK : C_DQ); const int head = j >> 6, p = j & 63; return (isK ? 3856 : 3088) + head * 64 + (p >> 1) + 32 * (p & 1); }
    if (n < C_GA) return 4624 + (n - C_DV);
    if (n < C_GB) return 5392 + (n - C_GA);
    if (n < C_GLR) return 6416 + (n - C_GB);
    if (n < C_END) return 3072 + (n - C_GLR);
    return -1;
}
__device__ __forceinline__ int map_up(int n) { const int q = n >> 3, e = n & 7; return e < 4 ? 4 * q + e : DFF + 4 * q + e - 4; }

__device__ __forceinline__ void tr_tile(const float* __restrict__ W, int ldw, bf16_t* __restrict__ Bt, int K, int n0, int k0, int mapid, unsigned char* smem) {
    unsigned short* t = (unsigned short*)smem;
    const int tid = threadIdx.x, lane = tid & 63, w8 = tid >> 6;
    const int n = n0 + lane; const int src = mapid == 0 ? n : (mapid == 1 ? map_in(n) : map_up(n));
#pragma unroll
    for (int j = 0; j < 8; ++j) { const int kk = w8 + 8 * j; const float v = src >= 0 ? W[(size_t)(k0 + kk) * ldw + src] : 0.f; t[kk * 66 + lane] = f2bf(v); }
    __syncthreads();
#pragma unroll
    for (int j = 0; j < 8; ++j) { const int nn = w8 + 8 * j; Bt[(size_t)(n0 + nn) * K + k0 + lane] = t[lane * 66 + nn]; }
    __syncthreads();
}

__device__ void phase_prep(KP p, unsigned char* smem) {
    const int G = gridDim.x;
    for (int ti = blockIdx.x; ti < 6144; ti += G) {
        const float* W; int ldw, K, kT, mapid, base; bf16_t* Bt;
        if (ti < 1536)      { W = p->in[10]; ldw = NADA; K = D;   kT = 16; mapid = 0; base = 0;    Bt = (bf16_t*)(p->ws + WS_WADA); }
        else if (ti < 3456) { W = p->in[12]; ldw = 7440; K = D;   kT = 16; mapid = 1; base = 1536; Bt = (bf16_t*)(p->ws + WS_WIN); }
        else if (ti < 3712) { W = p->in[17]; ldw = D;    K = D;   kT = 16; mapid = 0; base = 3456; Bt = (bf16_t*)(p->ws + WS_WPA); }
        else if (ti < 3776) { W = p->in[18]; ldw = D;    K = 256; kT = 4;  mapid = 0; base = 3712; Bt = (bf16_t*)(p->ws + WS_WPB); }
        else if (ti < 4032) { W = p->in[19]; ldw = D;    K = D;   kT = 16; mapid = 0; base = 3776; Bt = (bf16_t*)(p->ws + WS_WOUT); }
        else if (ti < 5440) { W = p->in[20]; ldw = NUP;  K = D;   kT = 16; mapid = 2; base = 4032; Bt = (bf16_t*)(p->ws + WS_WUP); }
        else                { W = p->in[21]; ldw = D;    K = DFF; kT = 44; mapid = 0; base = 5440; Bt = (bf16_t*)(p->ws + WS_WDN); }
        const int li = ti - base, nt = li / kT, kt = li % kT;
        tr_tile(W, ldw, Bt, K, nt * 64, kt * 64, mapid, smem);
    }
    const int gtid = blockIdx.x * 512 + threadIdx.x, gsz = G * 512;
    float* bin = (float*)(p->ws + WS_BIN);
    for (int n = gtid; n < NIN; n += gsz) { const int m = map_in(n); bin[n] = m >= 0 ? p->in[13][m] : 0.f; }
    bf16_t* sc = (bf16_t*)(p->ws + WS_SC);
    for (int i = gtid; i < 256 * D; i += gsz) { const int r = i >> 10, c = i & 1023; float v = 0.f;
        if (r < 4) v = p->in[6][r * D + c]; else if (r < 132) v = p->in[7][(r - 4) * D + c];
        sc[i] = f2bf(silu_f(v)); }
}

template <class F> struct EpiF {
    static constexpr bool PERM = true, AFTER_DRAIN = false;
    F f;
    __device__ __forceinline__ void operator()(const f32x4 (&acc)[2][2][4][2], const pg8::Unit& u, int wr, int wc, int fr, int fq) const {
#pragma unroll
        for (int ai = 0; ai < 2; ++ai)
#pragma unroll
            for (int m = 0; m < 4; ++m) {
                const int row = u.pm * 256 + ai * 128 + wr * 64 + m * 16 + fr;
#pragma unroll
                for (int bj = 0; bj < 2; ++bj) { const int col = u.pn * 256 + bj * 128 + wc * 32 + 8 * fq; f(row, col, acc[ai][bj][m][0], acc[ai][bj][m][1]); }
            }
    }
};

template <class F> struct EpiG {
    static constexpr bool PERM = true, AFTER_DRAIN = false;
    F f;
    __device__ __forceinline__ void operator()(const f32x4 (&acc)[2][2][4][2], const pg8::Unit& u, int wr, int wc, int fr, int fq) const {
        const bool uni = u.pm < 64;
        f32x4 g0[2], g1[2];
#pragma unroll
        for (int bj = 0; bj < 2; ++bj) { g0[bj] = (f32x4){0.f, 0.f, 0.f, 0.f}; g1[bj] = g0[bj];
            if (uni) { const float* g = f.gate(u.pm >> 4, u.pn * 256 + bj * 128 + wc * 32 + 8 * fq); g0[bj] = *(const f32x4*)g; g1[bj] = *(const f32x4*)(g + 4); } }
#pragma unroll
        for (int ai = 0; ai < 2; ++ai)
#pragma unroll
            for (int m = 0; m < 4; ++m) { const int row = u.pm * 256 + ai * 128 + wr * 64 + m * 16 + fr;
#pragma unroll
                for (int bj = 0; bj < 2; ++bj) { const int col = u.pn * 256 + bj * 128 + wc * 32 + 8 * fq;
                    f32x4 h0 = g0[bj], h1 = g1[bj];
                    if (!uni) { const float* g = f.gate(brow_of(row), col); h0 = *(const f32x4*)g; h1 = *(const f32x4*)(g + 4); }
                    f.run(row, col, acc[ai][bj][m][0], acc[ai][bj][m][1], h0, h1); } }
    }
};
struct FMod { float* mod; const float* bias;
    __device__ __forceinline__ void operator()(int row, int col, f32x4 a, f32x4 b) const {
        a += *(const f32x4*)(bias + col); b += *(const f32x4*)(bias + col + 4);
        float* d = mod + (size_t)row * NADA + col; *(f32x4*)d = a; *(f32x4*)(d + 4) = b; } };

struct FIn { bf16_t* proj; float* glr; const LAS float* lb; float* out;
    __device__ __forceinline__ void kvout(int row, int g, int hh, int kv, int f, f32x4 v) const {
        const int W = 128 << (2 * g);
        if (row < TP) { const int t = row & 4095, b = row >> 12; if (t >= T - W) { float* d = out + okvp(g) + ((size_t)(b * W + t - (T - W)) * 2 + kv) * 256 + hh * 64 + f; *(f32x4*)d = v; } }
        else { const int r = row - TP, db = r >> 2, s = r & 3; float* d = out + okvs(g) + ((size_t)(db * W + W - 4 + s) * 2 + kv) * 256 + hh * 64 + f; *(f32x4*)d = v; }
    }
    __device__ __forceinline__ void operator()(int row, int col, f32x4 a, f32x4 b) const {
        if (col >= C_END) return;
        a += *(const LAS f32x4*)(lb + col); b += *(const LAS f32x4*)(lb + col + 4);
        if (col >= C_GLR) { float* d = glr + (size_t)row * 16 + (col - C_GLR); *(f32x4*)d = a; *(f32x4*)(d + 4) = b; return; }
        if (col >= C_GA) {
#pragma unroll
            for (int j = 0; j < 4; ++j) { a[j] = sigm_f(a[j]); b[j] = sigm_f(b[j]); }
        } else if (col >= C_DQ && col < C_DV) {
            const int isK = col >= C_DK; const int j = col - (isK ? C_DK : C_DQ); const int head = j >> 6, i0 = (j & 63) >> 1;
            const float posf = (float)(row < TP ? (row & 4095) : 8192 + ((row - TP) & 3));
            const f32x4 inv4 = *(const LAS f32x4*)(lb + NIN + i0);
            f32x4 cs0, cs1;
            { const float r0 = __builtin_amdgcn_fractf(posf * inv4[0] * 0.15915494309189535f), r1 = __builtin_amdgcn_fractf(posf * inv4[1] * 0.15915494309189535f),
                          r2 = __builtin_amdgcn_fractf(posf * inv4[2] * 0.15915494309189535f), r3 = __builtin_amdgcn_fractf(posf * inv4[3] * 0.15915494309189535f);
              cs0[0] = __builtin_amdgcn_cosf(r0); cs0[1] = __builtin_amdgcn_sinf(r0); cs0[2] = __builtin_amdgcn_cosf(r1); cs0[3] = __builtin_amdgcn_sinf(r1);
              cs1[0] = __builtin_amdgcn_cosf(r2); cs1[1] = __builtin_amdgcn_sinf(r2); cs1[2] = __builtin_amdgcn_cosf(r3); cs1[3] = __builtin_amdgcn_sinf(r3); }
            f32x4 ra, rb;
            ra[0] = a[0] * cs0[0] - a[1] * cs0[1]; ra[1] = a[1] * cs0[0] + a[0] * cs0[1];
            ra[2] = a[2] * cs0[2] - a[3] * cs0[3]; ra[3] = a[3] * cs0[2] + a[2] * cs0[3];
            rb[0] = b[0] * cs1[0] - b[1] * cs1[1]; rb[1] = b[1] * cs1[0] + b[0] * cs1[1];
            rb[2] = b[2] * cs1[2] - b[3] * cs1[3]; rb[3] = b[3] * cs1[2] + b[2] * cs1[3];
            a = ra; b = rb;
            if (isK) { f32x4 x1, x2; x1[0] = a[0]; x1[1] = a[2]; x1[2] = b[0]; x1[3] = b[2]; x2[0] = a[1]; x2[1] = a[3]; x2[2] = b[1]; x2[3] = b[3];
                kvout(row, head >> 2, head & 3, 0, i0, x1); kvout(row, head >> 2, head & 3, 0, 32 + i0, x2); }
        } else if (col >= C_DV && col < C_GA) {
            const int j = col - C_DV, head = j >> 6, f = j & 63;
            kvout(row, head >> 2, head & 3, 1, f, a); kvout(row, head >> 2, head & 3, 1, f + 4, b);
        }
        *(u32x4*)(proj + (size_t)row * NIN + col) = pack8(a, b);
    } };

struct FPa { bf16_t* mg; const bf16_t* proj;
    __device__ __forceinline__ void operator()(int row, int col, f32x4 a, f32x4 b) const {
        f32x4 g0, g1; unpack8(*(const u32x4*)(proj + (size_t)row * NIN + C_GA + col), g0, g1);
        *(u32x4*)(mg + (size_t)row * D + col) = pack8(a * g0, b * g1); } };
struct FPb { bf16_t* mg; const bf16_t* proj;
    __device__ __forceinline__ void operator()(int row, int col, f32x4 a, f32x4 b) const {
        f32x4 g0, g1, m0, m1; unpack8(*(const u32x4*)(proj + (size_t)row * NIN + C_GB + col), g0, g1);
        unpack8(*(const u32x4*)(mg + (size_t)row * D + col), m0, m1);
        *(u32x4*)(mg + (size_t)row * D + col) = pack8(m0 + a * g0, m1 + b * g1); } };
struct FOut { bf16_t* x1; const float* xp; const float* xs; const float* mod;
    __device__ __forceinline__ const float* gate(int br, int col) const { return mod + (size_t)br * NADA + 2 * D + col; }
    __device__ __forceinline__ void run(int row, int col, f32x4 a, f32x4 b, f32x4 g0, f32x4 g1) const {
        const float* xr = row < TP ? xp + (size_t)row * D + col : xs + (size_t)(row - TP) * D + col;
        *(u32x4*)(x1 + (size_t)row * D + col) = pack8(*(const f32x4*)xr + g0 * a, *(const f32x4*)(xr + 4) + g1 * b); } };
struct FUp { bf16_t* act;
    __device__ __forceinline__ void operator()(int row, int col, f32x4 a, f32x4 b) const {
        u32x2 w; w.x = pk2(silu_f(a[0]) * b[0], silu_f(a[1]) * b[1]); w.y = pk2(silu_f(a[2]) * b[2], silu_f(a[3]) * b[3]);
        *(u32x2*)(act + (size_t)row * DFF + (col >> 1)) = w; } };
struct FDown { bf16_t* x1; const float* mod;
    __device__ __forceinline__ const float* gate(int br, int col) const { return mod + (size_t)br * NADA + 5 * D + col; }
    __device__ __forceinline__ void run(int row, int col, f32x4 a, f32x4 b, f32x4 g0, f32x4 g1) const {
        bf16_t* d = x1 + (size_t)row * D + col; f32x4 x0, x4; unpack8(*(const u32x4*)d, x0, x4);
        *(u32x4*)d = pack8(x0 + g0 * a, x4 + g1 * b); } };

template <class F> __device__ __forceinline__ void run_gemm_g(unsigned char* smem, const bf16_t* A, const bf16_t* Bt, int Mm, int Nn, int Kk, const F& f, int Gg, int cc) {
    asm volatile("" : "+s"(Kk));
    pg8::Gemm g{A, Bt, Mm, Nn, Kk}; pg8::StaticOrder S; S.init(Mm, Nn, Gg, cc);
    EpiG<F> E{f};
    pg8::gemm_phase<EpiG<F>, pg8::StaticOrder, false>((PG8_LAS unsigned char*)smem, g, S, E, nullptr);
}
template <class F> __device__ __forceinline__ void run_gemm(unsigned char* smem, const bf16_t* A, const bf16_t* Bt, int Mm, int Nn, int Kk, const F& f, int Gg, int cc) {
    asm volatile("" : "+s"(Kk));
    pg8::Gemm g{A, Bt, Mm, Nn, Kk}; pg8::StaticOrder S; S.init(Mm, Nn, Gg, cc);
    EpiF<F> E{f};
    pg8::gemm_phase<EpiF<F>, pg8::StaticOrder, false>((PG8_LAS unsigned char*)smem, g, S, E, nullptr);
}

__device__ void phase_norm(const float* xa, const float* xb, const float* gain, const float* mod, int sh_i, int sc_i, bf16_t* ob, float* of, int mode, const bf16_t* xh) {
    const int lane = threadIdx.x & 63, gw = blockIdx.x * 8 + (threadIdx.x >> 6), nw = gridDim.x * 8;
    for (int row = gw; row < M; row += nw) {
        const float* xr = row < TP ? xa + (size_t)row * D : xb + (size_t)(row - TP) * D;
        f32x4 v[4]; float ss = 0.f;
#pragma unroll
        for (int j = 0; j < 4; ++j) { if (xh) { const u32x2 w = *(const u32x2*)(xh + (size_t)row * D + j * 256 + lane * 4); v[j][0] = __uint_as_float(w.x << 16); v[j][1] = __uint_as_float(w.x & 0xffff0000u); v[j][2] = __uint_as_float(w.y << 16); v[j][3] = __uint_as_float(w.y & 0xffff0000u); }
            else v[j] = *(const f32x4*)(xr + j * 256 + lane * 4);
            ss += v[j][0] * v[j][0] + v[j][1] * v[j][1] + v[j][2] * v[j][2] + v[j][3] * v[j][3]; }
#pragma unroll
        for (int o = 32; o >= 1; o >>= 1) ss += __shfl_xor(ss, o);
        const float rstd = rsqrtf(ss * (1.f / D) + EPS);
        const float* mr = mod + (size_t)brow_of(row) * NADA;
#pragma unroll
        for (int j = 0; j < 4; ++j) { const int c = j * 256 + lane * 4; f32x4 y = v[j] * rstd * *(const f32x4*)(gain + c);
            if (mode == 0) { y = y * (*(const f32x4*)(mr + sc_i * D + c) + 1.f) + *(const f32x4*)(mr + sh_i * D + c);
                u32x2 w; w.x = pk2(y[0], y[1]); w.y = pk2(y[2], y[3]); *(u32x2*)(ob + (size_t)row * D + c) = w; }
            else *(f32x4*)(of + (size_t)row * D + c) = y; }
    }
}

__device__ __forceinline__ void gla_front(KP p, int row0, int h, float* LA, float* SEG) {
    const int tid = threadIdx.x; const float* glr = (const float*)(p->ws + WS_GLR);
    const float* wa = p->in[14]; const int ch = tid & 127, tg = tid >> 7;
    float* GL = SEG + 512;
    const f32x2 g2 = *(const f32x2*)(glr + (size_t)row0 * 16 + tid * 2);
    float w[16];
#pragma unroll
    for (int r = 0; r < 16; ++r) w[r] = wa[r * 512 + h * 128 + ch];
    const float bb = p->in[15][h * 128 + ch];
    *(f32x2*)(GL + tid * 2) = g2;
    __syncthreads();
    float run = 0.f;
#pragma unroll 4
    for (int i = 0; i < 16; ++i) { const int tok = tg * 16 + i; const float* g = GL + tok * 16; float z = bb;
#pragma unroll
        for (int r4 = 0; r4 < 4; ++r4) { const f32x4 g4 = *(const f32x4*)(g + r4 * 4); z += g4[0] * w[r4 * 4] + g4[1] * w[r4 * 4 + 1] + g4[2] * w[r4 * 4 + 2] + g4[3] * w[r4 * 4 + 3]; }
        const float ls = fminf(z, 0.f) - __logf(1.f + __expf(-fabsf(z)));
        run += ls * (1.f / 16.f); LA[tok * 132 + ch] = run; }
    SEG[tg * 128 + ch] = run;
    __syncthreads();
    if (tg > 0) { float off = SEG[ch]; if (tg > 1) off += SEG[128 + ch]; if (tg > 2) off += SEG[256 + ch];
#pragma unroll 4
        for (int i = 0; i < 16; ++i) LA[(tg * 16 + i) * 132 + ch] += off; }
    __syncthreads();
}
struct VRows { bf16x8 r[4]; };
__device__ __forceinline__ VRows gla_fetch_v(const bf16_t* proj, int row0, int h) {
    const int tid = threadIdx.x, t4 = tid & 15, vg = tid >> 4; VRows v;
#pragma unroll
    for (int j = 0; j < 4; ++j) v.r[j] = *(const bf16x8*)(proj + (size_t)(row0 + 4 * t4 + j) * NIN + C_GV + h * 256 + vg * 8);
    return v;
}
__device__ __forceinline__ void gla_put_vt(const VRows& v, unsigned short* VT) {
    const int tid = threadIdx.x, t4 = tid & 15, vg = tid >> 4;
#pragma unroll
    for (int e = 0; e < 8; ++e) { u32x2 w; w.x = (unsigned)(unsigned short)v.r[0][e] | ((unsigned)(unsigned short)v.r[1][e] << 16); w.y = (unsigned)(unsigned short)v.r[2][e] | ((unsigned)(unsigned short)v.r[3][e] << 16);
        *(u32x2*)(VT + (vg * 8 + e) * 72 + 4 * t4) = w; }
}

__device__ void gla_passA(KP p, unsigned char* smem, int item) {
    const int tid = threadIdx.x, lane = tid & 63, wid = tid >> 6, l15 = lane & 15, quad = lane >> 4;
    const int bh = item >> 6, n = item & 63, b = bh >> 2, h = bh & 3, row0 = b * T + n * 64;
    float* LA = (float*)smem; unsigned short* KLT = (unsigned short*)(smem + 33792); unsigned short* VT = (unsigned short*)(smem + 33792 + 18432);
    const bf16_t* proj = (const bf16_t*)(p->ws + WS_PROJ);
    const VRows vrows = gla_fetch_v(proj, row0, h);
    bf16x8 r[4];
    { const int t4 = tid & 15, cgp = (tid >> 4) & 15;
#pragma unroll
        for (int j = 0; j < 4; ++j) r[j] = *(const bf16x8*)(proj + (size_t)(row0 + 4 * t4 + j) * NIN + C_GK + h * 128 + cgp * 8); }
    gla_front(p, row0, h, LA, (float*)(smem + 118784));
    if (tid < 256) { const int t4 = tid & 15, cgp = tid >> 4;
#pragma unroll
        for (int e = 0; e < 8; ++e) { const int ch = cgp * 8 + e; const float bl = LA[63 * 132 + ch]; float kf[4];
#pragma unroll
            for (int j = 0; j < 4; ++j) kf[j] = bf2f((unsigned short)r[j][e]) * __expf(bl - LA[(4 * t4 + j) * 132 + ch]);
            u32x2 w; w.x = pk2(kf[0], kf[1]); w.y = pk2(kf[2], kf[3]); *(u32x2*)(KLT + ch * 72 + 4 * t4) = w; } }
    gla_put_vt(vrows, VT);
    if (tid < 128) ((float*)(p->ws + WS_DEC))[item * 128 + tid] = __expf(LA[63 * 132 + tid]);
    __syncthreads();
    f32x4 acc[2][8];
#pragma unroll
    for (int i = 0; i < 2; ++i)
#pragma unroll
        for (int j = 0; j < 8; ++j) acc[i][j] = (f32x4){0.f, 0.f, 0.f, 0.f};
#pragma unroll
    for (int ks = 0; ks < 2; ++ks) { bf16x8 a[2];
#pragma unroll
        for (int mt = 0; mt < 2; ++mt) a[mt] = *(const bf16x8*)(VT + (32 * wid + 16 * mt + l15) * 72 + ks * 32 + quad * 8);
#pragma unroll
        for (int nt = 0; nt < 8; ++nt) { const bf16x8 bb = *(const bf16x8*)(KLT + (16 * nt + l15) * 72 + ks * 32 + quad * 8);
#pragma unroll
            for (int mt = 0; mt < 2; ++mt) acc[mt][nt] = mfma16(a[mt], bb, acc[mt][nt]); } }
    bf16_t* U = (bf16_t*)(p->ws + WS_U) + (size_t)item * 32768;
#pragma unroll
    for (int mt = 0; mt < 2; ++mt)
#pragma unroll
        for (int nt = 0; nt < 8; ++nt)
#pragma unroll
            for (int e = 0; e < 4; ++e) U[(32 * wid + 16 * mt + quad * 4 + e) * 128 + 16 * nt + l15] = f2bf(acc[mt][nt][e]);
    __syncthreads();
}

__device__ void gla_passC(KP p, unsigned char* smem, int item) {
    const int tid = threadIdx.x, lane = tid & 63, wid = tid >> 6, l15 = lane & 15, quad = lane >> 4;
    const int bh = item >> 6, n = item & 63, b = bh >> 2, h = bh & 3, row0 = b * T + n * 64;
    float* LA = (float*)smem; unsigned short* QG = (unsigned short*)(smem + 33792); unsigned short* KD = (unsigned short*)(smem + 51200);
    unsigned short* VT = (unsigned short*)(smem + 68608); unsigned short* ATT = (unsigned short*)(smem + 105472); float* RED = (float*)(smem + 114688);
    const bf16_t* proj = (const bf16_t*)(p->ws + WS_PROJ);
    const VRows vrows = gla_fetch_v(proj, row0, h);
    bf16x8 q8s[2], k8s[2];
#pragma unroll
    for (int it = 0; it < 2; ++it) { const int idx = tid + it * 512, cgp = idx & 15, tok = idx >> 4;
        q8s[it] = *(const bf16x8*)(proj + (size_t)(row0 + tok) * NIN + C_GQ + h * 128 + cgp * 8); k8s[it] = *(const bf16x8*)(proj + (size_t)(row0 + tok) * NIN + C_GK + h * 128 + cgp * 8); }
    const bf16_t* sst = (const bf16_t*)(p->ws + WS_SST) + (size_t)item * 32768;
    bf16x8 bsall[4][2];
#pragma unroll
    for (int ks = 0; ks < 4; ++ks)
#pragma unroll
        for (int nt = 0; nt < 2; ++nt) bsall[ks][nt] = *(const bf16x8*)(sst + (32 * wid + 16 * nt + l15) * 128 + ks * 32 + quad * 8);
    gla_front(p, row0, h, LA, (float*)(smem + 118784));
#pragma unroll
    for (int it = 0; it < 2; ++it) { const int idx = tid + it * 512, cgp = idx & 15, tok = idx >> 4;
        const bf16x8 q8 = q8s[it], k8 = k8s[it];
        f32x4 qa, qb, ka, kb;
#pragma unroll
        for (int e = 0; e < 8; ++e) { const float bc = LA[tok * 132 + cgp * 8 + e];
            const float qf = bf2f((unsigned short)q8[e]) * 0.08838834764831845f * __expf(bc), kf = bf2f((unsigned short)k8[e]) * __expf(-bc);
            if (e < 4) { qa[e] = qf; ka[e] = kf; } else { qb[e - 4] = qf; kb[e - 4] = kf; } }
        *(u32x4*)(QG + tok * 136 + cgp * 8) = pack8(qa, qb); *(u32x4*)(KD + tok * 136 + cgp * 8) = pack8(ka, kb); }
    gla_put_vt(vrows, VT);
    __syncthreads();
    { const int mt = wid >> 1; f32x4 c2[2] = {(f32x4){0.f, 0.f, 0.f, 0.f}, (f32x4){0.f, 0.f, 0.f, 0.f}};
#pragma unroll
        for (int ks = 0; ks < 4; ++ks) { const bf16x8 a = *(const bf16x8*)(QG + (16 * mt + l15) * 136 + ks * 32 + quad * 8);
#pragma unroll
            for (int j = 0; j < 2; ++j) { const int nt = 2 * (wid & 1) + j; const bf16x8 bb = *(const bf16x8*)(KD + (16 * nt + l15) * 136 + ks * 32 + quad * 8); c2[j] = mfma16(a, bb, c2[j]); } }
#pragma unroll
        for (int j = 0; j < 2; ++j)
#pragma unroll
            for (int e = 0; e < 4; ++e) { const int c = 16 * mt + quad * 4 + e, s = 16 * (2 * (wid & 1) + j) + l15; ATT[c * 72 + s] = f2bf(s <= c ? c2[j][e] : 0.f); } }
    __syncthreads();
    f32x4 o[4][2];
#pragma unroll
    for (int i = 0; i < 4; ++i)
#pragma unroll
        for (int j = 0; j < 2; ++j) o[i][j] = (f32x4){0.f, 0.f, 0.f, 0.f};
#pragma unroll
    for (int ks = 0; ks < 2; ++ks) { bf16x8 bv[2];
#pragma unroll
        for (int nt = 0; nt < 2; ++nt) bv[nt] = *(const bf16x8*)(VT + (32 * wid + 16 * nt + l15) * 72 + ks * 32 + quad * 8);
#pragma unroll
        for (int mt = 0; mt < 4; ++mt) { const bf16x8 a = *(const bf16x8*)(ATT + (16 * mt + l15) * 72 + ks * 32 + quad * 8);
#pragma unroll
            for (int nt = 0; nt < 2; ++nt) o[mt][nt] = mfma16(a, bv[nt], o[mt][nt]); } }
#pragma unroll
    for (int ks = 0; ks < 4; ++ks) { bf16x8 bs[2];
#pragma unroll
        for (int nt = 0; nt < 2; ++nt) bs[nt] = bsall[ks][nt];
#pragma unroll
        for (int mt = 0; mt < 4; ++mt) { const bf16x8 a = *(const bf16x8*)(QG + (16 * mt + l15) * 136 + ks * 32 + quad * 8);
#pragma unroll
            for (int nt = 0; nt < 2; ++nt) o[mt][nt] = mfma16(a, bs[nt], o[mt][nt]); } }
#pragma unroll
    for (int mt = 0; mt < 4; ++mt)
#pragma unroll
        for (int e = 0; e < 4; ++e) { float ss = o[mt][0][e] * o[mt][0][e] + o[mt][1][e] * o[mt][1][e];
            ss += __shfl_xor(ss, 1); ss += __shfl_xor(ss, 2); ss += __shfl_xor(ss, 4); ss += __shfl_xor(ss, 8);
            if (l15 == 0) RED[(16 * mt + quad * 4 + e) * 8 + wid] = ss; }
    __syncthreads();
    bf16_t* oa = (bf16_t*)(p->ws + WS_OA); const float* gng = p->in[16];
    unsigned short* OS = (unsigned short*)smem;
#pragma unroll
    for (int mt = 0; mt < 4; ++mt)
#pragma unroll
        for (int e = 0; e < 4; ++e) { const int c = 16 * mt + quad * 4 + e; const f32x4 r0 = *(const f32x4*)(RED + c * 8), r1 = *(const f32x4*)(RED + c * 8 + 4);
            const float tot = (r0[0] + r0[1]) + (r0[2] + r0[3]) + (r1[0] + r1[1]) + (r1[2] + r1[3]); const float rstd = rsqrtf(tot * (1.f / 256.f) + EPS);
#pragma unroll
            for (int nt = 0; nt < 2; ++nt) OS[c * 264 + 32 * wid + 16 * nt + l15] = f2bf(o[mt][nt][e] * rstd); }
    __syncthreads();
#pragma unroll
    for (int it = 0; it < 4; ++it) { const int idx = tid + it * 512, c = idx >> 5, d8 = (idx & 31) * 8;
        f32x4 o0, o1, s0, s1; unpack8(*(const u32x4*)(OS + c * 264 + d8), o0, o1);
        unpack8(*(const u32x4*)(proj + (size_t)(row0 + c) * NIN + C_GR + h * 256 + d8), s0, s1);
        const f32x4 g0 = *(const f32x4*)(gng + d8), g1 = *(const f32x4*)(gng + d8 + 4);
#pragma unroll
        for (int j = 0; j < 4; ++j) { s0[j] = silu_f(s0[j]); s1[j] = silu_f(s1[j]); }
        *(u32x4*)(oa + (size_t)(row0 + c) * D + h * 256 + d8) = pack8(o0 * g0 * s0, o1 * g1 * s1); }
    __syncthreads();
}

__device__ void gla_passB(KP p) {
    const int gtid = blockIdx.x * 512 + threadIdx.x, gsz = gridDim.x * 512;
    const bf16_t* U = (const bf16_t*)(p->ws + WS_U); const float* DEC = (const float*)(p->ws + WS_DEC); bf16_t* SST = (bf16_t*)(p->ws + WS_SST);
    for (int e4 = gtid; e4 < 131072; e4 += gsz) {
        const int bh = e4 >> 13, dv = (e4 >> 5) & 255, dk4 = (e4 & 31) * 4;
        f32x4 S = (f32x4){0.f, 0.f, 0.f, 0.f};
#pragma unroll 4
        for (int n = 0; n < 64; ++n) { const int item = bh * 64 + n; const size_t off = (size_t)item * 32768 + dv * 128 + dk4;
            u32x2 w; w.x = pk2(S[0], S[1]); w.y = pk2(S[2], S[3]); *(u32x2*)(SST + off) = w;
            const u32x2 ub = *(const u32x2*)(U + off); const f32x4 d4 = *(const f32x4*)(DEC + item * 128 + dk4);
            f32x4 u4; u4[0] = __uint_as_float(ub.x << 16); u4[1] = __uint_as_float(ub.x & 0xffff0000u); u4[2] = __uint_as_float(ub.y << 16); u4[3] = __uint_as_float(ub.y & 0xffff0000u);
            S = d4 * S + u4; }
#pragma unroll
        for (int j = 0; j < 4; ++j) p->out[O_SGP + ((size_t)(bh * 128 + dk4 + j)) * 256 + dv] = S[j];
    }
}

__device__ void gla_sample(KP p, unsigned char* smem, int item) {
    const int tid = threadIdx.x, lane = tid & 63, wid = tid >> 6;
    const int db = item >> 2, h = item & 3, row0 = TP + db * 4;
    float* BC = (float*)smem;
    float* QG = BC + 512; float* KD = QG + 512; float* KL = KD + 512; float* DECs = KL + 512;
    float* V = DECs + 128;
    float* ATT = V + 1024;
    float* RS = ATT + 16;
    float* RED = RS + 16;
    const bf16_t* proj = (const bf16_t*)(p->ws + WS_PROJ); const float* glr = (const float*)(p->ws + WS_GLR);
    const int tok = tid >> 7, ch = tid & 127;
    { float z = p->in[15][h * 128 + ch]; const float* g = glr + (size_t)(row0 + tok) * 16;
#pragma unroll
        for (int r = 0; r < 16; ++r) z += g[r] * p->in[14][r * 512 + h * 128 + ch];
        BC[tok * 128 + ch] = (fminf(z, 0.f) - __logf(1.f + __expf(-fabsf(z)))) * (1.f / 16.f); }
    __syncthreads();
    if (tid < 128) { float s = 0.f;
#pragma unroll
        for (int t = 0; t < 4; ++t) { s += BC[t * 128 + tid]; BC[t * 128 + tid] = s; } }
    __syncthreads();
    { const float bc = BC[tok * 128 + ch], bl = BC[3 * 128 + ch];
        const float q = bf2f(proj[(size_t)(row0 + tok) * NIN + C_GQ + h * 128 + ch]), k = bf2f(proj[(size_t)(row0 + tok) * NIN + C_GK + h * 128 + ch]);
        QG[tok * 128 + ch] = q * 0.08838834764831845f * __expf(bc); KD[tok * 128 + ch] = k * __expf(-bc); KL[tok * 128 + ch] = k * __expf(bl - bc);
        if (tok == 0) DECs[ch] = __expf(bl);
#pragma unroll
        for (int j = 0; j < 2; ++j) { const int i = tid + j * 512, t2 = i >> 8, dv = i & 255; V[i] = bf2f(proj[(size_t)(row0 + t2) * NIN + C_GV + h * 256 + dv]); } }
    __syncthreads();
    {
#pragma unroll
        for (int j = 0; j < 2; ++j) { const int pr = wid + 8 * j, c = pr >> 2, s = pr & 3;
            float d = QG[c * 128 + lane] * KD[s * 128 + lane] + QG[c * 128 + 64 + lane] * KD[s * 128 + 64 + lane];
#pragma unroll
            for (int o = 32; o >= 1; o >>= 1) d += __shfl_xor(d, o);
            if (lane == 0) ATT[pr] = s <= c ? d : 0.f; } }
    __syncthreads();
    const int dvq = lane * 4;
    f32x4 v4[4], inter[4];
#pragma unroll
    for (int t = 0; t < 4; ++t) { v4[t] = *(const f32x4*)(V + t * 256 + dvq); inter[t] = (f32x4){0.f, 0.f, 0.f, 0.f}; }
    const float* S0 = p->in[2] + (size_t)(db * 4 + h) * 32768; float* S1 = p->out + O_SGS + (size_t)(db * 4 + h) * 32768;
#pragma unroll 4
    for (int it = 0; it < 16; ++it) { const int dk = it * 8 + wid;
        const f32x4 s4 = __builtin_nontemporal_load((const f32x4*)(S0 + dk * 256 + dvq));
        f32x4 nw = s4 * DECs[dk];
#pragma unroll
        for (int t = 0; t < 4; ++t) { inter[t] += s4 * QG[t * 128 + dk]; nw += v4[t] * KL[t * 128 + dk]; }
        __builtin_nontemporal_store(nw, (f32x4*)(S1 + dk * 256 + dvq)); }
#pragma unroll
    for (int t = 0; t < 4; ++t) *(f32x4*)(RED + (wid * 4 + t) * 256 + dvq) = inter[t];
    __syncthreads();
    { const int dv2 = (tid & 127) * 2; float o0 = 0.f, o1 = 0.f;
#pragma unroll
        for (int w = 0; w < 8; ++w) { const f32x2 r = *(const f32x2*)(RED + (w * 4 + tok) * 256 + dv2); o0 += r[0]; o1 += r[1]; }
#pragma unroll
        for (int s = 0; s < 4; ++s) { const float a = ATT[tok * 4 + s]; o0 += a * V[s * 256 + dv2]; o1 += a * V[s * 256 + dv2 + 1]; }
        float ss = o0 * o0 + o1 * o1;
#pragma unroll
        for (int o = 32; o >= 1; o >>= 1) ss += __shfl_xor(ss, o);
        if (lane == 0) RS[wid] = ss;
        __syncthreads();
        const float rstd = rsqrtf((RS[2 * tok] + RS[2 * tok + 1]) * (1.f / 256.f) + EPS);
        const int row = row0 + tok; const float* gng = p->in[16];
        const float y0 = o0 * rstd * gng[dv2] * silu_f(bf2f(proj[(size_t)row * NIN + C_GR + h * 256 + dv2]));
        const float y1 = o1 * rstd * gng[dv2 + 1] * silu_f(bf2f(proj[(size_t)row * NIN + C_GR + h * 256 + dv2 + 1]));
        *(unsigned*)((bf16_t*)(p->ws + WS_OA) + (size_t)row * D + h * 256 + dv2) = pk2(y0, y1); }
    __syncthreads();
}

__device__ void dsw_prompt(KP p, unsigned char* smem, int item) {
    const int tid = threadIdx.x, lane = tid & 63, wid = tid >> 6, l15 = lane & 15, quad = lane >> 4;
    const int blk = item & 31, gh = (item >> 5) % 12, b = item / 384;
    const int g = gh >> 2, dil = 1 << (2 * g), nbc = 32 >> (2 * g);
    const int r = blk / nbc, l0 = (blk % nbc) * 128;
    unsigned short* KS = (unsigned short*)smem;
    unsigned short* VT = (unsigned short*)(smem + 39168);
    unsigned short* PS = (unsigned short*)(smem + 75008) + wid * (16 * 168);
    const bf16_t* proj = (const bf16_t*)(p->ws + WS_PROJ);
    const int qrow = b * T + (l0 + 16 * wid + l15) * dil + r;
    bf16x8 qa[2];
#pragma unroll
    for (int ks = 0; ks < 2; ++ks) qa[ks] = *(const bf16x8*)(proj + (size_t)qrow * NIN + C_DQ + gh * 64 + ks * 32 + quad * 8);
    u32x4 kreg[5];
#pragma unroll
    for (int it = 0; it < 5; ++it) { const int idx = tid + it * 512, i = idx >> 3, c8 = idx & 7, l = l0 - 144 + i; kreg[it] = (u32x4){0u, 0u, 0u, 0u};
        if (idx < 2176 && l >= 0) kreg[it] = *(const u32x4*)(proj + (size_t)(b * T + l * dil + r) * NIN + C_DK + gh * 64 + c8 * 8); }
    bf16x8 vreg[2][4];
#pragma unroll
    for (int it = 0; it < 2; ++it) { const int idx = tid + it * 512, c8 = idx / 68, i = 4 * (idx - c8 * 68), l = l0 - 144 + i;
#pragma unroll
        for (int j = 0; j < 4; ++j) { vreg[it][j] = (bf16x8){0, 0, 0, 0, 0, 0, 0, 0}; if (idx < 544 && l >= 0) vreg[it][j] = *(const bf16x8*)(proj + (size_t)(b * T + (l + j) * dil + r) * NIN + C_DV + gh * 64 + c8 * 8); } }
#pragma unroll
    for (int it = 0; it < 5; ++it) { const int idx = tid + it * 512, i = idx >> 3, c8 = idx & 7; if (idx < 2176) *(u32x4*)(KS + i * 72 + c8 * 8) = kreg[it]; }
#pragma unroll
    for (int it = 0; it < 2; ++it) { const int idx = tid + it * 512, c8 = idx / 68, i = 4 * (idx - c8 * 68);
        if (idx < 544) {
#pragma unroll
            for (int e = 0; e < 8; ++e) { u32x2 w; w.x = (unsigned)(unsigned short)vreg[it][0][e] | ((unsigned)(unsigned short)vreg[it][1][e] << 16); w.y = (unsigned)(unsigned short)vreg[it][2][e] | ((unsigned)(unsigned short)vreg[it][3][e] << 16);
                *(u32x2*)(VT + (c8 * 8 + e) * 280 + i) = w; } } }
    __syncthreads();
    f32x4 s[9];
#pragma unroll
    for (int kt = 0; kt < 9; ++kt) { s[kt] = (f32x4){0.f, 0.f, 0.f, 0.f};
#pragma unroll
        for (int ks = 0; ks < 2; ++ks) { const bf16x8 bb = *(const bf16x8*)(KS + (16 * wid + 16 * (kt + 1) + l15) * 72 + ks * 32 + quad * 8); s[kt] = mfma16(qa[ks], bb, s[kt]); } }
    float mx[4] = {-INFINITY, -INFINITY, -INFINITY, -INFINITY};
#pragma unroll
    for (int kt = 0; kt < 9; ++kt)
#pragma unroll
        for (int e = 0; e < 4; ++e) { const int dist = 144 + quad * 4 + e - 16 * (kt + 1) - l15, lk = l0 - 144 + 16 * wid + 16 * (kt + 1) + l15;
            const bool valid = dist >= 0 && dist <= 128 && lk >= 0; const float v = valid ? s[kt][e] * 0.125f : -INFINITY; s[kt][e] = v; mx[e] = fmaxf(mx[e], v); }
#pragma unroll
    for (int e = 0; e < 4; ++e) { mx[e] = fmaxf(mx[e], __shfl_xor(mx[e], 1)); mx[e] = fmaxf(mx[e], __shfl_xor(mx[e], 2)); mx[e] = fmaxf(mx[e], __shfl_xor(mx[e], 4)); mx[e] = fmaxf(mx[e], __shfl_xor(mx[e], 8)); }
    float den[4] = {0.f, 0.f, 0.f, 0.f};
#pragma unroll
    for (int e = 0; e < 4; ++e) PS[(quad * 4 + e) * 168 + l15] = 0;
#pragma unroll
    for (int kt = 0; kt < 9; ++kt)
#pragma unroll
        for (int e = 0; e < 4; ++e) { const float pe = __expf(s[kt][e] - mx[e]); den[e] += pe; PS[(quad * 4 + e) * 168 + 16 * (kt + 1) + l15] = f2bf(pe); }
#pragma unroll
    for (int e = 0; e < 4; ++e) { den[e] += __shfl_xor(den[e], 1); den[e] += __shfl_xor(den[e], 2); den[e] += __shfl_xor(den[e], 4); den[e] += __shfl_xor(den[e], 8); }
    __syncthreads();
    f32x4 o[4];
#pragma unroll
    for (int dt = 0; dt < 4; ++dt) o[dt] = (f32x4){0.f, 0.f, 0.f, 0.f};
#pragma unroll
    for (int ks = 0; ks < 5; ++ks) { const bf16x8 a = *(const bf16x8*)(PS + l15 * 168 + ks * 32 + quad * 8);
#pragma unroll
        for (int dt = 0; dt < 4; ++dt) { const bf16x8 bb = *(const bf16x8*)(VT + (16 * dt + l15) * 280 + 16 * wid + ks * 32 + quad * 8); o[dt] = mfma16(a, bb, o[dt]); } }
    bf16_t* og = (bf16_t*)(p->ws + WS_OG); float* lse = (float*)(p->ws + WS_LSE);
#pragma unroll
    for (int e = 0; e < 4; ++e) { const int tk = b * T + (l0 + 16 * wid + quad * 4 + e) * dil + r; const float inv = 1.f / den[e];
#pragma unroll
        for (int dt = 0; dt < 4; ++dt) og[(size_t)tk * 768 + gh * 64 + 16 * dt + l15] = f2bf(o[dt][e] * inv);
        if (l15 == 0) lse[tk * 12 + gh] = mx[e] + __logf(den[e]); }
    __syncthreads();
}

__device__ void dsw_combine(KP p) {
    const int gtid = blockIdx.x * 512 + threadIdx.x, gsz = gridDim.x * 512;
    const bf16_t* og = (const bf16_t*)(p->ws + WS_OG); const float* lse = (const float*)(p->ws + WS_LSE); bf16_t* ob = (bf16_t*)(p->ws + WS_OB);
    for (int idx = gtid; idx < TP * 32; idx += gsz) { const int d8 = idx & 7, hh = (idx >> 3) & 3, tk = idx >> 5;
        const float l0 = lse[tk * 12 + hh], l1 = lse[tk * 12 + 4 + hh], l2 = lse[tk * 12 + 8 + hh];
        const float mx = fmaxf(l0, fmaxf(l1, l2)); float w0 = __expf(l0 - mx), w1 = __expf(l1 - mx), w2 = __expf(l2 - mx); const float inv = 1.f / (w0 + w1 + w2); w0 *= inv; w1 *= inv; w2 *= inv;
        f32x4 a0, b0, a1, b1, a2, b2;
        unpack8(*(const u32x4*)(og + (size_t)tk * 768 + hh * 64 + d8 * 8), a0, b0);
        unpack8(*(const u32x4*)(og + (size_t)tk * 768 + (4 + hh) * 64 + d8 * 8), a1, b1);
        unpack8(*(const u32x4*)(og + (size_t)tk * 768 + (8 + hh) * 64 + d8 * 8), a2, b2);
        *(u32x4*)(ob + (size_t)tk * 256 + hh * 64 + d8 * 8) = pack8(a0 * w0 + a1 * w1 + a2 * w2, b0 * w0 + b1 * w1 + b2 * w2); }
}

__device__ void dsw_sample(KP p, unsigned char* smem, int witem) {
    const int lane = threadIdx.x & 63, wid = threadIdx.x >> 6;
    float* qs = (float*)smem + wid * 256; float* ps = qs + 64;
    const int s = witem & 3, hh = (witem >> 2) & 3, db = witem >> 4, row = TP + db * 4 + s;
    const bf16_t* proj = (const bf16_t*)(p->ws + WS_PROJ);
    float rmx = -INFINITY, rws = 0.f; f32x4 racc = (f32x4){0.f, 0.f, 0.f, 0.f};
    const int ksl = lane >> 2, part = lane & 3, kq = lane >> 4, d4 = (lane & 15) * 4;
#pragma unroll 1
    for (int g = 0; g < 3; ++g) {
        const int W = 128 << (2 * g), dil = 1 << (2 * g);
        const float* cache = p->in[3 + g] + (size_t)db * W * 512 + hh * 64;
        const float* kvn = p->out + okvs(g) + (size_t)(db * W + W - 4) * 512 + hh * 64;
        qs[lane] = bf2f(proj[(size_t)row * NIN + C_DQ + (g * 4 + hh) * 64 + 2 * (lane & 31) + (lane >> 5)]);
        __builtin_amdgcn_wave_barrier();
        f32x4 q4[4];
#pragma unroll
        for (int c = 0; c < 4; ++c) q4[c] = *(const f32x4*)(qs + part * 16 + c * 4);
#pragma unroll 5
        for (int pi = 0; pi < 9; ++pi) { const int j = pi * 16 + ksl; float dot = 0.f;
            if (j <= 128) { const int idx = W + s - j * dil; const float* kr = (idx >= W ? kvn + (size_t)(idx - W) * 512 : cache + (size_t)idx * 512) + part * 16;
#pragma unroll
                for (int c = 0; c < 4; ++c) { const f32x4 k4 = *(const f32x4*)(kr + c * 4); dot += k4[0] * q4[c][0] + k4[1] * q4[c][1] + k4[2] * q4[c][2] + k4[3] * q4[c][3]; } }
            dot += __shfl_xor(dot, 1); dot += __shfl_xor(dot, 2);
            if (part == 0 && j <= 128) ps[j] = dot * 0.125f; }
        __builtin_amdgcn_wave_barrier();
        float sc[3]; float m = -INFINITY;
#pragma unroll
        for (int jj = 0; jj < 3; ++jj) { const int j = lane + 64 * jj; sc[jj] = j <= 128 ? ps[j] : -INFINITY; m = fmaxf(m, sc[jj]); }
#pragma unroll
        for (int o = 32; o >= 1; o >>= 1) m = fmaxf(m, __shfl_xor(m, o));
        float den = 0.f;
        __builtin_amdgcn_wave_barrier();
#pragma unroll
        for (int jj = 0; jj < 3; ++jj) { const int j = lane + 64 * jj; if (j <= 128) { const float e = __expf(sc[jj] - m); den += e; ps[j] = e; } }
#pragma unroll
        for (int o = 32; o >= 1; o >>= 1) den += __shfl_xor(den, o);
        __builtin_amdgcn_wave_barrier();
        f32x4 o = (f32x4){0.f, 0.f, 0.f, 0.f};
#pragma unroll 17
        for (int jt = 0; jt < 33; ++jt) { const int j = jt * 4 + kq;
            if (j <= 128) { const int idx = W + s - j * dil; const float* vr = (idx >= W ? kvn + (size_t)(idx - W) * 512 : cache + (size_t)idx * 512) + 256 + d4;
                o += *(const f32x4*)vr * ps[j]; } }
#pragma unroll
        for (int c = 0; c < 4; ++c) { o[c] += __shfl_xor(o[c], 16); o[c] += __shfl_xor(o[c], 32); }
        const float lg = m + __logf(den), nm = fmaxf(rmx, lg), sc_old = __expf(rmx - nm), wg = __expf(lg - nm);
        racc = racc * sc_old + o * (wg / den); rws = rws * sc_old + wg; rmx = nm;
        __builtin_amdgcn_wave_barrier();
    }
    if (lane < 16) { const float inv = 1.f / rws; u32x2 w; w.x = pk2(racc[0] * inv, racc[1] * inv); w.y = pk2(racc[2] * inv, racc[3] * inv);
        *(u32x2*)((bf16_t*)(p->ws + WS_OB) + (size_t)row * 256 + hh * 64 + d4) = w; }
}

constexpr unsigned NCH0 = 496, NCH1 = 2032, NCH2 = 8176, NCHUNK = NCH0 + NCH1 + NCH2;
__device__ __forceinline__ void half_where(KP p, unsigned c, const f32x4*& src, f32x4*& dst, unsigned& cl, unsigned& per) {
    if (c < NCH0) { src = (const f32x4*)p->in[3]; dst = (f32x4*)(p->out + O_KVS0); cl = c; per = 124u * 128u; }
    else if (c < NCH0 + NCH1) { src = (const f32x4*)p->in[4]; dst = (f32x4*)(p->out + O_KVS1); cl = c - NCH0; per = 508u * 128u; }
    else { src = (const f32x4*)p->in[5]; dst = (f32x4*)(p->out + O_KVS2); cl = c - NCH0 - NCH1; per = 2044u * 128u; }
}
#define HALF_LOAD(H, c) do { const f32x4* src_; f32x4* dst_; unsigned cl_, per_; half_where(p, (c), src_, dst_, cl_, per_); \
    const unsigned i0_ = cl_ * 4096u + threadIdx.x, db0_ = i0_ / per_, rem0_ = i0_ - db0_ * per_; \
    _Pragma("unroll") for (int u = 0; u < 8; ++u) { const unsigned rem_ = rem0_ + u * 512u; H##d[u] = i0_ + u * 512u + 512u * (db0_ + (rem_ >= per_ ? 1u : 0u)); H##v[u] = __builtin_nontemporal_load(src_ + H##d[u] + 512u); } } while (0)
#define HALF_STORE(H, c) do { const f32x4* src_; f32x4* dst_; unsigned cl_, per_; half_where(p, (c), src_, dst_, cl_, per_); \
    _Pragma("unroll") for (int u = 0; u < 8; ++u) __builtin_nontemporal_store(H##v[u], dst_ + H##d[u]); } while (0)
__device__ __forceinline__ unsigned copier_claim(unsigned* ctl, int done_slot, unsigned need) {
    const bool stop = need != 0u && __hip_atomic_load(ctl + 32 * done_slot, __ATOMIC_RELAXED, __HIP_MEMORY_SCOPE_AGENT) >= need;
    return stop ? 0xffffffffu : __hip_atomic_fetch_add(ctl, 1u, __ATOMIC_RELAXED, __HIP_MEMORY_SCOPE_AGENT);
}
__device__ void copier(KP p, int done_slot, unsigned need, unsigned char* smem) {
    unsigned* ctl = (unsigned*)(p->ws + WS_CTL); volatile unsigned* sh = (volatile unsigned*)smem;
    f32x4 Av[8], Bv[8]; unsigned Ad[8], Bd[8];
    __syncthreads();
    if (threadIdx.x == 0) sh[0] = copier_claim(ctl, done_slot, need);
    __syncthreads();
    unsigned ca = sh[0];
    if (ca >= NCHUNK) return;
    HALF_LOAD(A, ca);
    for (;;) {
        __syncthreads();
        if (threadIdx.x == 0) sh[0] = copier_claim(ctl, done_slot, need);
        __syncthreads();
        const unsigned cb = sh[0];
        if (cb < NCHUNK) HALF_LOAD(B, cb);
        HALF_STORE(A, ca);
        if (cb >= NCHUNK) break;
        __syncthreads();
        if (threadIdx.x == 0) sh[0] = copier_claim(ctl, done_slot, need);
        __syncthreads();
        ca = sh[0];
        if (ca < NCHUNK) HALF_LOAD(A, ca);
        HALF_STORE(B, cb);
        if (ca >= NCHUNK) break;
    }
}
__device__ __forceinline__ void gemm_done(KP p, int done_slot) {
    __syncthreads();
    if (threadIdx.x == 0) __hip_atomic_fetch_add((unsigned*)(p->ws + WS_CTL) + 32 * done_slot, 1u, __ATOMIC_RELAXED, __HIP_MEMORY_SCOPE_AGENT);
}

__global__ void __launch_bounds__(512) fwd(Params pv) {
    extern __shared__ __attribute__((aligned(16))) unsigned char smem[];
    cg::grid_group grid = cg::this_grid();
    const int G = gridDim.x, bid = blockIdx.x;
    constexpr int C3 = 8, C10 = 8, CN = 120;
#define WSP(T, off) ((T*)(p->ws + (off)))
    if (threadIdx.x < 4) ((volatile LAS unsigned*)(smem + 131072))[threadIdx.x] = 0u;
    __syncthreads();
    const XcdBarrier xbar = xcd_barrier_post((unsigned*)(pv.ws + WS_BAR), (volatile LAS unsigned*)(smem + 131072));
    if (pv.ws == nullptr) grid.sync();
    { KP p = kargs(); if (PHMASK & 1) phase_prep(p, smem); }
    xcd_barrier(xbar);
    { KP p = kargs(); if (bid < 24) { run_gemm(smem, WSP(const bf16_t, WS_SC), WSP(const bf16_t, WS_WADA), 256, NADA, D, FMod{WSP(float, WS_MOD), p->in[11]}, 24, bid); gemm_done(p, 1); } else copier(p, 1, 1u, smem); }
    xcd_barrier(xbar);
    { KP p = kargs(); if (PHMASK & 4) phase_norm(p->in[0], p->in[1], p->in[8], WSP(const float, WS_MOD), 0, 1, WSP(bf16_t, WS_H), nullptr, 0, nullptr); }
    xcd_barrier(xbar);
    { KP p = kargs(); if (bid >= C3) {
        LAS float* lb = (LAS float*)(smem + LDS_XTRA);
        for (int i = threadIdx.x; i < NIN + 32; i += 512) { float v;
            if (i < NIN) v = WSP(const float, WS_BIN)[i];
            else { double inv = 1.0; for (int q = 0; q < i - NIN; ++q) inv *= 0.74989420933245582730; v = (float)inv; }
            lb[i] = v; }
        __syncthreads();
        run_gemm(smem, WSP(const bf16_t, WS_H), WSP(const bf16_t, WS_WIN), M, NIN, D, FIn{WSP(bf16_t, WS_PROJ), WSP(float, WS_GLR), lb, p->out}, G - C3, bid - C3); gemm_done(p, 2); } else copier(p, 2, 5u, smem); }
    xcd_barrier(xbar);
    { KP p = kargs();
      unsigned* qctr = (unsigned*)(p->ws + WS_CTL) + 32 * 7; volatile unsigned* shq = (volatile unsigned*)(smem + 131072 + 8);
      for (;;) {
          __syncthreads();
          if (threadIdx.x == 0) shq[0] = __hip_atomic_fetch_add(qctr, 1u, __ATOMIC_RELAXED, __HIP_MEMORY_SCOPE_AGENT);
          __syncthreads();
          const int k = (int)shq[0]; if (k >= 3328) break;
          const int q = k / 13, r = k - q * 13;
          if ((r & 3) == 0 && r < 12) { const int si = 3 * q + (r >> 2);
              if (si < 256) dsw_sample(p, smem, si * 8 + (int)(threadIdx.x >> 6)); else gla_sample(p, smem, si - 256); }
          else { const int pi = 10 * q + r - ((r + 3) >> 2);
              if (pi < 1536) dsw_prompt(p, smem, pi); else gla_passA(p, smem, pi - 1536); }
      } }
    xcd_barrier(xbar);
    { KP p = kargs(); if (PHMASK & 512) gla_passB(p); }
    { KP p = kargs(); if (PHMASK & 1024) dsw_combine(p); }
    xcd_barrier(xbar);
    { KP p = kargs(); if (PHMASK & 2048) for (int it = bid; it < 1024; it += G) gla_passC(p, smem, it); }
    xcd_barrier(xbar);
    { KP p = kargs(); if (bid >= CN) { run_gemm(smem, WSP(const bf16_t, WS_OA), WSP(const bf16_t, WS_WPA), M, D, D, FPa{WSP(bf16_t, WS_MG), WSP(const bf16_t, WS_PROJ)}, G - CN, bid - CN); } }
    { KP p = kargs(); if (bid >= CN) { run_gemm(smem, WSP(const bf16_t, WS_OB), WSP(const bf16_t, WS_WPB), M, D, 256, FPb{WSP(bf16_t, WS_MG), WSP(const bf16_t, WS_PROJ)}, G - CN, bid - CN); gemm_done(p, 3); } else copier(p, 3, 9u, smem); }
    xcd_barrier(xbar);
    { KP p = kargs(); if (bid >= CN) { run_gemm_g(smem, WSP(const bf16_t, WS_MG), WSP(const bf16_t, WS_WOUT), M, D, D, FOut{WSP(bf16_t, WS_X1), p->in[0], p->in[1], WSP(const float, WS_MOD)}, G - CN, bid - CN); gemm_done(p, 4); } else copier(p, 4, 9u, smem); }
    xcd_barrier(xbar);
    { KP p = kargs(); if (PHMASK & 32768) phase_norm(nullptr, nullptr, p->in[9], WSP(const float, WS_MOD), 3, 4, WSP(bf16_t, WS_H), nullptr, 0, WSP(const bf16_t, WS_X1)); }
    xcd_barrier(xbar);
    { KP p = kargs(); if (bid >= C10) { run_gemm(smem, WSP(const bf16_t, WS_H), WSP(const bf16_t, WS_WUP), M, NUP, D, FUp{WSP(bf16_t, WS_ACT)}, G - C10, bid - C10); gemm_done(p, 5); } else copier(p, 5, 37u, smem); }
    xcd_barrier(xbar);
    { KP p = kargs(); if (bid >= CN) { run_gemm_g(smem, WSP(const bf16_t, WS_ACT), WSP(const bf16_t, WS_WDN), M, D, DFF, FDown{WSP(bf16_t, WS_X1), WSP(const float, WS_MOD)}, G - CN, bid - CN); gemm_done(p, 6); } else copier(p, 6, 9u, smem); }
    xcd_barrier(xbar);
    { KP p = kargs(); if (PHMASK & 262144) phase_norm(nullptr, nullptr, p->in[22], WSP(const float, WS_MOD), 0, 0, nullptr, p->out + O_Y, 1, WSP(const bf16_t, WS_X1));
      copier(p, 0, 0u, smem); }
#undef WSP
}
}

extern "C" void kernel_launch(void* const* d_in, const int* in_sizes, int n_in, void* d_out, int out_size, void* d_ws, size_t ws_size, hipStream_t stream) {
    static int grid = 0;
    if (grid == 0) {
        int dev = 0, cus = 0, per_cu = 0;
        hipGetDevice(&dev);
        hipDeviceGetAttribute(&cus, hipDeviceAttributeMultiprocessorCount, dev);
        if (hipFuncSetAttribute((const void*)mk::fwd, hipFuncAttributeMaxDynamicSharedMemorySize, mk::LDS_BYTES) != hipSuccess) fprintf(stderr, "kernel_launch: hipFuncSetAttribute failed\n");
        if (hipOccupancyMaxActiveBlocksPerMultiprocessor(&per_cu, (const void*)mk::fwd, 512, mk::LDS_BYTES) != hipSuccess || per_cu < 1) { fprintf(stderr, "kernel_launch: occupancy query says %d blocks per CU\n", per_cu); per_cu = 1; }
        (void)hipGetLastError();
        grid = cus > 0 ? cus : 256;
        if (n_in != 23 || (size_t)out_size != mk::O_END || ws_size < mk::WS_END) fprintf(stderr, "kernel_launch: unexpected sizes n_in %d out %d ws %zu (need %zu)\n", n_in, out_size, ws_size, (size_t)mk::WS_END);
    }
    if (hipMemsetAsync((char*)d_ws + mk::WS_CTL, 0, 4096 + 16384, stream) != hipSuccess) fprintf(stderr, "kernel_launch: memset of control words failed\n");
    mk::Params p{};
    for (int i = 0; i < 23; ++i) p.in[i] = (const float*)d_in[i];
    p.out = (float*)d_out; p.ws = (unsigned char*)d_ws;
    void* args[] = {&p};
    hipError_t e = hipLaunchCooperativeKernel((const void*)mk::fwd, dim3(grid), dim3(512), args, mk::LDS_BYTES, stream);
    if (e != hipSuccess) fprintf(stderr, "cooperative launch failed: %s (grid %d)\n", hipGetErrorString(e), grid);
}
```

```cpp
#include <hip/hip_runtime.h>
#include <hip/hip_cooperative_groups.h>
#include <cstdio>
namespace cg = cooperative_groups;
namespace pg8 {
#define PG8_LAS __attribute__((address_space(3)))
typedef unsigned short bf16_t;
typedef short bf16x8 __attribute__((ext_vector_type(8)));
typedef float f32x4 __attribute__((ext_vector_type(4)));
typedef unsigned u32x4 __attribute__((ext_vector_type(4)));
constexpr int BM = 256, BK = 64, HALF = 128, HTB = HALF * BK * 2  , STAGE_BYTES = 8 * HTB, NXCD = 8, WGM = 8;

__host__ __device__ __forceinline__ int lds_byte(int r, int c) { const int st = (r >> 4) * 2 + (c >> 5), rr = r & 15, cc = c & 31, ob = rr * 64 + cc * 2; return st * 1024 + (ob ^ (((ob >> 9) & 1) << 5)); }
__host__ __device__ __forceinline__ void stage_rc(int b, int& R, int& C) { const int st = b / 1024, sb = b % 1024, swz = sb ^ (((sb >> 9) & 1) << 5); R = (st >> 1) * 16 + swz / 64; C = (st & 1) * 32 + (swz % 64) / 2; }
__host__ __device__ __forceinline__ int perm32(int rho) { const int n = rho >> 4, i = rho & 15; return 8 * (i >> 2) + 4 * n + (i & 3); }

struct Unit { int pm, pn; };
struct Gemm { const bf16_t* A; const bf16_t* Bt; int M, N, K; };

struct StaticOrder {
    int nM, nN, nwg, G, c;
    __host__ __device__ void init(int M, int N, int G_, int c_) { nM = M / BM; nN = N / BM; nwg = nM * nN; G = G_; c = c_; }
    __host__ __device__ bool next(int i, Unit& u) const {
        const long L = (long)i * G + c; if (L >= nwg) return false;
        int wgid = (int)L; { const int q = nwg / NXCD, r = nwg % NXCD, xcd = wgid % NXCD, off = wgid / NXCD; wgid = (xcd < r ? xcd * (q + 1) : r * (q + 1) + (xcd - r) * q) + off; }
        const int nig = WGM * nN, gid = wgid / nig, fm = gid * WGM, gsz = (nM - fm) < WGM ? (nM - fm) : WGM;
        u.pm = fm + ((wgid % nig) % gsz); u.pn = (wgid % nig) / gsz; return true;
    }
    __device__ __forceinline__ void a_ready(const Unit&) const {}
    __device__ __forceinline__ void done(const Unit&) const {}
};
__device__ __forceinline__ unsigned cvt_pk_bf16(float lo, float hi) { unsigned r; asm volatile("v_cvt_pk_bf16_f32 %0, %1, %2" : "=v"(r) : "v"(lo), "v"(hi)); return r; }
typedef float f32x2 __attribute__((ext_vector_type(2)));
template <class Epi, class Sched, bool STAMP = false>
__device__ __forceinline__ void gemm_phase(PG8_LAS unsigned char* lds, const Gemm g, const Sched& S, const Epi& E, unsigned long long* stamps) {
    const int tid = threadIdx.x, wid = __builtin_amdgcn_readfirstlane(tid >> 6), lane = tid & 63, wr = wid >> 2, wc = wid & 3, fr = lane & 15, fq = lane >> 4;
    const int K = g.K, nt = K / BK;
    int ts_lo = 0, ts_hi = 0, nts = 0; const unsigned long long rt_entry = STAMP ? (unsigned long long)wall_clock64() : 0ull;
#define PG8_STAMP() do { if (STAMP && wid == 0 && nts < 64) { const unsigned long long _c = (unsigned long long)clock64(); \
        ts_lo = (lane == nts) ? (int)(unsigned)_c : ts_lo; ts_hi = (lane == nts) ? (int)(unsigned)(_c >> 32) : ts_hi; ++nts; } } while (0)
    PG8_STAMP();
    unsigned voffA[2], voffB[2];
#pragma unroll
    for (int i = 0; i < 2; ++i) { int R, C; stage_rc(tid * 16 + i * 8192, R, C); const int Rb = Epi::PERM ? ((R & ~31) + perm32(R & 31)) : R;
        voffA[i] = (unsigned)(R * K + C) * 2u; voffB[i] = (unsigned)(Rb * K + C) * 2u; }
    const size_t kstep = (size_t)(BK * 2);
    const size_t hstep = (size_t)HALF * K * 2;
    const size_t tstep = 2 * hstep;
    const unsigned ldsw = (unsigned)wid * 1024u;
    const int aoff = lds_byte(wr * 64 + fr, fq * 8), boff = lds_byte(wc * 32 + fr, fq * 8);
#define PG8_SA(b, h) (((b) * 2 + (h)) * HTB)
#define PG8_SB(b, h) ((4 + (b) * 2 + (h)) * HTB)
#define PG8_STAGE(bufoff, gbase, voff) do { _Pragma("unroll") for (int _i = 0; _i < 2; ++_i) \
        __builtin_amdgcn_global_load_lds((const unsigned*)((const char*)(gbase) + (voff)[_i]), (PG8_LAS unsigned*)(lds + (bufoff) + ldsw + _i * 8192), 16, 0, 0); } while (0)
#define PG8_LDA(dst, b, h) do { _Pragma("unroll") for (int m = 0; m < 4; ++m) _Pragma("unroll") for (int k = 0; k < 2; ++k) dst[m][k] = *(const PG8_LAS bf16x8*)(lds + PG8_SA(b, h) + aoff + m * 2048 + k * 1024); } while (0)
#define PG8_LDB(dst, b, h) do { _Pragma("unroll") for (int n = 0; n < 2; ++n) _Pragma("unroll") for (int k = 0; k < 2; ++k) dst[n][k] = *(const PG8_LAS bf16x8*)(lds + PG8_SB(b, h) + boff + n * 2048 + k * 1024); } while (0)
#define PG8_MMA(ai, bj, At, Bt) do { __builtin_amdgcn_s_setprio(1); _Pragma("unroll") for (int m = 0; m < 4; ++m) _Pragma("unroll") for (int n = 0; n < 2; ++n) _Pragma("unroll") for (int k = 0; k < 2; ++k) \
        acc[ai][bj][m][n] = __builtin_amdgcn_mfma_f32_16x16x32_bf16(Bt[n][k], At[m][k], acc[ai][bj][m][n], 0, 0, 0); __builtin_amdgcn_s_setprio(0); } while (0)
#define PG8_WAIT_V(n) asm volatile("s_waitcnt vmcnt(" #n ")" ::: "memory")
#define PG8_WAIT_L(n) asm volatile("s_waitcnt lgkmcnt(" #n ")" ::: "memory")
#define PG8_BAR __builtin_amdgcn_s_barrier()
#define PG8_SCHED __builtin_amdgcn_sched_barrier(0)
    Unit cur, nxt; int ui = 0;
    if (!S.next(0, cur)) return;
    f32x4 acc[2][2][4][2];
#pragma unroll
    for (int a = 0; a < 2; ++a)
#pragma unroll
        for (int b = 0; b < 2; ++b)
#pragma unroll
            for (int m = 0; m < 4; ++m)
#pragma unroll
                for (int n = 0; n < 2; ++n) acc[a][b][m][n] = (f32x4){0.f, 0.f, 0.f, 0.f};
    bf16x8 At[4][2], B0[2][2], B1[2][2];
    const char* cA = (const char*)g.A + (size_t)cur.pm * tstep; const char* cB = (const char*)g.Bt + (size_t)cur.pn * tstep;
    S.a_ready(cur);
    PG8_STAGE(PG8_SB(0, 0), cB, voffB); PG8_STAGE(PG8_SA(0, 0), cA, voffA); PG8_STAGE(PG8_SB(0, 1), cB + hstep, voffB); PG8_STAGE(PG8_SA(0, 1), cA + hstep, voffA);
    if (wr == 1) PG8_BAR;
    PG8_WAIT_V(4); PG8_BAR;
    PG8_STAGE(PG8_SB(1, 0), cB + kstep, voffB); PG8_STAGE(PG8_SA(1, 0), cA + kstep, voffA); PG8_STAGE(PG8_SB(1, 1), cB + hstep + kstep, voffB);
    PG8_WAIT_V(6); PG8_BAR;
    PG8_STAMP();
    for (;;) {
        const bool has_next = S.next(ui + 1, nxt);
        const char* nA = has_next ? (const char*)g.A + (size_t)nxt.pm * tstep : cA; const char* nB = has_next ? (const char*)g.Bt + (size_t)nxt.pn * tstep : cB;
        for (int t = 0; t < nt; t += 2) {
            const bool last = (t == nt - 2);
            const char* a1 = cA + (size_t)(t + 1) * kstep;
            const char* a2 = last ? nA : cA + (size_t)(t + 2) * kstep; const char* b2 = last ? nB : cB + (size_t)(t + 2) * kstep;
            const char* a3 = a2 + kstep; const char* b3 = b2 + kstep;
            if (last && has_next) S.a_ready(nxt);
            PG8_LDB(B0, 0, 0); PG8_SCHED; PG8_LDA(At, 0, 0); PG8_STAGE(PG8_SA(1, 1), a1 + hstep, voffA);
            PG8_WAIT_L(8); PG8_BAR; PG8_WAIT_L(0); PG8_MMA(0, 0, At, B0); PG8_BAR; PG8_SCHED;
            PG8_LDB(B1, 0, 1); PG8_STAGE(PG8_SB(0, 0), b2, voffB);
            PG8_BAR; PG8_WAIT_L(0); PG8_MMA(0, 1, At, B1); PG8_BAR;
            PG8_LDA(At, 0, 1); PG8_STAGE(PG8_SA(0, 0), a2, voffA);
            PG8_BAR; PG8_WAIT_L(0); PG8_MMA(1, 0, At, B0); PG8_BAR; PG8_SCHED;
            PG8_STAGE(PG8_SB(0, 1), b2 + hstep, voffB);
            PG8_WAIT_V(6); PG8_BAR; PG8_MMA(1, 1, At, B1); PG8_BAR;
            PG8_LDB(B0, 1, 0); PG8_SCHED; PG8_LDA(At, 1, 0); PG8_STAGE(PG8_SA(0, 1), a2 + hstep, voffA);
            PG8_WAIT_L(8); PG8_BAR; PG8_WAIT_L(0); PG8_MMA(0, 0, At, B0); PG8_BAR; PG8_SCHED;
            PG8_LDB(B1, 1, 1); PG8_STAGE(PG8_SB(1, 0), b3, voffB);
            PG8_BAR; PG8_WAIT_L(0); PG8_MMA(0, 1, At, B1); PG8_BAR;
            PG8_LDA(At, 1, 1); PG8_STAGE(PG8_SA(1, 0), a3, voffA);
            PG8_BAR; PG8_WAIT_L(0); PG8_MMA(1, 0, At, B0); PG8_BAR; PG8_SCHED;
            PG8_STAGE(PG8_SB(1, 1), b3 + hstep, voffB);
            PG8_WAIT_V(6); PG8_BAR; PG8_MMA(1, 1, At, B1); PG8_BAR;
        }
        PG8_STAMP();
        if constexpr (!Epi::AFTER_DRAIN) { E(acc, cur, wr, wc, fr, fq); S.done(cur); }
        PG8_STAMP();
        if (!has_next) break;
#pragma unroll
        for (int a = 0; a < 2; ++a)
#pragma unroll
            for (int b = 0; b < 2; ++b)
#pragma unroll
                for (int m = 0; m < 4; ++m)
#pragma unroll
                    for (int n = 0; n < 2; ++n) acc[a][b][m][n] = (f32x4){0.f, 0.f, 0.f, 0.f};
        cur = nxt; cA = nA; cB = nB; ++ui;
    }
    PG8_WAIT_V(0);
    if (wr == 0) PG8_BAR;
    PG8_BAR;
    if constexpr (Epi::AFTER_DRAIN) { E.fused(acc, cur, wr, wc, fr, fq, lds, wid, lane); S.done(cur); }
    PG8_STAMP();
    if (STAMP && wid == 0) { stamps[lane] = lane < nts ? (((unsigned long long)(unsigned)ts_hi << 32) | (unsigned)ts_lo) : 0ull;
        if (lane == 62) stamps[62] = rt_entry; if (lane == 63) stamps[63] = (unsigned long long)wall_clock64(); }
#undef PG8_STAMP
#undef PG8_SA
#undef PG8_SB
#undef PG8_STAGE
#undef PG8_LDA
#undef PG8_LDB
#undef PG8_MMA
#undef PG8_WAIT_V
#undef PG8_WAIT_L
#undef PG8_BAR
#undef PG8_SCHED
}
}

#define XB_TMO      128
#define XB_XCNT(j)  (256  + 64 * (j))
#define XB_XSUB(j)  (1280 + 64 * (j))
#define XB_XGEN(j)  (2304 + 64 * (j))
#define XB_TOP      3328
#define XB_TOPGEN   3392
#define XCD_BAR_WORDS 3456
#define XB_SPIN_CAP (1u << 18)
#define LAS __attribute__((address_space(3)))

__device__ __forceinline__ unsigned xb_ld(unsigned* p)              { return __hip_atomic_load(p, __ATOMIC_RELAXED, __HIP_MEMORY_SCOPE_AGENT); }
__device__ __forceinline__ unsigned xb_add(unsigned* p, unsigned v) { return __hip_atomic_fetch_add(p, v, __ATOMIC_RELAXED, __HIP_MEMORY_SCOPE_AGENT); }
__device__ __forceinline__ unsigned xb_xcc_id() { return (unsigned)__builtin_amdgcn_s_getreg((3 << 11) | 20) & 0xFu; }
#define XB_SPIN(cond, bar) do { unsigned _sp = 0; while (cond) { __builtin_amdgcn_s_sleep(1); \
    if ((++_sp & 255u) == 0u) { if (xb_ld(&(bar)[XB_TMO])) break; if (_sp > XB_SPIN_CAP) { atomicAdd(&(bar)[XB_TMO], 1u); break; } } } } while (0)

struct XcdBarrier {
    unsigned* bar; unsigned x;
    volatile LAS unsigned* st;
};

__device__ __forceinline__ XcdBarrier xcd_barrier_post(unsigned* bar, volatile LAS unsigned* st) {
    XcdBarrier b; b.bar = bar; b.x = xb_xcc_id(); b.st = st;
    if (threadIdx.x == 0) (void)xb_add(&bar[XB_XCNT(b.x)], 1u);
    return b;
}
__device__ __forceinline__ void xcd_barrier_complete(unsigned* bar, unsigned x, unsigned& nloc, unsigned& nx) {
    const unsigned G = gridDim.x * gridDim.y * gridDim.z;
    unsigned sum, cnt, mine, sp = 0u;
    for (;;) {
        sum = 0u; cnt = 0u; mine = 0u;
#pragma unroll
        for (unsigned j = 0; j < 16; ++j) { const unsigned c = xb_ld(&bar[XB_XCNT(j)]); sum += c; cnt += (c > 0u) ? 1u : 0u; mine = (j == x) ? c : mine; }
        if (sum == G) break;
        __builtin_amdgcn_s_sleep(1);
        if ((++sp & 255u) == 0u) { if (xb_ld(&bar[XB_TMO])) break; if (sp > XB_SPIN_CAP) { atomicAdd(&bar[XB_TMO], 1u); break; } }
    }
    nloc = mine > 0u ? mine : 1u; nx = cnt > 0u ? cnt : 1u;
}

__device__ __forceinline__ void xcd_barrier(const XcdBarrier& b) {
    asm volatile("s_waitcnt vmcnt(0)" ::: "memory");
    __syncthreads();
    if (threadIdx.x == 0) {
        unsigned* bar = b.bar;
        __builtin_amdgcn_s_waitcnt(0);
        unsigned nloc = b.st[0], nx = b.st[1];
        if (nloc == 0u) { xcd_barrier_complete(bar, b.x, nloc, nx); b.st[0] = nloc; b.st[1] = nx; }
        const unsigned old = xb_add(&bar[XB_XSUB(b.x)], 1u);
        const unsigned gen = old / nloc;
        if (old + 1u == (gen + 1u) * nloc) {
            __builtin_amdgcn_fence(__ATOMIC_RELEASE, "agent");
            asm volatile("s_waitcnt vmcnt(0)" ::: "memory");
            const unsigned og = xb_add(&bar[XB_TOP], 1u);
            const unsigned tg = og / nx;
            if (og + 1u == (tg + 1u) * nx) xb_add(&bar[XB_TOPGEN], 1u);
            else XB_SPIN(xb_ld(&bar[XB_TOPGEN]) == tg, bar);
            __builtin_amdgcn_fence(__ATOMIC_ACQUIRE, "agent");
            xb_add(&bar[XB_XGEN(b.x)], 1u);
            asm volatile("s_waitcnt vmcnt(0)" ::: "memory");
        } else {
            XB_SPIN(xb_ld(&bar[XB_XGEN(b.x)]) == gen, bar);
            __builtin_amdgcn_fence(__ATOMIC_ACQUIRE, "agent");
            asm volatile("s_waitcnt vmcnt(0)" ::: "memory");
        }
    }
    __syncthreads();
}

#ifndef PHMASK
#define PHMASK 0x7FFFF
#endif
namespace mk {
using pg8::bf16_t; using pg8::bf16x8; using pg8::f32x4; using pg8::u32x4;
typedef unsigned u32x2 __attribute__((ext_vector_type(2)));
typedef float f32x2 __attribute__((ext_vector_type(2)));

constexpr int D = 1024, T = 4096, NB = 4, TP = NB * T, DBATCH = 128, SS = 4, TS = DBATCH * SS, M = TP + TS;
constexpr int NIN = 7680, NADA = 6144, NUP = 5632, DFF = 2816;
constexpr int C_GQ = 0, C_GK = 512, C_GV = 1024, C_GR = 2048, C_DQ = 3072, C_DK = 3840, C_DV = 4608, C_GA = 5376, C_GB = 6400, C_GLR = 7424, C_END = 7440;
constexpr int LDS_XTRA = 131072 + 16;
constexpr int LDS_BYTES = LDS_XTRA + (7680 + 32) * 4;
constexpr float EPS = 1e-6f;

constexpr size_t al(size_t x) { return (x + 255) & ~(size_t)255; }
constexpr size_t WS_WADA = 0;
constexpr size_t WS_WIN = WS_WADA + al((size_t)NADA * D * 2);
constexpr size_t WS_WPA = WS_WIN + al((size_t)NIN * D * 2);
constexpr size_t WS_WPB = WS_WPA + al((size_t)D * D * 2);
constexpr size_t WS_WOUT = WS_WPB + al((size_t)D * 256 * 2);
constexpr size_t WS_WUP = WS_WOUT + al((size_t)D * D * 2);
constexpr size_t WS_WDN = WS_WUP + al((size_t)NUP * D * 2);
constexpr size_t WS_BIN = WS_WDN + al((size_t)D * DFF * 2);
constexpr size_t WS_SC = WS_BIN + al((size_t)NIN * 4);
constexpr size_t WS_ROPE = WS_SC + al((size_t)256 * D * 2);
constexpr size_t WS_MOD = WS_ROPE + al((size_t)4100 * 32 * 8);
constexpr size_t WS_H = WS_MOD + al((size_t)256 * NADA * 4);
constexpr size_t WS_PROJ = WS_H + al((size_t)M * D * 2);
constexpr size_t WS_GLR = WS_PROJ + al((size_t)M * NIN * 2);
constexpr size_t WS_U = WS_GLR + al((size_t)M * 16 * 4);
constexpr size_t WS_DEC = WS_U + al((size_t)1024 * 32768 * 4);
constexpr size_t WS_SST = WS_DEC + al((size_t)1024 * 128 * 4);
constexpr size_t WS_OG = WS_SST + al((size_t)1024 * 32768 * 2);
constexpr size_t WS_LSE = WS_OG + al((size_t)TP * 768 * 2);
constexpr size_t WS_OA = WS_LSE + al((size_t)TP * 12 * 4);
constexpr size_t WS_OB = WS_OA + al((size_t)M * D * 2);
constexpr size_t WS_MG = WS_OB + al((size_t)M * 256 * 2);
constexpr size_t WS_X1 = WS_MG + al((size_t)M * D * 2);
constexpr size_t WS_ACT = WS_X1 + al((size_t)M * D * 4);
constexpr size_t WS_CTL = WS_ACT + al((size_t)M * DFF * 2);
constexpr size_t WS_BAR = WS_CTL + 4096;
constexpr size_t WS_END = WS_BAR + 16384;

constexpr size_t O_Y = 0;
constexpr size_t O_SGP = O_Y + (size_t)M * D;
constexpr size_t O_KVP0 = O_SGP + (size_t)4 * 4 * 128 * 256;
constexpr size_t O_KVP1 = O_KVP0 + (size_t)4 * 128 * 512;
constexpr size_t O_KVP2 = O_KVP1 + (size_t)4 * 512 * 512;
constexpr size_t O_SGS = O_KVP2 + (size_t)4 * 2048 * 512;
constexpr size_t O_KVS0 = O_SGS + (size_t)128 * 4 * 128 * 256;
constexpr size_t O_KVS1 = O_KVS0 + (size_t)128 * 128 * 512;
constexpr size_t O_KVS2 = O_KVS1 + (size_t)128 * 512 * 512;
constexpr size_t O_END = O_KVS2 + (size_t)128 * 2048 * 512;

struct Params { const float* in[23]; float* out; unsigned char* ws; };
typedef const __attribute__((address_space(4))) Params* KP;
__device__ __forceinline__ KP kargs() { KP k = (KP)__builtin_amdgcn_kernarg_segment_ptr(); asm volatile("" : "+s"(k)); return k; }

__device__ __forceinline__ float bf2f(unsigned short b) { return __uint_as_float(((unsigned)b) << 16); }
__device__ __forceinline__ unsigned short f2bf(float f) { unsigned u = __float_as_uint(f); u += 0x7FFFu + ((u >> 16) & 1u); return (unsigned short)(u >> 16); }
__device__ __forceinline__ unsigned pk2(float lo, float hi) { unsigned r; asm("v_cvt_pk_bf16_f32 %0, %1, %2" : "=v"(r) : "v"(lo), "v"(hi)); return r; }
__device__ __forceinline__ float silu_f(float x) { return x * __builtin_amdgcn_rcpf(1.f + __expf(-x)); }
__device__ __forceinline__ float sigm_f(float x) { return __builtin_amdgcn_rcpf(1.f + __expf(-x)); }
__device__ __forceinline__ int brow_of(int row) { return row < TP ? (row >> 12) : 4 + ((row - TP) >> 2); }
__device__ __forceinline__ size_t okvp(int g) { return g == 0 ? O_KVP0 : (g == 1 ? O_KVP1 : O_KVP2); }
__device__ __forceinline__ size_t okvs(int g) { return g == 0 ? O_KVS0 : (g == 1 ? O_KVS1 : O_KVS2); }
__device__ __forceinline__ f32x4 mfma16(bf16x8 a, bf16x8 b, f32x4 c) { return __builtin_amdgcn_mfma_f32_16x16x32_bf16(a, b, c, 0, 0, 0); }
__device__ __forceinline__ u32x4 pack8(f32x4 a, f32x4 b) { u32x4 w; w.x = pk2(a[0], a[1]); w.y = pk2(a[2], a[3]); w.z = pk2(b[0], b[1]); w.w = pk2(b[2], b[3]); return w; }
__device__ __forceinline__ void unpack8(u32x4 w, f32x4& a, f32x4& b) {
    a[0] = __uint_as_float(w.x << 16); a[1] = __uint_as_float(w.x & 0xffff0000u); a[2] = __uint_as_float(w.y << 16); a[3] = __uint_as_float(w.y & 0xffff0000u);
    b[0] = __uint_as_float(w.z << 16); b[1] = __uint_as_float(w.z & 0xffff0000u); b[2] = __uint_as_float(w.w << 16); b[3] = __uint_as_float(w.w & 0xffff0000u); }

__device__ __forceinline__ int map_in(int n) {
    if (n < 3072) return n;
    if (n < C_DV) { const int isK = n >= C_DK; const int j = n - (isK ? C_DK : C_DQ); const int head = j >> 6, p = j & 63; return (isK ? 3856 : 3088) + head * 64 + (p >> 1) + 32 * (p & 1); }
    if (n < C_GA) return 4624 + (n - C_DV);
    if (n < C_GB) return 5392 + (n - C_GA);
    if (n < C_GLR) return 6416 + (n - C_GB);
    if (n < C_END) return 3072 + (n - C_GLR);
    return -1;
}
__device__ __forceinline__ int map_up(int n) { const int q = n >> 3, e = n & 7; return e < 4 ? 4 * q + e : DFF + 4 * q + e - 4; }

__device__ __forceinline__ void tr_tile(const float* __restrict__ W, int ldw, bf16_t* __restrict__ Bt, int K, int n0, int k0, int mapid, unsigned char* smem) {
    unsigned short* t = (unsigned short*)smem;
    const int tid = threadIdx.x, lane = tid & 63, w8 = tid >> 6;
    const int n = n0 + lane; const int src = mapid == 0 ? n : (mapid == 1 ? map_in(n) : map_up(n));
#pragma unroll
    for (int j = 0; j < 8; ++j) { const int kk = w8 + 8 * j; const float v = src >= 0 ? W[(size_t)(k0 + kk) * ldw + src] : 0.f; t[kk * 66 + lane] = f2bf(v); }
    __syncthreads();
#pragma unroll
    for (int j = 0; j < 8; ++j) { const int nn = w8 + 8 * j; Bt[(size_t)(n0 + nn) * K + k0 + lane] = t[lane * 66 + nn]; }
    __syncthreads();
}

__device__ void phase_prep(KP p, unsigned char* smem) {
    const int G = gridDim.x;
    for (int ti = blockIdx.x; ti < 6144; ti += G) {
        const float* W; int ldw, K, kT, mapid, base; bf16_t* Bt;
        if (ti < 1536)      { W = p->in[10]; ldw = NADA; K = D;   kT = 16; mapid = 0; base = 0;    Bt = (bf16_t*)(p->ws + WS_WADA); }
        else if (ti < 3456) { W = p->in[12]; ldw = 7440; K = D;   kT = 16; mapid = 1; base = 1536; Bt = (bf16_t*)(p->ws + WS_WIN); }
        else if (ti < 3712) { W = p->in[17]; ldw = D;    K = D;   kT = 16; mapid = 0; base = 3456; Bt = (bf16_t*)(p->ws + WS_WPA); }
        else if (ti < 3776) { W = p->in[18]; ldw = D;    K = 256; kT = 4;  mapid = 0; base = 3712; Bt = (bf16_t*)(p->ws + WS_WPB); }
        else if (ti < 4032) { W = p->in[19]; ldw = D;    K = D;   kT = 16; mapid = 0; base = 3776; Bt = (bf16_t*)(p->ws + WS_WOUT); }
        else if (ti < 5440) { W = p->in[20]; ldw = NUP;  K = D;   kT = 16; mapid = 2; base = 4032; Bt = (bf16_t*)(p->ws + WS_WUP); }
        else                { W = p->in[21]; ldw = D;    K = DFF; kT = 44; mapid = 0; base = 5440; Bt = (bf16_t*)(p->ws + WS_WDN); }
        const int li = ti - base, nt = li / kT, kt = li % kT;
        tr_tile(W, ldw, Bt, K, nt * 64, kt * 64, mapid, smem);
    }
    const int gtid = blockIdx.x * 512 + threadIdx.x, gsz = G * 512;
    float* bin = (float*)(p->ws + WS_BIN);
    for (int n = gtid; n < NIN; n += gsz) { const int m = map_in(n); bin[n] = m >= 0 ? p->in[13][m] : 0.f; }
    bf16_t* sc = (bf16_t*)(p->ws + WS_SC);
    for (int i = gtid; i < 256 * D; i += gsz) { const int r = i >> 10, c = i & 1023; float v = 0.f;
        if (r < 4) v = p->in[6][r * D + c]; else if (r < 132) v = p->in[7][(r - 4) * D + c];
        sc[i] = f2bf(silu_f(v)); }
}

template <class F> struct EpiF {
    static constexpr bool PERM = true, AFTER_DRAIN = false;
    F f;
    __device__ __forceinline__ void operator()(const f32x4 (&acc)[2][2][4][2], const pg8::Unit& u, int wr, int wc, int fr, int fq) const {
#pragma unroll
        for (int ai = 0; ai < 2; ++ai)
#pragma unroll
            for (int m = 0; m < 4; ++m) {
                const int row = u.pm * 256 + ai * 128 + wr * 64 + m * 16 + fr;
#pragma unroll
                for (int bj = 0; bj < 2; ++bj) { const int col = u.pn * 256 + bj * 128 + wc * 32 + 8 * fq; f(row, col, acc[ai][bj][m][0], acc[ai][bj][m][1]); }
            }
    }
};

struct FMod { float* mod; const float* bias;
    __device__ __forceinline__ void operator()(int row, int col, f32x4 a, f32x4 b) const {
        a += *(const f32x4*)(bias + col); b += *(const f32x4*)(bias + col + 4);
        float* d = mod + (size_t)row * NADA + col; *(f32x4*)d = a; *(f32x4*)(d + 4) = b; } };

struct FIn { bf16_t* proj; float* glr; const LAS float* lb; float* out;
    __device__ __forceinline__ void kvout(int row, int g, int hh, int kv, int f, f32x4 v) const {
        const int W = 128 << (2 * g);
        if (row < TP) { const int t = row & 4095, b = row >> 12; if (t >= T - W) { float* d = out + okvp(g) + ((size_t)(b * W + t - (T - W)) * 2 + kv) * 256 + hh * 64 + f; *(f32x4*)d = v; } }
        else { const int r = row - TP, db = r >> 2, s = r & 3; float* d = out + okvs(g) + ((size_t)(db * W + W - 4 + s) * 2 + kv) * 256 + hh * 64 + f; *(f32x4*)d = v; }
    }
    __device__ __forceinline__ void operator()(int row, int col, f32x4 a, f32x4 b) const {
        if (col >= C_END) return;
        a += *(const LAS f32x4*)(lb + col); b += *(const LAS f32x4*)(lb + col + 4);
        if (col >= C_GLR) { float* d = glr + (size_t)row * 16 + (col - C_GLR); *(f32x4*)d = a; *(f32x4*)(d + 4) = b; return; }
        if (col >= C_GA) {
#pragma unroll
            for (int j = 0; j < 4; ++j) { a[j] = sigm_f(a[j]); b[j] = sigm_f(b[j]); }
        } else if (col >= C_DQ && col < C_DV) {
            const int isK = col >= C_DK; const int j = col - (isK ? C_DK : C_DQ); const int head = j >> 6, i0 = (j & 63) >> 1;
            const float posf = (float)(row < TP ? (row & 4095) : 8192 + ((row - TP) & 3));
            const f32x4 inv4 = *(const LAS f32x4*)(lb + NIN + i0);
            f32x4 cs0, cs1;
            { const float r0 = __builtin_amdgcn_fractf(posf * inv4[0] * 0.15915494309189535f), r1 = __builtin_amdgcn_fractf(posf * inv4[1] * 0.15915494309189535f),
                          r2 = __builtin_amdgcn_fractf(posf * inv4[2] * 0.15915494309189535f), r3 = __builtin_amdgcn_fractf(posf * inv4[3] * 0.15915494309189535f);
              cs0[0] = __builtin_amdgcn_cosf(r0); cs0[1] = __builtin_amdgcn_sinf(r0); cs0[2] = __builtin_amdgcn_cosf(r1); cs0[3] = __builtin_amdgcn_sinf(r1);
              cs1[0] = __builtin_amdgcn_cosf(r2); cs1[1] = __builtin_amdgcn_sinf(r2); cs1[2] = __builtin_amdgcn_cosf(r3); cs1[3] = __builtin_amdgcn_sinf(r3); }
            f32x4 ra, rb;
            ra[0] = a[0] * cs0[0] - a[1] * cs0[1]; ra[1] = a[1] * cs0[0] + a[0] * cs0[1];
            ra[2] = a[2] * cs0[2] - a[3] * cs0[3]; ra[3] = a[3] * cs0[2] + a[2] * cs0[3];
            rb[0] = b[0] * cs1[0] - b[1] * cs1[1]; rb[1] = b[1] * cs1[0] + b[0] * cs1[1];
            rb[2] = b[2] * cs1[2] - b[3] * cs1[3]; rb[3] = b[3] * cs1[2] + b[2] * cs1[3];
            a = ra; b = rb;
            if (isK) { f32x4 x1, x2; x1[0] = a[0]; x1[1] = a[2]; x1[2] = b[0]; x1[3] = b[2]; x2[0] = a[1]; x2[1] = a[3]; x2[2] = b[1]; x2[3] = b[3];
                kvout(row, head >> 2, head & 3, 0, i0, x1); kvout(row, head >> 2, head & 3, 0, 32 + i0, x2); }
        } else if (col >= C_DV && col < C_GA) {
            const int j = col - C_DV, head = j >> 6, f = j & 63;
            kvout(row, head >> 2, head & 3, 1, f, a); kvout(row, head >> 2, head & 3, 1, f + 4, b);
        }
        *(u32x4*)(proj + (size_t)row * NIN + col) = pack8(a, b);
    } };

struct FPa { bf16_t* mg; const bf16_t* proj;
    __device__ __forceinline__ void operator()(int row, int col, f32x4 a, f32x4 b) const {
        f32x4 g0, g1; unpack8(*(const u32x4*)(proj + (size_t)row * NIN + C_GA + col), g0, g1);
        *(u32x4*)(mg + (size_t)row * D + col) = pack8(a * g0, b * g1); } };
struct FPb { bf16_t* mg; const bf16_t* proj;
    __device__ __forceinline__ void operator()(int row, int col, f32x4 a, f32x4 b) const {
        f32x4 g0, g1, m0, m1; unpack8(*(const u32x4*)(proj + (size_t)row * NIN + C_GB + col), g0, g1);
        unpack8(*(const u32x4*)(mg + (size_t)row * D + col), m0, m1);
        *(u32x4*)(mg + (size_t)row * D + col) = pack8(m0 + a * g0, m1 + b * g1); } };
struct FOut { bf16_t* x1; const float* xp; const float* xs; const float* mod;
    __device__ __forceinline__ void operator()(int row, int col, f32x4 a, f32x4 b) const {
        const float* xr = row < TP ? xp + (size_t)row * D + col : xs + (size_t)(row - TP) * D + col;
        const float* g = mod + (size_t)brow_of(row) * NADA + 2 * D + col;
        *(u32x4*)(x1 + (size_t)row * D + col) = pack8(*(const f32x4*)xr + *(const f32x4*)g * a, *(const f32x4*)(xr + 4) + *(const f32x4*)(g + 4) * b); } };
struct FUp { bf16_t* act;
    __device__ __forceinline__ void operator()(int row, int col, f32x4 a, f32x4 b) const {
        u32x2 w; w.x = pk2(silu_f(a[0]) * b[0], silu_f(a[1]) * b[1]); w.y = pk2(silu_f(a[2]) * b[2], silu_f(a[3]) * b[3]);
        *(u32x2*)(act + (size_t)row * DFF + (col >> 1)) = w; } };
struct FDown { bf16_t* x1; const float* mod;
    __device__ __forceinline__ void operator()(int row, int col, f32x4 a, f32x4 b) const {
        const float* g = mod + (size_t)brow_of(row) * NADA + 5 * D + col;
        bf16_t* d = x1 + (size_t)row * D + col; f32x4 x0, x4; unpack8(*(const u32x4*)d, x0, x4);
        *(u32x4*)d = pack8(x0 + *(const f32x4*)g * a, x4 + *(const f32x4*)(g + 4) * b); } };

template <class F> __device__ __forceinline__ void run_gemm(unsigned char* smem, const bf16_t* A, const bf16_t* Bt, int Mm, int Nn, int Kk, const F& f, int Gg, int cc) {
    asm volatile("" : "+s"(Kk));
    pg8::Gemm g{A, Bt, Mm, Nn, Kk}; pg8::StaticOrder S; S.init(Mm, Nn, Gg, cc);
    EpiF<F> E{f};
    pg8::gemm_phase<EpiF<F>, pg8::StaticOrder, false>((PG8_LAS unsigned char*)smem, g, S, E, nullptr);
}

__device__ void phase_norm(const float* xa, const float* xb, const float* gain, const float* mod, int sh_i, int sc_i, bf16_t* ob, float* of, int mode, const bf16_t* xh) {
    const int lane = threadIdx.x & 63, gw = blockIdx.x * 8 + (threadIdx.x >> 6), nw = gridDim.x * 8;
    for (int row = gw; row < M; row += nw) {
        const float* xr = row < TP ? xa + (size_t)row * D : xb + (size_t)(row - TP) * D;
        f32x4 v[4]; float ss = 0.f;
#pragma unroll
        for (int j = 0; j < 4; ++j) { if (xh) { const u32x2 w = *(const u32x2*)(xh + (size_t)row * D + j * 256 + lane * 4); v[j][0] = __uint_as_float(w.x << 16); v[j][1] = __uint_as_float(w.x & 0xffff0000u); v[j][2] = __uint_as_float(w.y << 16); v[j][3] = __uint_as_float(w.y & 0xffff0000u); }
            else v[j] = *(const f32x4*)(xr + j * 256 + lane * 4);
            ss += v[j][0] * v[j][0] + v[j][1] * v[j][1] + v[j][2] * v[j][2] + v[j][3] * v[j][3]; }
#pragma unroll
        for (int o = 32; o >= 1; o >>= 1) ss += __shfl_xor(ss, o);
        const float rstd = rsqrtf(ss * (1.f / D) + EPS);
        const float* mr = mod + (size_t)brow_of(row) * NADA;
#pragma unroll
        for (int j = 0; j < 4; ++j) { const int c = j * 256 + lane * 4; f32x4 y = v[j] * rstd * *(const f32x4*)(gain + c);
            if (mode == 0) { y = y * (*(const f32x4*)(mr + sc_i * D + c) + 1.f) + *(const f32x4*)(mr + sh_i * D + c);
                u32x2 w; w.x = pk2(y[0], y[1]); w.y = pk2(y[2], y[3]); *(u32x2*)(ob + (size_t)row * D + c) = w; }
            else *(f32x4*)(of + (size_t)row * D + c) = y; }
    }
}

__device__ __forceinline__ void gla_front(KP p, int row0, int h, float* LA, float* SEG) {
    const int tid = threadIdx.x; const float* glr = (const float*)(p->ws + WS_GLR);
    const float* wa = p->in[14]; const int ch = tid & 127, tg = tid >> 7;
    float* GL = SEG + 512;
    const f32x2 g2 = *(const f32x2*)(glr + (size_t)row0 * 16 + tid * 2);
    float w[16];
#pragma unroll
    for (int r = 0; r < 16; ++r) w[r] = wa[r * 512 + h * 128 + ch];
    const float bb = p->in[15][h * 128 + ch];
    *(f32x2*)(GL + tid * 2) = g2;
    __syncthreads();
    float run = 0.f;
#pragma unroll 4
    for (int i = 0; i < 16; ++i) { const int tok = tg * 16 + i; const float* g = GL + tok * 16; float z = bb;
#pragma unroll
        for (int r4 = 0; r4 < 4; ++r4) { const f32x4 g4 = *(const f32x4*)(g + r4 * 4); z += g4[0] * w[r4 * 4] + g4[1] * w[r4 * 4 + 1] + g4[2] * w[r4 * 4 + 2] + g4[3] * w[r4 * 4 + 3]; }
        const float ls = fminf(z, 0.f) - __logf(1.f + __expf(-fabsf(z)));
        run += ls * (1.f / 16.f); LA[tok * 132 + ch] = run; }
    SEG[tg * 128 + ch] = run;
    __syncthreads();
    if (tg > 0) { float off = SEG[ch]; if (tg > 1) off += SEG[128 + ch]; if (tg > 2) off += SEG[256 + ch];
#pragma unroll 4
        for (int i = 0; i < 16; ++i) LA[(tg * 16 + i) * 132 + ch] += off; }
    __syncthreads();
}
struct VRows { bf16x8 r[4]; };
__device__ __forceinline__ VRows gla_fetch_v(const bf16_t* proj, int row0, int h) {
    const int tid = threadIdx.x, t4 = tid & 15, vg = tid >> 4; VRows v;
#pragma unroll
    for (int j = 0; j < 4; ++j) v.r[j] = *(const bf16x8*)(proj + (size_t)(row0 + 4 * t4 + j) * NIN + C_GV + h * 256 + vg * 8);
    return v;
}
__device__ __forceinline__ void gla_put_vt(const VRows& v, unsigned short* VT) {
    const int tid = threadIdx.x, t4 = tid & 15, vg = tid >> 4;
#pragma unroll
    for (int e = 0; e < 8; ++e) { u32x2 w; w.x = (unsigned)(unsigned short)v.r[0][e] | ((unsigned)(unsigned short)v.r[1][e] << 16); w.y = (unsigned)(unsigned short)v.r[2][e] | ((unsigned)(unsigned short)v.r[3][e] << 16);
        *(u32x2*)(VT + (vg * 8 + e) * 72 + 4 * t4) = w; }
}

__device__ void gla_passA(KP p, unsigned char* smem, int item) {
    const int tid = threadIdx.x, lane = tid & 63, wid = tid >> 6, l15 = lane & 15, quad = lane >> 4;
    const int bh = item >> 6, n = item & 63, b = bh >> 2, h = bh & 3, row0 = b * T + n * 64;
    float* LA = (float*)smem; unsigned short* KLT = (unsigned short*)(smem + 33792); unsigned short* VT = (unsigned short*)(smem + 33792 + 18432);
    const bf16_t* proj = (const bf16_t*)(p->ws + WS_PROJ);
    const VRows vrows = gla_fetch_v(proj, row0, h);
    bf16x8 r[4];
    { const int t4 = tid & 15, cgp = (tid >> 4) & 15;
#pragma unroll
        for (int j = 0; j < 4; ++j) r[j] = *(const bf16x8*)(proj + (size_t)(row0 + 4 * t4 + j) * NIN + C_GK + h * 128 + cgp * 8); }
    gla_front(p, row0, h, LA, (float*)(smem + 118784));
    if (tid < 256) { const int t4 = tid & 15, cgp = tid >> 4;
#pragma unroll
        for (int e = 0; e < 8; ++e) { const int ch = cgp * 8 + e; const float bl = LA[63 * 132 + ch]; float kf[4];
#pragma unroll
            for (int j = 0; j < 4; ++j) kf[j] = bf2f((unsigned short)r[j][e]) * __expf(bl - LA[(4 * t4 + j) * 132 + ch]);
            u32x2 w; w.x = pk2(kf[0], kf[1]); w.y = pk2(kf[2], kf[3]); *(u32x2*)(KLT + ch * 72 + 4 * t4) = w; } }
    gla_put_vt(vrows, VT);
    if (tid < 128) ((float*)(p->ws + WS_DEC))[item * 128 + tid] = __expf(LA[63 * 132 + tid]);
    __syncthreads();
    f32x4 acc[2][8];
#pragma unroll
    for (int i = 0; i < 2; ++i)
#pragma unroll
        for (int j = 0; j < 8; ++j) acc[i][j] = (f32x4){0.f, 0.f, 0.f, 0.f};
#pragma unroll
    for (int ks = 0; ks < 2; ++ks) { bf16x8 a[2];
#pragma unroll
        for (int mt = 0; mt < 2; ++mt) a[mt] = *(const bf16x8*)(VT + (32 * wid + 16 * mt + l15) * 72 + ks * 32 + quad * 8);
#pragma unroll
        for (int nt = 0; nt < 8; ++nt) { const bf16x8 bb = *(const bf16x8*)(KLT + (16 * nt + l15) * 72 + ks * 32 + quad * 8);
#pragma unroll
            for (int mt = 0; mt < 2; ++mt) acc[mt][nt] = mfma16(a[mt], bb, acc[mt][nt]); } }
    bf16_t* U = (bf16_t*)(p->ws + WS_U) + (size_t)item * 32768;
#pragma unroll
    for (int mt = 0; mt < 2; ++mt)
#pragma unroll
        for (int nt = 0; nt < 8; ++nt)
#pragma unroll
            for (int e = 0; e < 4; ++e) U[(32 * wid + 16 * mt + quad * 4 + e) * 128 + 16 * nt + l15] = f2bf(acc[mt][nt][e]);
    __syncthreads();
}

__device__ void gla_passC(KP p, unsigned char* smem, int item) {
    const int tid = threadIdx.x, lane = tid & 63, wid = tid >> 6, l15 = lane & 15, quad = lane >> 4;
    const int bh = item >> 6, n = item & 63, b = bh >> 2, h = bh & 3, row0 = b * T + n * 64;
    float* LA = (float*)smem; unsigned short* QG = (unsigned short*)(smem + 33792); unsigned short* KD = (unsigned short*)(smem + 51200);
    unsigned short* VT = (unsigned short*)(smem + 68608); unsigned short* ATT = (unsigned short*)(smem + 105472); float* RED = (float*)(smem + 114688);
    const bf16_t* proj = (const bf16_t*)(p->ws + WS_PROJ);
    const VRows vrows = gla_fetch_v(proj, row0, h);
    bf16x8 q8s[2], k8s[2];
#pragma unroll
    for (int it = 0; it < 2; ++it) { const int idx = tid + it * 512, cgp = idx & 15, tok = idx >> 4;
        q8s[it] = *(const bf16x8*)(proj + (size_t)(row0 + tok) * NIN + C_GQ + h * 128 + cgp * 8); k8s[it] = *(const bf16x8*)(proj + (size_t)(row0 + tok) * NIN + C_GK + h * 128 + cgp * 8); }
    const bf16_t* sst = (const bf16_t*)(p->ws + WS_SST) + (size_t)item * 32768;
    bf16x8 bsall[4][2];
#pragma unroll
    for (int ks = 0; ks < 4; ++ks)
#pragma unroll
        for (int nt = 0; nt < 2; ++nt) bsall[ks][nt] = *(const bf16x8*)(sst + (32 * wid + 16 * nt + l15) * 128 + ks * 32 + quad * 8);
    gla_front(p, row0, h, LA, (float*)(smem + 118784));
#pragma unroll
    for (int it = 0; it < 2; ++it) { const int idx = tid + it * 512, cgp = idx & 15, tok = idx >> 4;
        const bf16x8 q8 = q8s[it], k8 = k8s[it];
        f32x4 qa, qb, ka, kb;
#pragma unroll
        for (int e = 0; e < 8; ++e) { const float bc = LA[tok * 132 + cgp * 8 + e];
            const float qf = bf2f((unsigned short)q8[e]) * 0.08838834764831845f * __expf(bc), kf = bf2f((unsigned short)k8[e]) * __expf(-bc);
            if (e < 4) { qa[e] = qf; ka[e] = kf; } else { qb[e - 4] = qf; kb[e - 4] = kf; } }
        *(u32x4*)(QG + tok * 136 + cgp * 8) = pack8(qa, qb); *(u32x4*)(KD + tok * 136 + cgp * 8) = pack8(ka, kb); }
    gla_put_vt(vrows, VT);
    __syncthreads();
    { const int mt = wid >> 1; f32x4 c2[2] = {(f32x4){0.f, 0.f, 0.f, 0.f}, (f32x4){0.f, 0.f, 0.f, 0.f}};
#pragma unroll
        for (int ks = 0; ks < 4; ++ks) { const bf16x8 a = *(const bf16x8*)(QG + (16 * mt + l15) * 136 + ks * 32 + quad * 8);
#pragma unroll
            for (int j = 0; j < 2; ++j) { const int nt = 2 * (wid & 1) + j; const bf16x8 bb = *(const bf16x8*)(KD + (16 * nt + l15) * 136 + ks * 32 + quad * 8); c2[j] = mfma16(a, bb, c2[j]); } }
#pragma unroll
        for (int j = 0; j < 2; ++j)
#pragma unroll
            for (int e = 0; e < 4; ++e) { const int c = 16 * mt + quad * 4 + e, s = 16 * (2 * (wid & 1) + j) + l15; ATT[c * 72 + s] = f2bf(s <= c ? c2[j][e] : 0.f); } }
    __syncthreads();
    f32x4 o[4][2];
#pragma unroll
    for (int i = 0; i < 4; ++i)
#pragma unroll
        for (int j = 0; j < 2; ++j) o[i][j] = (f32x4){0.f, 0.f, 0.f, 0.f};
#pragma unroll
    for (int ks = 0; ks < 2; ++ks) { bf16x8 bv[2];
#pragma unroll
        for (int nt = 0; nt < 2; ++nt) bv[nt] = *(const bf16x8*)(VT + (32 * wid + 16 * nt + l15) * 72 + ks * 32 + quad * 8);
#pragma unroll
        for (int mt = 0; mt < 4; ++mt) { const bf16x8 a = *(const bf16x8*)(ATT + (16 * mt + l15) * 72 + ks * 32 + quad * 8);
#pragma unroll
            for (int nt = 0; nt < 2; ++nt) o[mt][nt] = mfma16(a, bv[nt], o[mt][nt]); } }
#pragma unroll
    for (int ks = 0; ks < 4; ++ks) { bf16x8 bs[2];
#pragma unroll
        for (int nt = 0; nt < 2; ++nt) bs[nt] = bsall[ks][nt];
#pragma unroll
        for (int mt = 0; mt < 4; ++mt) { const bf16x8 a = *(const bf16x8*)(QG + (16 * mt + l15) * 136 + ks * 32 + quad * 8);
#pragma unroll
            for (int nt = 0; nt < 2; ++nt) o[mt][nt] = mfma16(a, bs[nt], o[mt][nt]); } }
#pragma unroll
    for (int mt = 0; mt < 4; ++mt)
#pragma unroll
        for (int e = 0; e < 4; ++e) { float ss = o[mt][0][e] * o[mt][0][e] + o[mt][1][e] * o[mt][1][e];
            ss += __shfl_xor(ss, 1); ss += __shfl_xor(ss, 2); ss += __shfl_xor(ss, 4); ss += __shfl_xor(ss, 8);
            if (l15 == 0) RED[(16 * mt + quad * 4 + e) * 8 + wid] = ss; }
    __syncthreads();
    bf16_t* oa = (bf16_t*)(p->ws + WS_OA); const float* gng = p->in[16];
    unsigned short* OS = (unsigned short*)smem;
#pragma unroll
    for (int mt = 0; mt < 4; ++mt)
#pragma unroll
        for (int e = 0; e < 4; ++e) { const int c = 16 * mt + quad * 4 + e; const f32x4 r0 = *(const f32x4*)(RED + c * 8), r1 = *(const f32x4*)(RED + c * 8 + 4);
            const float tot = (r0[0] + r0[1]) + (r0[2] + r0[3]) + (r1[0] + r1[1]) + (r1[2] + r1[3]); const float rstd = rsqrtf(tot * (1.f / 256.f) + EPS);
#pragma unroll
            for (int nt = 0; nt < 2; ++nt) OS[c * 264 + 32 * wid + 16 * nt + l15] = f2bf(o[mt][nt][e] * rstd); }
    __syncthreads();
#pragma unroll
    for (int it = 0; it < 4; ++it) { const int idx = tid + it * 512, c = idx >> 5, d8 = (idx & 31) * 8;
        f32x4 o0, o1, s0, s1; unpack8(*(const u32x4*)(OS + c * 264 + d8), o0, o1);
        unpack8(*(const u32x4*)(proj + (size_t)(row0 + c) * NIN + C_GR + h * 256 + d8), s0, s1);
        const f32x4 g0 = *(const f32x4*)(gng + d8), g1 = *(const f32x4*)(gng + d8 + 4);
#pragma unroll
        for (int j = 0; j < 4; ++j) { s0[j] = silu_f(s0[j]); s1[j] = silu_f(s1[j]); }
        *(u32x4*)(oa + (size_t)(row0 + c) * D + h * 256 + d8) = pack8(o0 * g0 * s0, o1 * g1 * s1); }
    __syncthreads();
}

__device__ void gla_passB(KP p) {
    const int gtid = blockIdx.x * 512 + threadIdx.x, gsz = gridDim.x * 512;
    const bf16_t* U = (const bf16_t*)(p->ws + WS_U); const float* DEC = (const float*)(p->ws + WS_DEC); bf16_t* SST = (bf16_t*)(p->ws + WS_SST);
    for (int e4 = gtid; e4 < 131072; e4 += gsz) {
        const int bh = e4 >> 13, dv = (e4 >> 5) & 255, dk4 = (e4 & 31) * 4;
        f32x4 S = (f32x4){0.f, 0.f, 0.f, 0.f};
#pragma unroll 4
        for (int n = 0; n < 64; ++n) { const int item = bh * 64 + n; const size_t off = (size_t)item * 32768 + dv * 128 + dk4;
            u32x2 w; w.x = pk2(S[0], S[1]); w.y = pk2(S[2], S[3]); *(u32x2*)(SST + off) = w;
            const u32x2 ub = *(const u32x2*)(U + off); const f32x4 d4 = *(const f32x4*)(DEC + item * 128 + dk4);
            f32x4 u4; u4[0] = __uint_as_float(ub.x << 16); u4[1] = __uint_as_float(ub.x & 0xffff0000u); u4[2] = __uint_as_float(ub.y << 16); u4[3] = __uint_as_float(ub.y & 0xffff0000u);
            S = d4 * S + u4; }
#pragma unroll
        for (int j = 0; j < 4; ++j) p->out[O_SGP + ((size_t)(bh * 128 + dk4 + j)) * 256 + dv] = S[j];
    }
}

__device__ void gla_sample(KP p, unsigned char* smem, int item) {
    const int tid = threadIdx.x, lane = tid & 63, wid = tid >> 6;
    const int db = item >> 2, h = item & 3, row0 = TP + db * 4;
    float* BC = (float*)smem;
    float* QG = BC + 512; float* KD = QG + 512; float* KL = KD + 512; float* DECs = KL + 512;
    float* V = DECs + 128;
    float* ATT = V + 1024;
    float* RS = ATT + 16;
    float* RED = RS + 16;
    const bf16_t* proj = (const bf16_t*)(p->ws + WS_PROJ); const float* glr = (const float*)(p->ws + WS_GLR);
    const int tok = tid >> 7, ch = tid & 127;
    { float z = p->in[15][h * 128 + ch]; const float* g = glr + (size_t)(row0 + tok) * 16;
#pragma unroll
        for (int r = 0; r < 16; ++r) z += g[r] * p->in[14][r * 512 + h * 128 + ch];
        BC[tok * 128 + ch] = (fminf(z, 0.f) - __logf(1.f + __expf(-fabsf(z)))) * (1.f / 16.f); }
    __syncthreads();
    if (tid < 128) { float s = 0.f;
#pragma unroll
        for (int t = 0; t < 4; ++t) { s += BC[t * 128 + tid]; BC[t * 128 + tid] = s; } }
    __syncthreads();
    { const float bc = BC[tok * 128 + ch], bl = BC[3 * 128 + ch];
        const float q = bf2f(proj[(size_t)(row0 + tok) * NIN + C_GQ + h * 128 + ch]), k = bf2f(proj[(size_t)(row0 + tok) * NIN + C_GK + h * 128 + ch]);
        QG[tok * 128 + ch] = q * 0.08838834764831845f * __expf(bc); KD[tok * 128 + ch] = k * __expf(-bc); KL[tok * 128 + ch] = k * __expf(bl - bc);
        if (tok == 0) DECs[ch] = __expf(bl);
#pragma unroll
        for (int j = 0; j < 2; ++j) { const int i = tid + j * 512, t2 = i >> 8, dv = i & 255; V[i] = bf2f(proj[(size_t)(row0 + t2) * NIN + C_GV + h * 256 + dv]); } }
    __syncthreads();
    {
#pragma unroll
        for (int j = 0; j < 2; ++j) { const int pr = wid + 8 * j, c = pr >> 2, s = pr & 3;
            float d = QG[c * 128 + lane] * KD[s * 128 + lane] + QG[c * 128 + 64 + lane] * KD[s * 128 + 64 + lane];
#pragma unroll
            for (int o = 32; o >= 1; o >>= 1) d += __shfl_xor(d, o);
            if (lane == 0) ATT[pr] = s <= c ? d : 0.f; } }
    __syncthreads();
    const int dvq = lane * 4;
    f32x4 v4[4], inter[4];
#pragma unroll
    for (int t = 0; t < 4; ++t) { v4[t] = *(const f32x4*)(V + t * 256 + dvq); inter[t] = (f32x4){0.f, 0.f, 0.f, 0.f}; }
    const float* S0 = p->in[2] + (size_t)(db * 4 + h) * 32768; float* S1 = p->out + O_SGS + (size_t)(db * 4 + h) * 32768;
#pragma unroll 4
    for (int it = 0; it < 16; ++it) { const int dk = it * 8 + wid;
        const f32x4 s4 = __builtin_nontemporal_load((const f32x4*)(S0 + dk * 256 + dvq));
        f32x4 nw = s4 * DECs[dk];
#pragma unroll
        for (int t = 0; t < 4; ++t) { inter[t] += s4 * QG[t * 128 + dk]; nw += v4[t] * KL[t * 128 + dk]; }
        __builtin_nontemporal_store(nw, (f32x4*)(S1 + dk * 256 + dvq)); }
#pragma unroll
    for (int t = 0; t < 4; ++t) *(f32x4*)(RED + (wid * 4 + t) * 256 + dvq) = inter[t];
    __syncthreads();
    { const int dv2 = (tid & 127) * 2; float o0 = 0.f, o1 = 0.f;
#pragma unroll
        for (int w = 0; w < 8; ++w) { const f32x2 r = *(const f32x2*)(RED + (w * 4 + tok) * 256 + dv2); o0 += r[0]; o1 += r[1]; }
#pragma unroll
        for (int s = 0; s < 4; ++s) { const float a = ATT[tok * 4 + s]; o0 += a * V[s * 256 + dv2]; o1 += a * V[s * 256 + dv2 + 1]; }
        float ss = o0 * o0 + o1 * o1;
#pragma unroll
        for (int o = 32; o >= 1; o >>= 1) ss += __shfl_xor(ss, o);
        if (lane == 0) RS[wid] = ss;
        __syncthreads();
        const float rstd = rsqrtf((RS[2 * tok] + RS[2 * tok + 1]) * (1.f / 256.f) + EPS);
        const int row = row0 + tok; const float* gng = p->in[16];
        const float y0 = o0 * rstd * gng[dv2] * silu_f(bf2f(proj[(size_t)row * NIN + C_GR + h * 256 + dv2]));
        const float y1 = o1 * rstd * gng[dv2 + 1] * silu_f(bf2f(proj[(size_t)row * NIN + C_GR + h * 256 + dv2 + 1]));
        *(unsigned*)((bf16_t*)(p->ws + WS_OA) + (size_t)row * D + h * 256 + dv2) = pk2(y0, y1); }
    __syncthreads();
}

__device__ void dsw_prompt(KP p, unsigned char* smem, int item) {
    const int tid = threadIdx.x, lane = tid & 63, wid = tid >> 6, l15 = lane & 15, quad = lane >> 4;
    const int blk = item & 31, gh = (item >> 5) % 12, b = item / 384;
    const int g = gh >> 2, dil = 1 << (2 * g), nbc = 32 >> (2 * g);
    const int r = blk / nbc, l0 = (blk % nbc) * 128;
    unsigned short* KS = (unsigned short*)smem;
    unsigned short* VT = (unsigned short*)(smem + 39168);
    unsigned short* PS = (unsigned short*)(smem + 75008) + wid * (16 * 168);
    const bf16_t* proj = (const bf16_t*)(p->ws + WS_PROJ);
    const int qrow = b * T + (l0 + 16 * wid + l15) * dil + r;
    bf16x8 qa[2];
#pragma unroll
    for (int ks = 0; ks < 2; ++ks) qa[ks] = *(const bf16x8*)(proj + (size_t)qrow * NIN + C_DQ + gh * 64 + ks * 32 + quad * 8);
    u32x4 kreg[5];
#pragma unroll
    for (int it = 0; it < 5; ++it) { const int idx = tid + it * 512, i = idx >> 3, c8 = idx & 7, l = l0 - 144 + i; kreg[it] = (u32x4){0u, 0u, 0u, 0u};
        if (idx < 2176 && l >= 0) kreg[it] = *(const u32x4*)(proj + (size_t)(b * T + l * dil + r) * NIN + C_DK + gh * 64 + c8 * 8); }
    bf16x8 vreg[2][4];
#pragma unroll
    for (int it = 0; it < 2; ++it) { const int idx = tid + it * 512, c8 = idx / 68, i = 4 * (idx - c8 * 68), l = l0 - 144 + i;
#pragma unroll
        for (int j = 0; j < 4; ++j) { vreg[it][j] = (bf16x8){0, 0, 0, 0, 0, 0, 0, 0}; if (idx < 544 && l >= 0) vreg[it][j] = *(const bf16x8*)(proj + (size_t)(b * T + (l + j) * dil + r) * NIN + C_DV + gh * 64 + c8 * 8); } }
#pragma unroll
    for (int it = 0; it < 5; ++it) { const int idx = tid + it * 512, i = idx >> 3, c8 = idx & 7; if (idx < 2176) *(u32x4*)(KS + i * 72 + c8 * 8) = kreg[it]; }
#pragma unroll
    for (int it = 0; it < 2; ++it) { const int idx = tid + it * 512, c8 = idx / 68, i = 4 * (idx - c8 * 68);
        if (idx < 544) {
#pragma unroll
            for (int e = 0; e < 8; ++e) { u32x2 w; w.x = (unsigned)(unsigned short)vreg[it][0][e] | ((unsigned)(unsigned short)vreg[it][1][e] << 16); w.y = (unsigned)(unsigned short)vreg[it][2][e] | ((unsigned)(unsigned short)vreg[it][3][e] << 16);
                *(u32x2*)(VT + (c8 * 8 + e) * 280 + i) = w; } } }
    __syncthreads();
    f32x4 s[9];
#pragma unroll
    for (int kt = 0; kt < 9; ++kt) { s[kt] = (f32x4){0.f, 0.f, 0.f, 0.f};
#pragma unroll
        for (int ks = 0; ks < 2; ++ks) { const bf16x8 bb = *(const bf16x8*)(KS + (16 * wid + 16 * (kt + 1) + l15) * 72 + ks * 32 + quad * 8); s[kt] = mfma16(qa[ks], bb, s[kt]); } }
    float mx[4] = {-INFINITY, -INFINITY, -INFINITY, -INFINITY};
#pragma unroll
    for (int kt = 0; kt < 9; ++kt)
#pragma unroll
        for (int e = 0; e < 4; ++e) { const int dist = 144 + quad * 4 + e - 16 * (kt + 1) - l15, lk = l0 - 144 + 16 * wid + 16 * (kt + 1) + l15;
            const bool valid = dist >= 0 && dist <= 128 && lk >= 0; const float v = valid ? s[kt][e] * 0.125f : -INFINITY; s[kt][e] = v; mx[e] = fmaxf(mx[e], v); }
#pragma unroll
    for (int e = 0; e < 4; ++e) { mx[e] = fmaxf(mx[e], __shfl_xor(mx[e], 1)); mx[e] = fmaxf(mx[e], __shfl_xor(mx[e], 2)); mx[e] = fmaxf(mx[e], __shfl_xor(mx[e], 4)); mx[e] = fmaxf(mx[e], __shfl_xor(mx[e], 8)); }
    float den[4] = {0.f, 0.f, 0.f, 0.f};
#pragma unroll
    for (int e = 0; e < 4; ++e) PS[(quad * 4 + e) * 168 + l15] = 0;
#pragma unroll
    for (int kt = 0; kt < 9; ++kt)
#pragma unroll
        for (int e = 0; e < 4; ++e) { const float pe = __expf(s[kt][e] - mx[e]); den[e] += pe; PS[(quad * 4 + e) * 168 + 16 * (kt + 1) + l15] = f2bf(pe); }
#pragma unroll
    for (int e = 0; e < 4; ++e) { den[e] += __shfl_xor(den[e], 1); den[e] += __shfl_xor(den[e], 2); den[e] += __shfl_xor(den[e], 4); den[e] += __shfl_xor(den[e], 8); }
    __syncthreads();
    f32x4 o[4];
#pragma unroll
    for (int dt = 0; dt < 4; ++dt) o[dt] = (f32x4){0.f, 0.f, 0.f, 0.f};
#pragma unroll
    for (int ks = 0; ks < 5; ++ks) { const bf16x8 a = *(const bf16x8*)(PS + l15 * 168 + ks * 32 + quad * 8);
#pragma unroll
        for (int dt = 0; dt < 4; ++dt) { const bf16x8 bb = *(const bf16x8*)(VT + (16 * dt + l15) * 280 + 16 * wid + ks * 32 + quad * 8); o[dt] = mfma16(a, bb, o[dt]); } }
    bf16_t* og = (bf16_t*)(p->ws + WS_OG); float* lse = (float*)(p->ws + WS_LSE);
#pragma unroll
    for (int e = 0; e < 4; ++e) { const int tk = b * T + (l0 + 16 * wid + quad * 4 + e) * dil + r; const float inv = 1.f / den[e];
#pragma unroll
        for (int dt = 0; dt < 4; ++dt) og[(size_t)tk * 768 + gh * 64 + 16 * dt + l15] = f2bf(o[dt][e] * inv);
        if (l15 == 0) lse[tk * 12 + gh] = mx[e] + __logf(den[e]); }
    __syncthreads();
}

__device__ void dsw_combine(KP p) {
    const int gtid = blockIdx.x * 512 + threadIdx.x, gsz = gridDim.x * 512;
    const bf16_t* og = (const bf16_t*)(p->ws + WS_OG); const float* lse = (const float*)(p->ws + WS_LSE); bf16_t* ob = (bf16_t*)(p->ws + WS_OB);
    for (int idx = gtid; idx < TP * 32; idx += gsz) { const int d8 = idx & 7, hh = (idx >> 3) & 3, tk = idx >> 5;
        const float l0 = lse[tk * 12 + hh], l1 = lse[tk * 12 + 4 + hh], l2 = lse[tk * 12 + 8 + hh];
        const float mx = fmaxf(l0, fmaxf(l1, l2)); float w0 = __expf(l0 - mx), w1 = __expf(l1 - mx), w2 = __expf(l2 - mx); const float inv = 1.f / (w0 + w1 + w2); w0 *= inv; w1 *= inv; w2 *= inv;
        f32x4 a0, b0, a1, b1, a2, b2;
        unpack8(*(const u32x4*)(og + (size_t)tk * 768 + hh * 64 + d8 * 8), a0, b0);
        unpack8(*(const u32x4*)(og + (size_t)tk * 768 + (4 + hh) * 64 + d8 * 8), a1, b1);
        unpack8(*(const u32x4*)(og + (size_t)tk * 768 + (8 + hh) * 64 + d8 * 8), a2, b2);
        *(u32x4*)(ob + (size_t)tk * 256 + hh * 64 + d8 * 8) = pack8(a0 * w0 + a1 * w1 + a2 * w2, b0 * w0 + b1 * w1 + b2 * w2); }
}

__device__ void dsw_sample(KP p, unsigned char* smem, int witem) {
    const int lane = threadIdx.x & 63, wid = threadIdx.x >> 6;
    float* qs = (float*)smem + wid * 256; float* ps = qs + 64;
    const int s = witem & 3, hh = (witem >> 2) & 3, db = witem >> 4, row = TP + db * 4 + s;
    const bf16_t* proj = (const bf16_t*)(p->ws + WS_PROJ);
    float rmx = -INFINITY, rws = 0.f; f32x4 racc = (f32x4){0.f, 0.f, 0.f, 0.f};
    const int ksl = lane >> 2, part = lane & 3, kq = lane >> 4, d4 = (lane & 15) * 4;
#pragma unroll 1
    for (int g = 0; g < 3; ++g) {
        const int W = 128 << (2 * g), dil = 1 << (2 * g);
        const float* cache = p->in[3 + g] + (size_t)db * W * 512 + hh * 64;
        const float* kvn = p->out + okvs(g) + (size_t)(db * W + W - 4) * 512 + hh * 64;
        qs[lane] = bf2f(proj[(size_t)row * NIN + C_DQ + (g * 4 + hh) * 64 + 2 * (lane & 31) + (lane >> 5)]);
        __builtin_amdgcn_wave_barrier();
        f32x4 q4[4];
#pragma unroll
        for (int c = 0; c < 4; ++c) q4[c] = *(const f32x4*)(qs + part * 16 + c * 4);
#pragma unroll 5
        for (int pi = 0; pi < 9; ++pi) { const int j = pi * 16 + ksl; float dot = 0.f;
            if (j <= 128) { const int idx = W + s - j * dil; const float* kr = (idx >= W ? kvn + (size_t)(idx - W) * 512 : cache + (size_t)idx * 512) + part * 16;
#pragma unroll
                for (int c = 0; c < 4; ++c) { const f32x4 k4 = *(const f32x4*)(kr + c * 4); dot += k4[0] * q4[c][0] + k4[1] * q4[c][1] + k4[2] * q4[c][2] + k4[3] * q4[c][3]; } }
            dot += __shfl_xor(dot, 1); dot += __shfl_xor(dot, 2);
            if (part == 0 && j <= 128) ps[j] = dot * 0.125f; }
        __builtin_amdgcn_wave_barrier();
        float sc[3]; float m = -INFINITY;
#pragma unroll
        for (int jj = 0; jj < 3; ++jj) { const int j = lane + 64 * jj; sc[jj] = j <= 128 ? ps[j] : -INFINITY; m = fmaxf(m, sc[jj]); }
#pragma unroll
        for (int o = 32; o >= 1; o >>= 1) m = fmaxf(m, __shfl_xor(m, o));
        float den = 0.f;
        __builtin_amdgcn_wave_barrier();
#pragma unroll
        for (int jj = 0; jj < 3; ++jj) { const int j = lane + 64 * jj; if (j <= 128) { const float e = __expf(sc[jj] - m); den += e; ps[j] = e; } }
#pragma unroll
        for (int o = 32; o >= 1; o >>= 1) den += __shfl_xor(den, o);
        __builtin_amdgcn_wave_barrier();
        f32x4 o = (f32x4){0.f, 0.f, 0.f, 0.f};
#pragma unroll 17
        for (int jt = 0; jt < 33; ++jt) { const int j = jt * 4 + kq;
            if (j <= 128) { const int idx = W + s - j * dil; const float* vr = (idx >= W ? kvn + (size_t)(idx - W) * 512 : cache + (size_t)idx * 512) + 256 + d4;
                o += *(const f32x4*)vr * ps[j]; } }
#pragma unroll
        for (int c = 0; c < 4; ++c) { o[c] += __shfl_xor(o[c], 16); o[c] += __shfl_xor(o[c], 32); }
        const float lg = m + __logf(den), nm = fmaxf(rmx, lg), sc_old = __expf(rmx - nm), wg = __expf(lg - nm);
        racc = racc * sc_old + o * (wg / den); rws = rws * sc_old + wg; rmx = nm;
        __builtin_amdgcn_wave_barrier();
    }
    if (lane < 16) { const float inv = 1.f / rws; u32x2 w; w.x = pk2(racc[0] * inv, racc[1] * inv); w.y = pk2(racc[2] * inv, racc[3] * inv);
        *(u32x2*)((bf16_t*)(p->ws + WS_OB) + (size_t)row * 256 + hh * 64 + d4) = w; }
}

constexpr unsigned NCH0 = 496, NCH1 = 2032, NCH2 = 8176, NCHUNK = NCH0 + NCH1 + NCH2;
__device__ __forceinline__ void half_where(KP p, unsigned c, const f32x4*& src, f32x4*& dst, unsigned& cl, unsigned& per) {
    if (c < NCH0) { src = (const f32x4*)p->in[3]; dst = (f32x4*)(p->out + O_KVS0); cl = c; per = 124u * 128u; }
    else if (c < NCH0 + NCH1) { src = (const f32x4*)p->in[4]; dst = (f32x4*)(p->out + O_KVS1); cl = c - NCH0; per = 508u * 128u; }
    else { src = (const f32x4*)p->in[5]; dst = (f32x4*)(p->out + O_KVS2); cl = c - NCH0 - NCH1; per = 2044u * 128u; }
}
#define HALF_LOAD(H, c) do { const f32x4* src_; f32x4* dst_; unsigned cl_, per_; half_where(p, (c), src_, dst_, cl_, per_); \
    const unsigned i0_ = cl_ * 4096u + threadIdx.x, db0_ = i0_ / per_, rem0_ = i0_ - db0_ * per_; \
    _Pragma("unroll") for (int u = 0; u < 8; ++u) { const unsigned rem_ = rem0_ + u * 512u; H##d[u] = i0_ + u * 512u + 512u * (db0_ + (rem_ >= per_ ? 1u : 0u)); H##v[u] = __builtin_nontemporal_load(src_ + H##d[u] + 512u); } } while (0)
#define HALF_STORE(H, c) do { const f32x4* src_; f32x4* dst_; unsigned cl_, per_; half_where(p, (c), src_, dst_, cl_, per_); \
    _Pragma("unroll") for (int u = 0; u < 8; ++u) __builtin_nontemporal_store(H##v[u], dst_ + H##d[u]); } while (0)
__device__ __forceinline__ unsigned copier_claim(unsigned* ctl, int done_slot, unsigned need) {
    const bool stop = need != 0u && __hip_atomic_load(ctl + 32 * done_slot, __ATOMIC_RELAXED, __HIP_MEMORY_SCOPE_AGENT) >= need;
    return stop ? 0xffffffffu : __hip_atomic_fetch_add(ctl, 1u, __ATOMIC_RELAXED, __HIP_MEMORY_SCOPE_AGENT);
}
__device__ void copier(KP p, int done_slot, unsigned need, unsigned char* smem) {
    unsigned* ctl = (unsigned*)(p->ws + WS_CTL); volatile unsigned* sh = (volatile unsigned*)smem;
    f32x4 Av[8], Bv[8]; unsigned Ad[8], Bd[8];
    __syncthreads();
    if (threadIdx.x == 0) sh[0] = copier_claim(ctl, done_slot, need);
    __syncthreads();
    unsigned ca = sh[0];
    if (ca >= NCHUNK) return;
    HALF_LOAD(A, ca);
    for (;;) {
        __syncthreads();
        if (threadIdx.x == 0) sh[0] = copier_claim(ctl, done_slot, need);
        __syncthreads();
        const unsigned cb = sh[0];
        if (cb < NCHUNK) HALF_LOAD(B, cb);
        HALF_STORE(A, ca);
        if (cb >= NCHUNK) break;
        __syncthreads();
        if (threadIdx.x == 0) sh[0] = copier_claim(ctl, done_slot, need);
        __syncthreads();
        ca = sh[0];
        if (ca < NCHUNK) HALF_LOAD(A, ca);
        HALF_STORE(B, cb);
        if (ca >= NCHUNK) break;
    }
}
__device__ __forceinline__ void gemm_done(KP p, int done_slot) {
    __syncthreads();
    if (threadIdx.x == 0) __hip_atomic_fetch_add((unsigned*)(p->ws + WS_CTL) + 32 * done_slot, 1u, __ATOMIC_RELAXED, __HIP_MEMORY_SCOPE_AGENT);
}

__global__ void __launch_bounds__(512) fwd(Params pv) {
    extern __shared__ __attribute__((aligned(16))) unsigned char smem[];
    cg::grid_group grid = cg::this_grid();
    const int G = gridDim.x, bid = blockIdx.x;
    constexpr int C3 = 8, C10 = 8, CN = 120;
#define WSP(T, off) ((T*)(p->ws + (off)))
    if (threadIdx.x < 4) ((volatile LAS unsigned*)(smem + 131072))[threadIdx.x] = 0u;
    __syncthreads();
    const XcdBarrier xbar = xcd_barrier_post((unsigned*)(pv.ws + WS_BAR), (volatile LAS unsigned*)(smem + 131072));
    if (pv.ws == nullptr) grid.sync();
    { KP p = kargs(); if (PHMASK & 1) phase_prep(p, smem); }
    xcd_barrier(xbar);
    { KP p = kargs(); if (bid < 24) { run_gemm(smem, WSP(const bf16_t, WS_SC), WSP(const bf16_t, WS_WADA), 256, NADA, D, FMod{WSP(float, WS_MOD), p->in[11]}, 24, bid); gemm_done(p, 1); } else copier(p, 1, 1u, smem); }
    xcd_barrier(xbar);
    { KP p = kargs(); if (PHMASK & 4) phase_norm(p->in[0], p->in[1], p->in[8], WSP(const float, WS_MOD), 0, 1, WSP(bf16_t, WS_H), nullptr, 0, nullptr); }
    xcd_barrier(xbar);
    { KP p = kargs(); if (bid >= C3) {
        LAS float* lb = (LAS float*)(smem + LDS_XTRA);
        for (int i = threadIdx.x; i < NIN + 32; i += 512) { float v;
            if (i < NIN) v = WSP(const float, WS_BIN)[i];
            else { double inv = 1.0; for (int q = 0; q < i - NIN; ++q) inv *= 0.74989420933245582730; v = (float)inv; }
            lb[i] = v; }
        __syncthreads();
        run_gemm(smem, WSP(const bf16_t, WS_H), WSP(const bf16_t, WS_WIN), M, NIN, D, FIn{WSP(bf16_t, WS_PROJ), WSP(float, WS_GLR), lb, p->out}, G - C3, bid - C3); gemm_done(p, 2); } else copier(p, 2, 5u, smem); }
    xcd_barrier(xbar);
    { KP p = kargs();
      unsigned* qctr = (unsigned*)(p->ws + WS_CTL) + 32 * 7; volatile unsigned* shq = (volatile unsigned*)(smem + 131072 + 8);
      for (;;) {
          __syncthreads();
          if (threadIdx.x == 0) shq[0] = __hip_atomic_fetch_add(qctr, 1u, __ATOMIC_RELAXED, __HIP_MEMORY_SCOPE_AGENT);
          __syncthreads();
          const int k = (int)shq[0]; if (k >= 3328) break;
          const int q = k / 13, r = k - q * 13;
          if ((r & 3) == 0 && r < 12) { const int si = 3 * q + (r >> 2);
              if (si < 256) dsw_sample(p, smem, si * 8 + (int)(threadIdx.x >> 6)); else gla_sample(p, smem, si - 256); }
          else { const int pi = 10 * q + r - ((r + 3) >> 2);
              if (pi < 1536) dsw_prompt(p, smem, pi); else gla_passA(p, smem, pi - 1536); }
      } }
    xcd_barrier(xbar);
    { KP p = kargs(); if (PHMASK & 512) gla_passB(p); }
    xcd_barrier(xbar);
    { KP p = kargs(); if (PHMASK & 1024) dsw_combine(p); }
    { KP p = kargs(); if (PHMASK & 2048) for (int it = bid; it < 1024; it += G) gla_passC(p, smem, it); }
    xcd_barrier(xbar);
    { KP p = kargs(); if (bid >= CN) { run_gemm(smem, WSP(const bf16_t, WS_OA), WSP(const bf16_t, WS_WPA), M, D, D, FPa{WSP(bf16_t, WS_MG), WSP(const bf16_t, WS_PROJ)}, G - CN, bid - CN); } }
    { KP p = kargs(); if (bid >= CN) { run_gemm(smem, WSP(const bf16_t, WS_OB), WSP(const bf16_t, WS_WPB), M, D, 256, FPb{WSP(bf16_t, WS_MG), WSP(const bf16_t, WS_PROJ)}, G - CN, bid - CN); gemm_done(p, 3); } else copier(p, 3, 9u, smem); }
    xcd_barrier(xbar);
    { KP p = kargs(); if (bid >= CN) { run_gemm(smem, WSP(const bf16_t, WS_MG), WSP(const bf16_t, WS_WOUT), M, D, D, FOut{WSP(bf16_t, WS_X1), p->in[0], p->in[1], WSP(const float, WS_MOD)}, G - CN, bid - CN); gemm_done(p, 4); } else copier(p, 4, 9u, smem); }
    xcd_barrier(xbar);
    { KP p = kargs(); if (PHMASK & 32768) phase_norm(nullptr, nullptr, p->in[9], WSP(const float, WS_MOD), 3, 4, WSP(bf16_t, WS_H), nullptr, 0, WSP(const bf16_t, WS_X1)); }
    xcd_barrier(xbar);
    { KP p = kargs(); if (bid >= C10) { run_gemm(smem, WSP(const bf16_t, WS_H), WSP(const bf16_t, WS_WUP), M, NUP, D, FUp{WSP(bf16_t, WS_ACT)}, G - C10, bid - C10); gemm_done(p, 5); } else copier(p, 5, 37u, smem); }
    xcd_barrier(xbar);
    { KP p = kargs(); if (bid >= CN) { run_gemm(smem, WSP(const bf16_t, WS_ACT), WSP(const bf16_t, WS_WDN), M, D, DFF, FDown{WSP(bf16_t, WS_X1), WSP(const float, WS_MOD)}, G - CN, bid - CN); gemm_done(p, 6); } else copier(p, 6, 9u, smem); }
    xcd_barrier(xbar);
    { KP p = kargs(); if (PHMASK & 262144) phase_norm(nullptr, nullptr, p->in[22], WSP(const float, WS_MOD), 0, 0, nullptr, p->out + O_Y, 1, WSP(const bf16_t, WS_X1));
      copier(p, 0, 0u, smem); }
#undef WSP
}
}

extern "C" void kernel_launch(void* const* d_in, const int* in_sizes, int n_in, void* d_out, int out_size, void* d_ws, size_t ws_size, hipStream_t stream) {
    static int grid = 0;
    if (grid == 0) {
        int dev = 0, cus = 0, per_cu = 0;
        hipGetDevice(&dev);
        hipDeviceGetAttribute(&cus, hipDeviceAttributeMultiprocessorCount, dev);
        if (hipFuncSetAttribute((const void*)mk::fwd, hipFuncAttributeMaxDynamicSharedMemorySize, mk::LDS_BYTES) != hipSuccess) fprintf(stderr, "kernel_launch: hipFuncSetAttribute failed\n");
        if (hipOccupancyMaxActiveBlocksPerMultiprocessor(&per_cu, (const void*)mk::fwd, 512, mk::LDS_BYTES) != hipSuccess || per_cu < 1) { fprintf(stderr, "kernel_launch: occupancy query says %d blocks per CU\n", per_cu); per_cu = 1; }
        (void)hipGetLastError();
        grid = cus > 0 ? cus : 256;
        if (n_in != 23 || (size_t)out_size != mk::O_END || ws_size < mk::WS_END) fprintf(stderr, "kernel_launch: unexpected sizes n_in %d out %d ws %zu (need %zu)\n", n_in, out_size, ws_size, (size_t)mk::WS_END);
    }
    if (hipMemsetAsync((char*)d_ws + mk::WS_CTL, 0, 4096 + 16384, stream) != hipSuccess) fprintf(stderr, "kernel_launch: memset of control words failed\n");
    mk::Params p{};
    for (int i = 0; i < 23; ++i) p.in[i] = (const float*)d_in[i];
    p.out = (float*)d_out; p.ws = (unsigned char*)d_ws;
    void* args[] = {&p};
    hipError_t e = hipLaunchCooperativeKernel((const void*)mk::fwd, dim3(grid), dim3(512), args, mk::LDS_BYTES, stream);
    if (e != hipSuccess) fprintf(stderr, "cooperative launch failed: %s (grid %d)\n", hipGetErrorString(e), grid);
}
```

```cpp
#include <hip/hip_runtime.h>
#include <hip/hip_cooperative_groups.h>
#include <cstdio>
namespace cg = cooperative_groups;
namespace pg8 {
#define PG8_LAS __attribute__((address_space(3)))
typedef unsigned short bf16_t;
typedef short bf16x8 __attribute__((ext_vector_type(8)));
typedef float f32x4 __attribute__((ext_vector_type(4)));
typedef unsigned u32x4 __attribute__((ext_vector_type(4)));
constexpr int BM = 256, BK = 64, HALF = 128, HTB = HALF * BK * 2  , STAGE_BYTES = 8 * HTB, NXCD = 8, WGM = 8;

__host__ __device__ __forceinline__ int lds_byte(int r, int c) { const int st = (r >> 4) * 2 + (c >> 5), rr = r & 15, cc = c & 31, ob = rr * 64 + cc * 2; return st * 1024 + (ob ^ (((ob >> 9) & 1) << 5)); }
__host__ __device__ __forceinline__ void stage_rc(int b, int& R, int& C) { const int st = b / 1024, sb = b % 1024, swz = sb ^ (((sb >> 9) & 1) << 5); R = (st >> 1) * 16 + swz / 64; C = (st & 1) * 32 + (swz % 64) / 2; }
__host__ __device__ __forceinline__ int perm32(int rho) { const int n = rho >> 4, i = rho & 15; return 8 * (i >> 2) + 4 * n + (i & 3); }

struct Unit { int pm, pn; };
struct Gemm { const bf16_t* A; const bf16_t* Bt; int M, N, K; };

struct StaticOrder {
    int nM, nN, nwg, G, c;
    __host__ __device__ void init(int M, int N, int G_, int c_) { nM = M / BM; nN = N / BM; nwg = nM * nN; G = G_; c = c_; }
    __host__ __device__ bool next(int i, Unit& u) const {
        const long L = (long)i * G + c; if (L >= nwg) return false;
        int wgid = (int)L; { const int q = nwg / NXCD, r = nwg % NXCD, xcd = wgid % NXCD, off = wgid / NXCD; wgid = (xcd < r ? xcd * (q + 1) : r * (q + 1) + (xcd - r) * q) + off; }
        const int nig = WGM * nN, gid = wgid / nig, fm = gid * WGM, gsz = (nM - fm) < WGM ? (nM - fm) : WGM;
        u.pm = fm + ((wgid % nig) % gsz); u.pn = (wgid % nig) / gsz; return true;
    }
    __device__ __forceinline__ void a_ready(const Unit&) const {}
    __device__ __forceinline__ void done(const Unit&) const {}
};
__device__ __forceinline__ unsigned cvt_pk_bf16(float lo, float hi) { unsigned r; asm volatile("v_cvt_pk_bf16_f32 %0, %1, %2" : "=v"(r) : "v"(lo), "v"(hi)); return r; }
typedef float f32x2 __attribute__((ext_vector_type(2)));
template <class Epi, class Sched, bool STAMP = false>
__device__ __forceinline__ void gemm_phase(PG8_LAS unsigned char* lds, const Gemm g, const Sched& S, const Epi& E, unsigned long long* stamps) {
    const int tid = threadIdx.x, wid = __builtin_amdgcn_readfirstlane(tid >> 6), lane = tid & 63, wr = wid >> 2, wc = wid & 3, fr = lane & 15, fq = lane >> 4;
    const int K = g.K, nt = K / BK;
    int ts_lo = 0, ts_hi = 0, nts = 0; const unsigned long long rt_entry = STAMP ? (unsigned long long)wall_clock64() : 0ull;
#define PG8_STAMP() do { if (STAMP && wid == 0 && nts < 64) { const unsigned long long _c = (unsigned long long)clock64(); \
        ts_lo = (lane == nts) ? (int)(unsigned)_c : ts_lo; ts_hi = (lane == nts) ? (int)(unsigned)(_c >> 32) : ts_hi; ++nts; } } while (0)
    PG8_STAMP();
    unsigned voffA[2], voffB[2];
#pragma unroll
    for (int i = 0; i < 2; ++i) { int R, C; stage_rc(tid * 16 + i * 8192, R, C); const int Rb = Epi::PERM ? ((R & ~31) + perm32(R & 31)) : R;
        voffA[i] = (unsigned)(R * K + C) * 2u; voffB[i] = (unsigned)(Rb * K + C) * 2u; }
    const size_t kstep = (size_t)(BK * 2);
    const size_t hstep = (size_t)HALF * K * 2;
    const size_t tstep = 2 * hstep;
    const unsigned ldsw = (unsigned)wid * 1024u;
    const int aoff = lds_byte(wr * 64 + fr, fq * 8), boff = lds_byte(wc * 32 + fr, fq * 8);
#define PG8_SA(b, h) (((b) * 2 + (h)) * HTB)
#define PG8_SB(b, h) ((4 + (b) * 2 + (h)) * HTB)
#define PG8_STAGE(bufoff, gbase, voff) do { _Pragma("unroll") for (int _i = 0; _i < 2; ++_i) \
        __builtin_amdgcn_global_load_lds((const unsigned*)((const char*)(gbase) + (voff)[_i]), (PG8_LAS unsigned*)(lds + (bufoff) + ldsw + _i * 8192), 16, 0, 0); } while (0)
#define PG8_LDA(dst, b, h) do { _Pragma("unroll") for (int m = 0; m < 4; ++m) _Pragma("unroll") for (int k = 0; k < 2; ++k) dst[m][k] = *(const PG8_LAS bf16x8*)(lds + PG8_SA(b, h) + aoff + m * 2048 + k * 1024); } while (0)
#define PG8_LDB(dst, b, h) do { _Pragma("unroll") for (int n = 0; n < 2; ++n) _Pragma("unroll") for (int k = 0; k < 2; ++k) dst[n][k] = *(const PG8_LAS bf16x8*)(lds + PG8_SB(b, h) + boff + n * 2048 + k * 1024); } while (0)
#define PG8_MMA(ai, bj, At, Bt) do { __builtin_amdgcn_s_setprio(1); _Pragma("unroll") for (int m = 0; m < 4; ++m) _Pragma("unroll") for (int n = 0; n < 2; ++n) _Pragma("unroll") for (int k = 0; k < 2; ++k) \
        acc[ai][bj][m][n] = __builtin_amdgcn_mfma_f32_16x16x32_bf16(Bt[n][k], At[m][k], acc[ai][bj][m][n], 0, 0, 0); __builtin_amdgcn_s_setprio(0); } while (0)
#define PG8_WAIT_V(n) asm volatile("s_waitcnt vmcnt(" #n ")" ::: "memory")
#define PG8_WAIT_L(n) asm volatile("s_waitcnt lgkmcnt(" #n ")" ::: "memory")
#define PG8_BAR __builtin_amdgcn_s_barrier()
#define PG8_SCHED __builtin_amdgcn_sched_barrier(0)
    Unit cur, nxt; int ui = 0;
    if (!S.next(0, cur)) return;
    f32x4 acc[2][2][4][2];
#pragma unroll
    for (int a = 0; a < 2; ++a)
#pragma unroll
        for (int b = 0; b < 2; ++b)
#pragma unroll
            for (int m = 0; m < 4; ++m)
#pragma unroll
                for (int n = 0; n < 2; ++n) acc[a][b][m][n] = (f32x4){0.f, 0.f, 0.f, 0.f};
    bf16x8 At[4][2], B0[2][2], B1[2][2];
    const char* cA = (const char*)g.A + (size_t)cur.pm * tstep; const char* cB = (const char*)g.Bt + (size_t)cur.pn * tstep;
    S.a_ready(cur);
    PG8_STAGE(PG8_SB(0, 0), cB, voffB); PG8_STAGE(PG8_SA(0, 0), cA, voffA); PG8_STAGE(PG8_SB(0, 1), cB + hstep, voffB); PG8_STAGE(PG8_SA(0, 1), cA + hstep, voffA);
    if (wr == 1) PG8_BAR;
    PG8_WAIT_V(4); PG8_BAR;
    PG8_STAGE(PG8_SB(1, 0), cB + kstep, voffB); PG8_STAGE(PG8_SA(1, 0), cA + kstep, voffA); PG8_STAGE(PG8_SB(1, 1), cB + hstep + kstep, voffB);
    PG8_WAIT_V(6); PG8_BAR;
    PG8_STAMP();
    for (;;) {
        const bool has_next = S.next(ui + 1, nxt);
        const char* nA = has_next ? (const char*)g.A + (size_t)nxt.pm * tstep : cA; const char* nB = has_next ? (const char*)g.Bt + (size_t)nxt.pn * tstep : cB;
        for (int t = 0; t < nt; t += 2) {
            const bool last = (t == nt - 2);
            const char* a1 = cA + (size_t)(t + 1) * kstep;
            const char* a2 = last ? nA : cA + (size_t)(t + 2) * kstep; const char* b2 = last ? nB : cB + (size_t)(t + 2) * kstep;
            const char* a3 = a2 + kstep; const char* b3 = b2 + kstep;
            if (last && has_next) S.a_ready(nxt);
            PG8_LDB(B0, 0, 0); PG8_SCHED; PG8_LDA(At, 0, 0); PG8_STAGE(PG8_SA(1, 1), a1 + hstep, voffA);
            PG8_WAIT_L(8); PG8_BAR; PG8_WAIT_L(0); PG8_MMA(0, 0, At, B0); PG8_BAR; PG8_SCHED;
            PG8_LDB(B1, 0, 1); PG8_STAGE(PG8_SB(0, 0), b2, voffB);
            PG8_BAR; PG8_WAIT_L(0); PG8_MMA(0, 1, At, B1); PG8_BAR;
            PG8_LDA(At, 0, 1); PG8_STAGE(PG8_SA(0, 0), a2, voffA);
            PG8_BAR; PG8_WAIT_L(0); PG8_MMA(1, 0, At, B0); PG8_BAR; PG8_SCHED;
            PG8_STAGE(PG8_SB(0, 1), b2 + hstep, voffB);
            PG8_WAIT_V(6); PG8_BAR; PG8_MMA(1, 1, At, B1); PG8_BAR;
            PG8_LDB(B0, 1, 0); PG8_SCHED; PG8_LDA(At, 1, 0); PG8_STAGE(PG8_SA(0, 1), a2 + hstep, voffA);
            PG8_WAIT_L(8); PG8_BAR; PG8_WAIT_L(0); PG8_MMA(0, 0, At, B0); PG8_BAR; PG8_SCHED;
            PG8_LDB(B1, 1, 1); PG8_STAGE(PG8_SB(1, 0), b3, voffB);
            PG8_BAR; PG8_WAIT_L(0); PG8_MMA(0, 1, At, B1); PG8_BAR;
            PG8_LDA(At, 1, 1); PG8_STAGE(PG8_SA(1, 0), a3, voffA);
            PG8_BAR; PG8_WAIT_L(0); PG8_MMA(1, 0, At, B0); PG8_BAR; PG8_SCHED;
            PG8_STAGE(PG8_SB(1, 1), b3 + hstep, voffB);
            PG8_WAIT_V(6); PG8_BAR; PG8_MMA(1, 1, At, B1); PG8_BAR;
        }
        PG8_STAMP();
        if constexpr (!Epi::AFTER_DRAIN) { E(acc, cur, wr, wc, fr, fq); S.done(cur); }
        PG8_STAMP();
        if (!has_next) break;
#pragma unroll
        for (int a = 0; a < 2; ++a)
#pragma unroll
            for (int b = 0; b < 2; ++b)
#pragma unroll
                for (int m = 0; m < 4; ++m)
#pragma unroll
                    for (int n = 0; n < 2; ++n) acc[a][b][m][n] = (f32x4){0.f, 0.f, 0.f, 0.f};
        cur = nxt; cA = nA; cB = nB; ++ui;
    }
    PG8_WAIT_V(0);
    if (wr == 0) PG8_BAR;
    PG8_BAR;
    if constexpr (Epi::AFTER_DRAIN) { E.fused(acc, cur, wr, wc, fr, fq, lds, wid, lane); S.done(cur); }
    PG8_STAMP();
    if (STAMP && wid == 0) { stamps[lane] = lane < nts ? (((unsigned long long)(unsigned)ts_hi << 32) | (unsigned)ts_lo) : 0ull;
        if (lane == 62) stamps[62] = rt_entry; if (lane == 63) stamps[63] = (unsigned long long)wall_clock64(); }
#undef PG8_STAMP
#undef PG8_SA
#undef PG8_SB
#undef PG8_STAGE
#undef PG8_LDA
#undef PG8_LDB
#undef PG8_MMA
#undef PG8_WAIT_V
#undef PG8_WAIT_L
#undef PG8_BAR
#undef PG8_SCHED
}
}

#define XB_TMO      128
#define XB_XCNT(j)  (256  + 64 * (j))
#define XB_XSUB(j)  (1280 + 64 * (j))
#define XB_XGEN(j)  (2304 + 64 * (j))
#define XB_TOP      3328
#define XB_TOPGEN   3392
#define XCD_BAR_WORDS 3456
#define XB_SPIN_CAP (1u << 18)
#define LAS __attribute__((address_space(3)))

__device__ __forceinline__ unsigned xb_ld(unsigned* p)              { return __hip_atomic_load(p, __ATOMIC_RELAXED, __HIP_MEMORY_SCOPE_AGENT); }
__device__ __forceinline__ unsigned xb_add(unsigned* p, unsigned v) { return __hip_atomic_fetch_add(p, v, __ATOMIC_RELAXED, __HIP_MEMORY_SCOPE_AGENT); }
__device__ __forceinline__ unsigned xb_xcc_id() { return (unsigned)__builtin_amdgcn_s_getreg((3 << 11) | 20) & 0xFu; }
#define XB_SPIN(cond, bar) do { unsigned _sp = 0; while (cond) { __builtin_amdgcn_s_sleep(1); \
    if ((++_sp & 255u) == 0u) { if (xb_ld(&(bar)[XB_TMO])) break; if (_sp > XB_SPIN_CAP) { atomicAdd(&(bar)[XB_TMO], 1u); break; } } } } while (0)

struct XcdBarrier {
    unsigned* bar; unsigned x;
    volatile LAS unsigned* st;
};

__device__ __forceinline__ XcdBarrier xcd_barrier_post(unsigned* bar, volatile LAS unsigned* st) {
    XcdBarrier b; b.bar = bar; b.x = xb_xcc_id(); b.st = st;
    if (threadIdx.x == 0) (void)xb_add(&bar[XB_XCNT(b.x)], 1u);
    return b;
}
__device__ __forceinline__ void xcd_barrier_complete(unsigned* bar, unsigned x, unsigned& nloc, unsigned& nx) {
    const unsigned G = gridDim.x * gridDim.y * gridDim.z;
    unsigned sum, cnt, mine, sp = 0u;
    for (;;) {
        sum = 0u; cnt = 0u; mine = 0u;
#pragma unroll
        for (unsigned j = 0; j < 16; ++j) { const unsigned c = xb_ld(&bar[XB_XCNT(j)]); sum += c; cnt += (c > 0u) ? 1u : 0u; mine = (j == x) ? c : mine; }
        if (sum == G) break;
        __builtin_amdgcn_s_sleep(1);
        if ((++sp & 255u) == 0u) { if (xb_ld(&bar[XB_TMO])) break; if (sp > XB_SPIN_CAP) { atomicAdd(&bar[XB_TMO], 1u); break; } }
    }
    nloc = mine > 0u ? mine : 1u; nx = cnt > 0u ? cnt : 1u;
}

__device__ __forceinline__ void xcd_barrier(const XcdBarrier& b) {
    asm volatile("s_waitcnt vmcnt(0)" ::: "memory");
    __syncthreads();
    if (threadIdx.x == 0) {
        unsigned* bar = b.bar;
        __builtin_amdgcn_s_waitcnt(0);
        unsigned nloc = b.st[0], nx = b.st[1];
        if (nloc == 0u) { xcd_barrier_complete(bar, b.x, nloc, nx); b.st[0] = nloc; b.st[1] = nx; }
        const unsigned old = xb_add(&bar[XB_XSUB(b.x)], 1u);
        const unsigned gen = old / nloc;
        if (old + 1u == (gen + 1u) * nloc) {
            __builtin_amdgcn_fence(__ATOMIC_RELEASE, "agent");
            asm volatile("s_waitcnt vmcnt(0)" ::: "memory");
            const unsigned og = xb_add(&bar[XB_TOP], 1u);
            const unsigned tg = og / nx;
            if (og + 1u == (tg + 1u) * nx) xb_add(&bar[XB_TOPGEN], 1u);
            else XB_SPIN(xb_ld(&bar[XB_TOPGEN]) == tg, bar);
            __builtin_amdgcn_fence(__ATOMIC_ACQUIRE, "agent");
            xb_add(&bar[XB_XGEN(b.x)], 1u);
            asm volatile("s_waitcnt vmcnt(0)" ::: "memory");
        } else {
            XB_SPIN(xb_ld(&bar[XB_XGEN(b.x)]) == gen, bar);
            __builtin_amdgcn_fence(__ATOMIC_ACQUIRE, "agent");
            asm volatile("s_waitcnt vmcnt(0)" ::: "memory");
        }
    }
    __syncthreads();
}

#ifndef PHMASK
#define PHMASK 0x7FFFF
#endif
namespace mk {
using pg8::bf16_t; using pg8::bf16x8; using pg8::f32x4; using pg8::u32x4;
typedef unsigned u32x2 __attribute__((ext_vector_type(2)));
typedef float f32x2 __attribute__((ext_vector_type(2)));

constexpr int D = 1024, T = 4096, NB = 4, TP = NB * T, DBATCH = 128, SS = 4, TS = DBATCH * SS, M = TP + TS;
constexpr int NIN = 7680, NADA = 6144, NUP = 5632, DFF = 2816;
constexpr int C_GQ = 0, C_GK = 512, C_GV = 1024, C_GR = 2048, C_DQ = 3072, C_DK = 3840, C_DV = 4608, C_GA = 5376, C_GB = 6400, C_GLR = 7424, C_END = 7440;
constexpr int LDS_XTRA = 131072 + 16;
constexpr int LDS_BYTES = LDS_XTRA + (7680 + 32) * 4;
constexpr float EPS = 1e-6f;

constexpr size_t al(size_t x) { return (x + 255) & ~(size_t)255; }
constexpr size_t WS_WADA = 0;
constexpr size_t WS_WIN = WS_WADA + al((size_t)NADA * D * 2);
constexpr size_t WS_WPA = WS_WIN + al((size_t)NIN * D * 2);
constexpr size_t WS_WPB = WS_WPA + al((size_t)D * D * 2);
constexpr size_t WS_WOUT = WS_WPB + al((size_t)D * 256 * 2);
constexpr size_t WS_WUP = WS_WOUT + al((size_t)D * D * 2);
constexpr size_t WS_WDN = WS_WUP + al((size_t)NUP * D * 2);
constexpr size_t WS_BIN = WS_WDN + al((size_t)D * DFF * 2);
constexpr size_t WS_SC = WS_BIN + al((size_t)NIN * 4);
constexpr size_t WS_ROPE = WS_SC + al((size_t)256 * D * 2);
constexpr size_t WS_MOD = WS_ROPE + al((size_t)4100 * 32 * 8);
constexpr size_t WS_H = WS_MOD + al((size_t)256 * NADA * 4);
constexpr size_t WS_PROJ = WS_H + al((size_t)M * D * 2);
constexpr size_t WS_GLR = WS_PROJ + al((size_t)M * NIN * 2);
constexpr size_t WS_U = WS_GLR + al((size_t)M * 16 * 4);
constexpr size_t WS_DEC = WS_U + al((size_t)1024 * 32768 * 4);
constexpr size_t WS_SST = WS_DEC + al((size_t)1024 * 128 * 4);
constexpr size_t WS_OG = WS_SST + al((size_t)1024 * 32768 * 2);
constexpr size_t WS_LSE = WS_OG + al((size_t)TP * 768 * 2);
constexpr size_t WS_OA = WS_LSE + al((size_t)TP * 12 * 4);
constexpr size_t WS_OB = WS_OA + al((size_t)M * D * 2);
constexpr size_t WS_MG = WS_OB + al((size_t)M * 256 * 2);
constexpr size_t WS_X1 = WS_MG + al((size_t)M * D * 2);
constexpr size_t WS_ACT = WS_X1 + al((size_t)M * D * 4);
constexpr size_t WS_CTL = WS_ACT + al((size_t)M * DFF * 2);
constexpr size_t WS_BAR = WS_CTL + 4096;
constexpr size_t WS_END = WS_BAR + 16384;

constexpr size_t O_Y = 0;
constexpr size_t O_SGP = O_Y + (size_t)M * D;
constexpr size_t O_KVP0 = O_SGP + (size_t)4 * 4 * 128 * 256;
constexpr size_t O_KVP1 = O_KVP0 + (size_t)4 * 128 * 512;
constexpr size_t O_KVP2 = O_KVP1 + (size_t)4 * 512 * 512;
constexpr size_t O_SGS = O_KVP2 + (size_t)4 * 2048 * 512;
constexpr size_t O_KVS0 = O_SGS + (size_t)128 * 4 * 128 * 256;
constexpr size_t O_KVS1 = O_KVS0 + (size_t)128 * 128 * 512;
constexpr size_t O_KVS2 = O_KVS1 + (size_t)128 * 512 * 512;
constexpr size_t O_END = O_KVS2 + (size_t)128 * 2048 * 512;

struct Params { const float* in[23]; float* out; unsigned char* ws; };
typedef const __attribute__((address_space(4))) Params* KP;
__device__ __forceinline__ KP kargs() { KP k = (KP)__builtin_amdgcn_kernarg_segment_ptr(); asm volatile("" : "+s"(k)); return k; }

__device__ __forceinline__ float bf2f(unsigned short b) { return __uint_as_float(((unsigned)b) << 16); }
__device__ __forceinline__ unsigned short f2bf(float f) { unsigned u = __float_as_uint(f); u += 0x7FFFu + ((u >> 16) & 1u); return (unsigned short)(u >> 16); }
__device__ __forceinline__ unsigned pk2(float lo, float hi) { unsigned r; asm("v_cvt_pk_bf16_f32 %0, %1, %2" : "=v"(r) : "v"(lo), "v"(hi)); return r; }
__device__ __forceinline__ float silu_f(float x) { return x * __builtin_amdgcn_rcpf(1.f + __expf(-x)); }
__device__ __forceinline__ float sigm_f(float x) { return __builtin_amdgcn_rcpf(1.f + __expf(-x)); }
__device__ __forceinline__ int brow_of(int row) { return row < TP ? (row >> 12) : 4 + ((row - TP) >> 2); }
__device__ __forceinline__ size_t okvp(int g) { return g == 0 ? O_KVP0 : (g == 1 ? O_KVP1 : O_KVP2); }
__device__ __forceinline__ size_t okvs(int g) { return g == 0 ? O_KVS0 : (g == 1 ? O_KVS1 : O_KVS2); }
__device__ __forceinline__ f32x4 mfma16(bf16x8 a, bf16x8 b, f32x4 c) { return __builtin_amdgcn_mfma_f32_16x16x32_bf16(a, b, c, 0, 0, 0); }
__device__ __forceinline__ u32x4 pack8(f32x4 a, f32x4 b) { u32x4 w; w.x = pk2(a[0], a[1]); w.y = pk2(a[2], a[3]); w.z = pk2(b[0], b[1]); w.w = pk2(b[2], b[3]); return w; }
__device__ __forceinline__ void unpack8(u32x4 w, f32x4& a, f32x4& b) {
    a[0] = __uint_as_float(w.x << 16); a[1] = __uint_as_float(w.x & 0xffff0000u); a[2] = __uint_as_float(w.y << 16); a[3] = __uint_as_float(w.y & 0xffff0000u);
    b[0] = __uint_as_float(w.z << 16); b[1] = __uint_as_float(w.z & 0xffff0000u); b[2] = __uint_as_float(w.w << 16); b[3] = __uint_as_float(w.w & 0xffff0000u); }

__device__ __forceinline__ int map_in(int n) {
    if (n < 3072) return n;
    if (n < C_DV) { const int isK = n >= C_DK; const int j = n - (isK ? C_DK : C_DQ); const int head = j >> 6, p = j & 63; return (isK ? 3856 : 3088) + head * 64 + (p >> 1) + 32 * (p & 1); }
    if (n < C_GA) return 4624 + (n - C_DV);
    if (n < C_GB) return 5392 + (n - C_GA);
    if (n < C_GLR) return 6416 + (n - C_GB);
    if (n < C_END) return 3072 + (n - C_GLR);
    return -1;
}
__device__ __forceinline__ int map_up(int n) { const int q = n >> 3, e = n & 7; return e < 4 ? 4 * q + e : DFF + 4 * q + e - 4; }

__device__ __forceinline__ void tr_tile(const float* __restrict__ W, int ldw, bf16_t* __restrict__ Bt, int K, int n0, int k0, int mapid, unsigned char* smem) {
    unsigned short* t = (unsigned short*)smem;
    const int tid = threadIdx.x, lane = tid & 63, w8 = tid >> 6;
    const int n = n0 + lane; const int src = mapid == 0 ? n : (mapid == 1 ? map_in(n) : map_up(n));
#pragma unroll
    for (int j = 0; j < 8; ++j) { const int kk = w8 + 8 * j; const float v = src >= 0 ? W[(size_t)(k0 + kk) * ldw + src] : 0.f; t[kk * 66 + lane] = f2bf(v); }
    __syncthreads();
#pragma unroll
    for (int j = 0; j < 8; ++j) { const int nn = w8 + 8 * j; Bt[(size_t)(n0 + nn) * K + k0 + lane] = t[lane * 66 + nn]; }
    __syncthreads();
}

__device__ void phase_prep(KP p, unsigned char* smem) {
    const int G = gridDim.x;
    for (int ti = blockIdx.x; ti < 6144; ti += G) {
        const float* W; int ldw, K, kT, mapid, base; bf16_t* Bt;
        if (ti < 1536)      { W = p->in[10]; ldw = NADA; K = D;   kT = 16; mapid = 0; base = 0;    Bt = (bf16_t*)(p->ws + WS_WADA); }
        else if (ti < 3456) { W = p->in[12]; ldw = 7440; K = D;   kT = 16; mapid = 1; base = 1536; Bt = (bf16_t*)(p->ws + WS_WIN); }
        else if (ti < 3712) { W = p->in[17]; ldw = D;    K = D;   kT = 16; mapid = 0; base = 3456; Bt = (bf16_t*)(p->ws + WS_WPA); }
        else if (ti < 3776) { W = p->in[18]; ldw = D;    K = 256; kT = 4;  mapid = 0; base = 3712; Bt = (bf16_t*)(p->ws + WS_WPB); }
        else if (ti < 4032) { W = p->in[19]; ldw = D;    K = D;   kT = 16; mapid = 0; base = 3776; Bt = (bf16_t*)(p->ws + WS_WOUT); }
        else if (ti < 5440) { W = p->in[20]; ldw = NUP;  K = D;   kT = 16; mapid = 2; base = 4032; Bt = (bf16_t*)(p->ws + WS_WUP); }
        else                { W = p->in[21]; ldw = D;    K = DFF; kT = 44; mapid = 0; base = 5440; Bt = (bf16_t*)(p->ws + WS_WDN); }
        const int li = ti - base, nt = li / kT, kt = li % kT;
        tr_tile(W, ldw, Bt, K, nt * 64, kt * 64, mapid, smem);
    }
    const int gtid = blockIdx.x * 512 + threadIdx.x, gsz = G * 512;
    float* bin = (float*)(p->ws + WS_BIN);
    for (int n = gtid; n < NIN; n += gsz) { const int m = map_in(n); bin[n] = m >= 0 ? p->in[13][m] : 0.f; }
    bf16_t* sc = (bf16_t*)(p->ws + WS_SC);
    for (int i = gtid; i < 256 * D; i += gsz) { const int r = i >> 10, c = i & 1023; float v = 0.f;
        if (r < 4) v = p->in[6][r * D + c]; else if (r < 132) v = p->in[7][(r - 4) * D + c];
        sc[i] = f2bf(silu_f(v)); }
}

template <class F> struct EpiF {
    static constexpr bool PERM = true, AFTER_DRAIN = false;
    F f;
    __device__ __forceinline__ void operator()(const f32x4 (&acc)[2][2][4][2], const pg8::Unit& u, int wr, int wc, int fr, int fq) const {
#pragma unroll
        for (int ai = 0; ai < 2; ++ai)
#pragma unroll
            for (int m = 0; m < 4; ++m) {
                const int row = u.pm * 256 + ai * 128 + wr * 64 + m * 16 + fr;
#pragma unroll
                for (int bj = 0; bj < 2; ++bj) { const int col = u.pn * 256 + bj * 128 + wc * 32 + 8 * fq; f(row, col, acc[ai][bj][m][0], acc[ai][bj][m][1]); }
            }
    }
};

struct FMod { float* mod; const float* bias;
    __device__ __forceinline__ void operator()(int row, int col, f32x4 a, f32x4 b) const {
        a += *(const f32x4*)(bias + col); b += *(const f32x4*)(bias + col + 4);
        float* d = mod + (size_t)row * NADA + col; *(f32x4*)d = a; *(f32x4*)(d + 4) = b; } };

struct FIn { bf16_t* proj; float* glr; const LAS float* lb; float* out;
    __device__ __forceinline__ void kvout(int row, int g, int hh, int kv, int f, f32x4 v) const {
        const int W = 128 << (2 * g);
        if (row < TP) { const int t = row & 4095, b = row >> 12; if (t >= T - W) { float* d = out + okvp(g) + ((size_t)(b * W + t - (T - W)) * 2 + kv) * 256 + hh * 64 + f; *(f32x4*)d = v; } }
        else { const int r = row - TP, db = r >> 2, s = r & 3; float* d = out + okvs(g) + ((size_t)(db * W + W - 4 + s) * 2 + kv) * 256 + hh * 64 + f; *(f32x4*)d = v; }
    }
    __device__ __forceinline__ void operator()(int row, int col, f32x4 a, f32x4 b) const {
        if (col >= C_END) return;
        a += *(const LAS f32x4*)(lb + col); b += *(const LAS f32x4*)(lb + col + 4);
        if (col >= C_GLR) { float* d = glr + (size_t)row * 16 + (col - C_GLR); *(f32x4*)d = a; *(f32x4*)(d + 4) = b; return; }
        if (col >= C_GA) {
#pragma unroll
            for (int j = 0; j < 4; ++j) { a[j] = sigm_f(a[j]); b[j] = sigm_f(b[j]); }
        } else if (col >= C_DQ && col < C_DV) {
            const int isK = col >= C_DK; const int j = col - (isK ? C_DK : C_DQ); const int head = j >> 6, i0 = (j & 63) >> 1;
            const float posf = (float)(row < TP ? (row & 4095) : 8192 + ((row - TP) & 3));
            const f32x4 inv4 = *(const LAS f32x4*)(lb + NIN + i0);
            f32x4 cs0, cs1;
            { const float r0 = __builtin_amdgcn_fractf(posf * inv4[0] * 0.15915494309189535f), r1 = __builtin_amdgcn_fractf(posf * inv4[1] * 0.15915494309189535f),
                          r2 = __builtin_amdgcn_fractf(posf * inv4[2] * 0.15915494309189535f), r3 = __builtin_amdgcn_fractf(posf * inv4[3] * 0.15915494309189535f);
              cs0[0] = __builtin_amdgcn_cosf(r0); cs0[1] = __builtin_amdgcn_sinf(r0); cs0[2] = __builtin_amdgcn_cosf(r1); cs0[3] = __builtin_amdgcn_sinf(r1);
              cs1[0] = __builtin_amdgcn_cosf(r2); cs1[1] = __builtin_amdgcn_sinf(r2); cs1[2] = __builtin_amdgcn_cosf(r3); cs1[3] = __builtin_amdgcn_sinf(r3); }
            f32x4 ra, rb;
            ra[0] = a[0] * cs0[0] - a[1] * cs0[1]; ra[1] = a[1] * cs0[0] + a[0] * cs0[1];
            ra[2] = a[2] * cs0[2] - a[3] * cs0[3]; ra[3] = a[3] * cs0[2] + a[2] * cs0[3];
            rb[0] = b[0] * cs1[0] - b[1] * cs1[1]; rb[1] = b[1] * cs1[0] + b[0] * cs1[1];
            rb[2] = b[2] * cs1[2] - b[3] * cs1[3]; rb[3] = b[3] * cs1[2] + b[2] * cs1[3];
            a = ra; b = rb;
            if (isK) { f32x4 x1, x2; x1[0] = a[0]; x1[1] = a[2]; x1[2] = b[0]; x1[3] = b[2]; x2[0] = a[1]; x2[1] = a[3]; x2[2] = b[1]; x2[3] = b[3];
                kvout(row, head >> 2, head & 3, 0, i0, x1); kvout(row, head >> 2, head & 3, 0, 32 + i0, x2); }
        } else if (col >= C_DV && col < C_GA) {
            const int j = col - C_DV, head = j >> 6, f = j & 63;
            kvout(row, head >> 2, head & 3, 1, f, a); kvout(row, head >> 2, head & 3, 1, f + 4, b);
        }
        *(u32x4*)(proj + (size_t)row * NIN + col) = pack8(a, b);
    } };

struct FPa { bf16_t* mg; const bf16_t* proj;
    __device__ __forceinline__ void operator()(int row, int col, f32x4 a, f32x4 b) const {
        f32x4 g0, g1; unpack8(*(const u32x4*)(proj + (size_t)row * NIN + C_GA + col), g0, g1);
        *(u32x4*)(mg + (size_t)row * D + col) = pack8(a * g0, b * g1); } };
struct FPb { bf16_t* mg; const bf16_t* proj;
    __device__ __forceinline__ void operator()(int row, int col, f32x4 a, f32x4 b) const {
        f32x4 g0, g1, m0, m1; unpack8(*(const u32x4*)(proj + (size_t)row * NIN + C_GB + col), g0, g1);
        unpack8(*(const u32x4*)(mg + (size_t)row * D + col), m0, m1);
        *(u32x4*)(mg + (size_t)row * D + col) = pack8(m0 + a * g0, m1 + b * g1); } };
struct FOut { bf16_t* x1; const float* xp; const float* xs; const float* mod;
    __device__ __forceinline__ void operator()(int row, int col, f32x4 a, f32x4 b) const {
        const float* xr = row < TP ? xp + (size_t)row * D + col : xs + (size_t)(row - TP) * D + col;
        const float* g = mod + (size_t)brow_of(row) * NADA + 2 * D + col;
        *(u32x4*)(x1 + (size_t)row * D + col) = pack8(*(const f32x4*)xr + *(const f32x4*)g * a, *(const f32x4*)(xr + 4) + *(const f32x4*)(g + 4) * b); } };
struct FUp { bf16_t* act;
    __device__ __forceinline__ void operator()(int row, int col, f32x4 a, f32x4 b) const {
        u32x2 w; w.x = pk2(silu_f(a[0]) * b[0], silu_f(a[1]) * b[1]); w.y = pk2(silu_f(a[2]) * b[2], silu_f(a[3]) * b[3]);
        *(u32x2*)(act + (size_t)row * DFF + (col >> 1)) = w; } };
struct FDown { bf16_t* x1; const float* mod;
    __device__ __forceinline__ void operator()(int row, int col, f32x4 a, f32x4 b) const {
        const float* g = mod + (size_t)brow_of(row) * NADA + 5 * D + col;
        bf16_t* d = x1 + (size_t)row * D + col; f32x4 x0, x4; unpack8(*(const u32x4*)d, x0, x4);
        *(u32x4*)d = pack8(x0 + *(const f32x4*)g * a, x4 + *(const f32x4*)(g + 4) * b); } };

template <class F> __device__ __forceinline__ void run_gemm(unsigned char* smem, const bf16_t* A, const bf16_t* Bt, int Mm, int Nn, int Kk, const F& f, int Gg, int cc) {
    asm volatile("" : "+s"(Kk));
    pg8::Gemm g{A, Bt, Mm, Nn, Kk}; pg8::StaticOrder S; S.init(Mm, Nn, Gg, cc);
    EpiF<F> E{f};
    pg8::gemm_phase<EpiF<F>, pg8::StaticOrder, false>((PG8_LAS unsigned char*)smem, g, S, E, nullptr);
}

__device__ __forceinline__ void phase_norm(const float* xa, const float* xb, const float* gain, const float* mod, int sh_i, int sc_i, bf16_t* ob, float* of, int mode, const bf16_t* xh) {
    const int lane = threadIdx.x & 63, gw = blockIdx.x * 8 + (threadIdx.x >> 6), nw = gridDim.x * 8;
    f32x4 gn[4];
#pragma unroll
    for (int j = 0; j < 4; ++j) gn[j] = *(const f32x4*)(gain + j * 256 + lane * 4);
    for (int rowa = gw; rowa < M; rowa += 2 * nw) {
        f32x4 v[2][4], sc[2][4], sh[2][4];
#pragma unroll
        for (int r = 0; r < 2; ++r) { const int row = (rowa + r * nw) < M ? (rowa + r * nw) : (M - 1);
            {
                const float* xr = row < TP ? xa + (size_t)row * D : xb + (size_t)(row - TP) * D;
                const float* mr = mod + (size_t)brow_of(row) * NADA;
#pragma unroll
                for (int j = 0; j < 4; ++j) { const int c = j * 256 + lane * 4;
                    f32x4 t;
                    if (xh) { const u32x2 w = *(const u32x2*)(xh + (size_t)row * D + c); t = (f32x4){__uint_as_float(w.x << 16), __uint_as_float(w.x & 0xffff0000u), __uint_as_float(w.y << 16), __uint_as_float(w.y & 0xffff0000u)}; }
                    else t = *(const f32x4*)(xr + c);
                    v[r][j] = t;
                    sc[r][j] = *(const f32x4*)(mr + sc_i * D + c); sh[r][j] = *(const f32x4*)(mr + sh_i * D + c); } } }
#pragma unroll
        for (int r = 0; r < 2; ++r) { const int row = rowa + r * nw;
            if (row < M) {
                float ss = 0.f;
#pragma unroll
                for (int j = 0; j < 4; ++j) ss += v[r][j][0] * v[r][j][0] + v[r][j][1] * v[r][j][1] + v[r][j][2] * v[r][j][2] + v[r][j][3] * v[r][j][3];
#pragma unroll
                for (int o = 32; o >= 1; o >>= 1) ss += __shfl_xor(ss, o);
                const float rstd = rsqrtf(ss * (1.f / D) + EPS);
#pragma unroll
                for (int j = 0; j < 4; ++j) { const int c = j * 256 + lane * 4; f32x4 y = v[r][j] * rstd * gn[j];
                    if (mode == 0) { y = y * (sc[r][j] + 1.f) + sh[r][j];
                        u32x2 w; w.x = pk2(y[0], y[1]); w.y = pk2(y[2], y[3]); *(u32x2*)(ob + (size_t)row * D + c) = w; }
                    else *(f32x4*)(of + (size_t)row * D + c) = y; } } }
    }
}

__device__ __forceinline__ void gla_front(KP p, int row0, int h, float* LA, float* SEG) {
    const int tid = threadIdx.x; const float* glr = (const float*)(p->ws + WS_GLR);
    const float* wa = p->in[14]; const int ch = tid & 127, tg = tid >> 7;
    float* GL = SEG + 512;
    const f32x2 g2 = *(const f32x2*)(glr + (size_t)row0 * 16 + tid * 2);
    float w[16];
#pragma unroll
    for (int r = 0; r < 16; ++r) w[r] = wa[r * 512 + h * 128 + ch];
    const float bb = p->in[15][h * 128 + ch];
    *(f32x2*)(GL + tid * 2) = g2;
    __syncthreads();
    float run = 0.f;
#pragma unroll 4
    for (int i = 0; i < 16; ++i) { const int tok = tg * 16 + i; const float* g = GL + tok * 16; float z = bb;
#pragma unroll
        for (int r4 = 0; r4 < 4; ++r4) { const f32x4 g4 = *(const f32x4*)(g + r4 * 4); z += g4[0] * w[r4 * 4] + g4[1] * w[r4 * 4 + 1] + g4[2] * w[r4 * 4 + 2] + g4[3] * w[r4 * 4 + 3]; }
        const float ls = fminf(z, 0.f) - __logf(1.f + __expf(-fabsf(z)));
        run += ls * (1.f / 16.f); LA[tok * 132 + ch] = run; }
    SEG[tg * 128 + ch] = run;
    __syncthreads();
    if (tg > 0) { float off = SEG[ch]; if (tg > 1) off += SEG[128 + ch]; if (tg > 2) off += SEG[256 + ch];
#pragma unroll 4
        for (int i = 0; i < 16; ++i) LA[(tg * 16 + i) * 132 + ch] += off; }
    __syncthreads();
}
struct VRows { bf16x8 r[4]; };
__device__ __forceinline__ VRows gla_fetch_v(const bf16_t* proj, int row0, int h) {
    const int tid = threadIdx.x, t4 = tid & 15, vg = tid >> 4; VRows v;
#pragma unroll
    for (int j = 0; j < 4; ++j) v.r[j] = *(const bf16x8*)(proj + (size_t)(row0 + 4 * t4 + j) * NIN + C_GV + h * 256 + vg * 8);
    return v;
}
__device__ __forceinline__ void gla_put_vt(const VRows& v, unsigned short* VT) {
    const int tid = threadIdx.x, t4 = tid & 15, vg = tid >> 4;
#pragma unroll
    for (int e = 0; e < 8; ++e) { u32x2 w; w.x = (unsigned)(unsigned short)v.r[0][e] | ((unsigned)(unsigned short)v.r[1][e] << 16); w.y = (unsigned)(unsigned short)v.r[2][e] | ((unsigned)(unsigned short)v.r[3][e] << 16);
        *(u32x2*)(VT + (vg * 8 + e) * 72 + 4 * t4) = w; }
}

__device__ void gla_passA(KP p, unsigned char* smem, int item) {
    const int tid = threadIdx.x, lane = tid & 63, wid = tid >> 6, l15 = lane & 15, quad = lane >> 4;
    const int bh = item >> 6, n = item & 63, b = bh >> 2, h = bh & 3, row0 = b * T + n * 64;
    float* LA = (float*)smem; unsigned short* KLT = (unsigned short*)(smem + 33792); unsigned short* VT = (unsigned short*)(smem + 33792 + 18432);
    const bf16_t* proj = (const bf16_t*)(p->ws + WS_PROJ);
    const VRows vrows = gla_fetch_v(proj, row0, h);
    bf16x8 r[4];
    { const int t4 = tid & 15, cgp = (tid >> 4) & 15;
#pragma unroll
        for (int j = 0; j < 4; ++j) r[j] = *(const bf16x8*)(proj + (size_t)(row0 + 4 * t4 + j) * NIN + C_GK + h * 128 + cgp * 8); }
    gla_front(p, row0, h, LA, (float*)(smem + 118784));
    if (tid < 256) { const int t4 = tid & 15, cgp = tid >> 4;
#pragma unroll
        for (int e = 0; e < 8; ++e) { const int ch = cgp * 8 + e; const float bl = LA[63 * 132 + ch]; float kf[4];
#pragma unroll
            for (int j = 0; j < 4; ++j) kf[j] = bf2f((unsigned short)r[j][e]) * __expf(bl - LA[(4 * t4 + j) * 132 + ch]);
            u32x2 w; w.x = pk2(kf[0], kf[1]); w.y = pk2(kf[2], kf[3]); *(u32x2*)(KLT + ch * 72 + 4 * t4) = w; } }
    gla_put_vt(vrows, VT);
    if (tid < 128) ((float*)(p->ws + WS_DEC))[item * 128 + tid] = __expf(LA[63 * 132 + tid]);
    __syncthreads();
    f32x4 acc[2][8];
#pragma unroll
    for (int i = 0; i < 2; ++i)
#pragma unroll
        for (int j = 0; j < 8; ++j) acc[i][j] = (f32x4){0.f, 0.f, 0.f, 0.f};
#pragma unroll
    for (int ks = 0; ks < 2; ++ks) { bf16x8 a[2];
#pragma unroll
        for (int mt = 0; mt < 2; ++mt) a[mt] = *(const bf16x8*)(VT + (32 * wid + 16 * mt + l15) * 72 + ks * 32 + quad * 8);
#pragma unroll
        for (int nt = 0; nt < 8; ++nt) { const bf16x8 bb = *(const bf16x8*)(KLT + (16 * nt + l15) * 72 + ks * 32 + quad * 8);
#pragma unroll
            for (int mt = 0; mt < 2; ++mt) acc[mt][nt] = mfma16(a[mt], bb, acc[mt][nt]); } }
    bf16_t* U = (bf16_t*)(p->ws + WS_U) + (size_t)item * 32768;
#pragma unroll
    for (int mt = 0; mt < 2; ++mt)
#pragma unroll
        for (int nt = 0; nt < 8; ++nt)
#pragma unroll
            for (int e = 0; e < 4; ++e) U[(32 * wid + 16 * mt + quad * 4 + e) * 128 + 16 * nt + l15] = f2bf(acc[mt][nt][e]);
    __syncthreads();
}

__device__ void gla_passC(KP p, unsigned char* smem, int item) {
    const int tid = threadIdx.x, lane = tid & 63, wid = tid >> 6, l15 = lane & 15, quad = lane >> 4;
    const int bh = item >> 6, n = item & 63, b = bh >> 2, h = bh & 3, row0 = b * T + n * 64;
    float* LA = (float*)smem; unsigned short* QG = (unsigned short*)(smem + 33792); unsigned short* KD = (unsigned short*)(smem + 51200);
    unsigned short* VT = (unsigned short*)(smem + 68608); unsigned short* ATT = (unsigned short*)(smem + 105472); float* RED = (float*)(smem + 114688);
    const bf16_t* proj = (const bf16_t*)(p->ws + WS_PROJ);
    const VRows vrows = gla_fetch_v(proj, row0, h);
    bf16x8 q8s[2], k8s[2];
#pragma unroll
    for (int it = 0; it < 2; ++it) { const int idx = tid + it * 512, cgp = idx & 15, tok = idx >> 4;
        q8s[it] = *(const bf16x8*)(proj + (size_t)(row0 + tok) * NIN + C_GQ + h * 128 + cgp * 8); k8s[it] = *(const bf16x8*)(proj + (size_t)(row0 + tok) * NIN + C_GK + h * 128 + cgp * 8); }
    const bf16_t* sst = (const bf16_t*)(p->ws + WS_SST) + (size_t)item * 32768;
    bf16x8 bsall[4][2];
#pragma unroll
    for (int ks = 0; ks < 4; ++ks)
#pragma unroll
        for (int nt = 0; nt < 2; ++nt) bsall[ks][nt] = *(const bf16x8*)(sst + (32 * wid + 16 * nt + l15) * 128 + ks * 32 + quad * 8);
    gla_front(p, row0, h, LA, (float*)(smem + 118784));
#pragma unroll
    for (int it = 0; it < 2; ++it) { const int idx = tid + it * 512, cgp = idx & 15, tok = idx >> 4;
        const bf16x8 q8 = q8s[it], k8 = k8s[it];
        f32x4 qa, qb, ka, kb;
#pragma unroll
        for (int e = 0; e < 8; ++e) { const float bc = LA[tok * 132 + cgp * 8 + e];
            const float qf = bf2f((unsigned short)q8[e]) * 0.08838834764831845f * __expf(bc), kf = bf2f((unsigned short)k8[e]) * __expf(-bc);
            if (e < 4) { qa[e] = qf; ka[e] = kf; } else { qb[e - 4] = qf; kb[e - 4] = kf; } }
        *(u32x4*)(QG + tok * 136 + cgp * 8) = pack8(qa, qb); *(u32x4*)(KD + tok * 136 + cgp * 8) = pack8(ka, kb); }
    gla_put_vt(vrows, VT);
    __syncthreads();
    { const int mt = wid >> 1; f32x4 c2[2] = {(f32x4){0.f, 0.f, 0.f, 0.f}, (f32x4){0.f, 0.f, 0.f, 0.f}};
#pragma unroll
        for (int ks = 0; ks < 4; ++ks) { const bf16x8 a = *(const bf16x8*)(QG + (16 * mt + l15) * 136 + ks * 32 + quad * 8);
#pragma unroll
            for (int j = 0; j < 2; ++j) { const int nt = 2 * (wid & 1) + j; const bf16x8 bb = *(const bf16x8*)(KD + (16 * nt + l15) * 136 + ks * 32 + quad * 8); c2[j] = mfma16(a, bb, c2[j]); } }
#pragma unroll
        for (int j = 0; j < 2; ++j)
#pragma unroll
            for (int e = 0; e < 4; ++e) { const int c = 16 * mt + quad * 4 + e, s = 16 * (2 * (wid & 1) + j) + l15; ATT[c * 72 + s] = f2bf(s <= c ? c2[j][e] : 0.f); } }
    __syncthreads();
    f32x4 o[4][2];
#pragma unroll
    for (int i = 0; i < 4; ++i)
#pragma unroll
        for (int j = 0; j < 2; ++j) o[i][j] = (f32x4){0.f, 0.f, 0.f, 0.f};
#pragma unroll
    for (int ks = 0; ks < 2; ++ks) { bf16x8 bv[2];
#pragma unroll
        for (int nt = 0; nt < 2; ++nt) bv[nt] = *(const bf16x8*)(VT + (32 * wid + 16 * nt + l15) * 72 + ks * 32 + quad * 8);
#pragma unroll
        for (int mt = 0; mt < 4; ++mt) { const bf16x8 a = *(const bf16x8*)(ATT + (16 * mt + l15) * 72 + ks * 32 + quad * 8);
#pragma unroll
            for (int nt = 0; nt < 2; ++nt) o[mt][nt] = mfma16(a, bv[nt], o[mt][nt]); } }
#pragma unroll
    for (int ks = 0; ks < 4; ++ks) { bf16x8 bs[2];
#pragma unroll
        for (int nt = 0; nt < 2; ++nt) bs[nt] = bsall[ks][nt];
#pragma unroll
        for (int mt = 0; mt < 4; ++mt) { const bf16x8 a = *(const bf16x8*)(QG + (16 * mt + l15) * 136 + ks * 32 + quad * 8);
#pragma unroll
            for (int nt = 0; nt < 2; ++nt) o[mt][nt] = mfma16(a, bs[nt], o[mt][nt]); } }
#pragma unroll
    for (int mt = 0; mt < 4; ++mt)
#pragma unroll
        for (int e = 0; e < 4; ++e) { float ss = o[mt][0][e] * o[mt][0][e] + o[mt][1][e] * o[mt][1][e];
            ss += __shfl_xor(ss, 1); ss += __shfl_xor(ss, 2); ss += __shfl_xor(ss, 4); ss += __shfl_xor(ss, 8);
            if (l15 == 0) RED[(16 * mt + quad * 4 + e) * 8 + wid] = ss; }
    __syncthreads();
    bf16_t* oa = (bf16_t*)(p->ws + WS_OA); const float* gng = p->in[16];
    unsigned short* OS = (unsigned short*)smem;
#pragma unroll
    for (int mt = 0; mt < 4; ++mt)
#pragma unroll
        for (int e = 0; e < 4; ++e) { const int c = 16 * mt + quad * 4 + e; const f32x4 r0 = *(const f32x4*)(RED + c * 8), r1 = *(const f32x4*)(RED + c * 8 + 4);
            const float tot = (r0[0] + r0[1]) + (r0[2] + r0[3]) + (r1[0] + r1[1]) + (r1[2] + r1[3]); const float rstd = rsqrtf(tot * (1.f / 256.f) + EPS);
#pragma unroll
            for (int nt = 0; nt < 2; ++nt) OS[c * 264 + 32 * wid + 16 * nt + l15] = f2bf(o[mt][nt][e] * rstd); }
    __syncthreads();
#pragma unroll
    for (int it = 0; it < 4; ++it) { const int idx = tid + it * 512, c = idx >> 5, d8 = (idx & 31) * 8;
        f32x4 o0, o1, s0, s1; unpack8(*(const u32x4*)(OS + c * 264 + d8), o0, o1);
        unpack8(*(const u32x4*)(proj + (size_t)(row0 + c) * NIN + C_GR + h * 256 + d8), s0, s1);
        const f32x4 g0 = *(const f32x4*)(gng + d8), g1 = *(const f32x4*)(gng + d8 + 4);
#pragma unroll
        for (int j = 0; j < 4; ++j) { s0[j] = silu_f(s0[j]); s1[j] = silu_f(s1[j]); }
        *(u32x4*)(oa + (size_t)(row0 + c) * D + h * 256 + d8) = pack8(o0 * g0 * s0, o1 * g1 * s1); }
    __syncthreads();
}

__device__ void gla_passB(KP p) {
    const int gtid = blockIdx.x * 512 + threadIdx.x, gsz = gridDim.x * 512;
    const bf16_t* U = (const bf16_t*)(p->ws + WS_U); const float* DEC = (const float*)(p->ws + WS_DEC); bf16_t* SST = (bf16_t*)(p->ws + WS_SST);
    for (int e4 = gtid; e4 < 131072; e4 += gsz) {
        const int bh = e4 >> 13, dv = (e4 >> 5) & 255, dk4 = (e4 & 31) * 4;
        f32x4 S = (f32x4){0.f, 0.f, 0.f, 0.f};
#pragma unroll 4
        for (int n = 0; n < 64; ++n) { const int item = bh * 64 + n; const size_t off = (size_t)item * 32768 + dv * 128 + dk4;
            u32x2 w; w.x = pk2(S[0], S[1]); w.y = pk2(S[2], S[3]); *(u32x2*)(SST + off) = w;
            const u32x2 ub = *(const u32x2*)(U + off); const f32x4 d4 = *(const f32x4*)(DEC + item * 128 + dk4);
            f32x4 u4; u4[0] = __uint_as_float(ub.x << 16); u4[1] = __uint_as_float(ub.x & 0xffff0000u); u4[2] = __uint_as_float(ub.y << 16); u4[3] = __uint_as_float(ub.y & 0xffff0000u);
            S = d4 * S + u4; }
#pragma unroll
        for (int j = 0; j < 4; ++j) p->out[O_SGP + ((size_t)(bh * 128 + dk4 + j)) * 256 + dv] = S[j];
    }
}

__device__ void gla_sample(KP p, unsigned char* smem, int item) {
    const int tid = threadIdx.x, lane = tid & 63, wid = tid >> 6;
    const int db = item >> 2, h = item & 3, row0 = TP + db * 4;
    float* BC = (float*)smem;
    float* QG = BC + 512; float* KD = QG + 512; float* KL = KD + 512; float* DECs = KL + 512;
    float* V = DECs + 128;
    float* ATT = V + 1024;
    float* RS = ATT + 16;
    float* RED = RS + 16;
    const bf16_t* proj = (const bf16_t*)(p->ws + WS_PROJ); const float* glr = (const float*)(p->ws + WS_GLR);
    const int tok = tid >> 7, ch = tid & 127;
    { float z = p->in[15][h * 128 + ch]; const float* g = glr + (size_t)(row0 + tok) * 16;
#pragma unroll
        for (int r = 0; r < 16; ++r) z += g[r] * p->in[14][r * 512 + h * 128 + ch];
        BC[tok * 128 + ch] = (fminf(z, 0.f) - __logf(1.f + __expf(-fabsf(z)))) * (1.f / 16.f); }
    __syncthreads();
    if (tid < 128) { float s = 0.f;
#pragma unroll
        for (int t = 0; t < 4; ++t) { s += BC[t * 128 + tid]; BC[t * 128 + tid] = s; } }
    __syncthreads();
    { const float bc = BC[tok * 128 + ch], bl = BC[3 * 128 + ch];
        const float q = bf2f(proj[(size_t)(row0 + tok) * NIN + C_GQ + h * 128 + ch]), k = bf2f(proj[(size_t)(row0 + tok) * NIN + C_GK + h * 128 + ch]);
        QG[tok * 128 + ch] = q * 0.08838834764831845f * __expf(bc); KD[tok * 128 + ch] = k * __expf(-bc); KL[tok * 128 + ch] = k * __expf(bl - bc);
        if (tok == 0) DECs[ch] = __expf(bl);
#pragma unroll
        for (int j = 0; j < 2; ++j) { const int i = tid + j * 512, t2 = i >> 8, dv = i & 255; V[i] = bf2f(proj[(size_t)(row0 + t2) * NIN + C_GV + h * 256 + dv]); } }
    __syncthreads();
    {
#pragma unroll
        for (int j = 0; j < 2; ++j) { const int pr = wid + 8 * j, c = pr >> 2, s = pr & 3;
            float d = QG[c * 128 + lane] * KD[s * 128 + lane] + QG[c * 128 + 64 + lane] * KD[s * 128 + 64 + lane];
#pragma unroll
            for (int o = 32; o >= 1; o >>= 1) d += __shfl_xor(d, o);
            if (lane == 0) ATT[pr] = s <= c ? d : 0.f; } }
    __syncthreads();
    const int dvq = lane * 4;
    f32x4 v4[4], inter[4];
#pragma unroll
    for (int t = 0; t < 4; ++t) { v4[t] = *(const f32x4*)(V + t * 256 + dvq); inter[t] = (f32x4){0.f, 0.f, 0.f, 0.f}; }
    const float* S0 = p->in[2] + (size_t)(db * 4 + h) * 32768; float* S1 = p->out + O_SGS + (size_t)(db * 4 + h) * 32768;
#pragma unroll 4
    for (int it = 0; it < 16; ++it) { const int dk = it * 8 + wid;
        const f32x4 s4 = __builtin_nontemporal_load((const f32x4*)(S0 + dk * 256 + dvq));
        f32x4 nw = s4 * DECs[dk];
#pragma unroll
        for (int t = 0; t < 4; ++t) { inter[t] += s4 * QG[t * 128 + dk]; nw += v4[t] * KL[t * 128 + dk]; }
        __builtin_nontemporal_store(nw, (f32x4*)(S1 + dk * 256 + dvq)); }
#pragma unroll
    for (int t = 0; t < 4; ++t) *(f32x4*)(RED + (wid * 4 + t) * 256 + dvq) = inter[t];
    __syncthreads();
    { const int dv2 = (tid & 127) * 2; float o0 = 0.f, o1 = 0.f;
#pragma unroll
        for (int w = 0; w < 8; ++w) { const f32x2 r = *(const f32x2*)(RED + (w * 4 + tok) * 256 + dv2); o0 += r[0]; o1 += r[1]; }
#pragma unroll
        for (int s = 0; s < 4; ++s) { const float a = ATT[tok * 4 + s]; o0 += a * V[s * 256 + dv2]; o1 += a * V[s * 256 + dv2 + 1]; }
        float ss = o0 * o0 + o1 * o1;
#pragma unroll
        for (int o = 32; o >= 1; o >>= 1) ss += __shfl_xor(ss, o);
        if (lane == 0) RS[wid] = ss;
        __syncthreads();
        const float rstd = rsqrtf((RS[2 * tok] + RS[2 * tok + 1]) * (1.f / 256.f) + EPS);
        const int row = row0 + tok; const float* gng = p->in[16];
        const float y0 = o0 * rstd * gng[dv2] * silu_f(bf2f(proj[(size_t)row * NIN + C_GR + h * 256 + dv2]));
        const float y1 = o1 * rstd * gng[dv2 + 1] * silu_f(bf2f(proj[(size_t)row * NIN + C_GR + h * 256 + dv2 + 1]));
        *(unsigned*)((bf16_t*)(p->ws + WS_OA) + (size_t)row * D + h * 256 + dv2) = pk2(y0, y1); }
    __syncthreads();
}

__device__ void dsw_prompt(KP p, unsigned char* smem, int item) {
    const int tid = threadIdx.x, lane = tid & 63, wid = tid >> 6, l15 = lane & 15, quad = lane >> 4;
    const int blk = item & 31, gh = (item >> 5) % 12, b = item / 384;
    const int g = gh >> 2, dil = 1 << (2 * g), nbc = 32 >> (2 * g);
    const int r = blk / nbc, l0 = (blk % nbc) * 128;
    unsigned short* KS = (unsigned short*)smem;
    unsigned short* VT = (unsigned short*)(smem + 39168);
    unsigned short* PS = (unsigned short*)(smem + 75008) + wid * (16 * 168);
    const bf16_t* proj = (const bf16_t*)(p->ws + WS_PROJ);
    const int qrow = b * T + (l0 + 16 * wid + l15) * dil + r;
    bf16x8 qa[2];
#pragma unroll
    for (int ks = 0; ks < 2; ++ks) qa[ks] = *(const bf16x8*)(proj + (size_t)qrow * NIN + C_DQ + gh * 64 + ks * 32 + quad * 8);
    u32x4 kreg[5];
#pragma unroll
    for (int it = 0; it < 5; ++it) { const int idx = tid + it * 512, i = idx >> 3, c8 = idx & 7, l = l0 - 144 + i; kreg[it] = (u32x4){0u, 0u, 0u, 0u};
        if (idx < 2176 && l >= 0) kreg[it] = *(const u32x4*)(proj + (size_t)(b * T + l * dil + r) * NIN + C_DK + gh * 64 + c8 * 8); }
    bf16x8 vreg[2][4];
#pragma unroll
    for (int it = 0; it < 2; ++it) { const int idx = tid + it * 512, c8 = idx / 68, i = 4 * (idx - c8 * 68), l = l0 - 144 + i;
#pragma unroll
        for (int j = 0; j < 4; ++j) { vreg[it][j] = (bf16x8){0, 0, 0, 0, 0, 0, 0, 0}; if (idx < 544 && l >= 0) vreg[it][j] = *(const bf16x8*)(proj + (size_t)(b * T + (l + j) * dil + r) * NIN + C_DV + gh * 64 + c8 * 8); } }
#pragma unroll
    for (int it = 0; it < 5; ++it) { const int idx = tid + it * 512, i = idx >> 3, c8 = idx & 7; if (idx < 2176) *(u32x4*)(KS + i * 72 + c8 * 8) = kreg[it]; }
#pragma unroll
    for (int it = 0; it < 2; ++it) { const int idx = tid + it * 512, c8 = idx / 68, i = 4 * (idx - c8 * 68);
        if (idx < 544) {
#pragma unroll
            for (int e = 0; e < 8; ++e) { u32x2 w; w.x = (unsigned)(unsigned short)vreg[it][0][e] | ((unsigned)(unsigned short)vreg[it][1][e] << 16); w.y = (unsigned)(unsigned short)vreg[it][2][e] | ((unsigned)(unsigned short)vreg[it][3][e] << 16);
                *(u32x2*)(VT + (c8 * 8 + e) * 280 + i) = w; } } }
    __syncthreads();
    f32x4 s[9];
#pragma unroll
    for (int kt = 0; kt < 9; ++kt) { s[kt] = (f32x4){0.f, 0.f, 0.f, 0.f};
#pragma unroll
        for (int ks = 0; ks < 2; ++ks) { const bf16x8 bb = *(const bf16x8*)(KS + (16 * wid + 16 * (kt + 1) + l15) * 72 + ks * 32 + quad * 8); s[kt] = mfma16(qa[ks], bb, s[kt]); } }
    float mx[4] = {-INFINITY, -INFINITY, -INFINITY, -INFINITY};
#pragma unroll
    for (int kt = 0; kt < 9; ++kt)
#pragma unroll
        for (int e = 0; e < 4; ++e) { const int dist = 144 + quad * 4 + e - 16 * (kt + 1) - l15, lk = l0 - 144 + 16 * wid + 16 * (kt + 1) + l15;
            const bool valid = dist >= 0 && dist <= 128 && lk >= 0; const float v = valid ? s[kt][e] * 0.125f : -INFINITY; s[kt][e] = v; mx[e] = fmaxf(mx[e], v); }
#pragma unroll
    for (int e = 0; e < 4; ++e) { mx[e] = fmaxf(mx[e], __shfl_xor(mx[e], 1)); mx[e] = fmaxf(mx[e], __shfl_xor(mx[e], 2)); mx[e] = fmaxf(mx[e], __shfl_xor(mx[e], 4)); mx[e] = fmaxf(mx[e], __shfl_xor(mx[e], 8)); }
    float den[4] = {0.f, 0.f, 0.f, 0.f};
#pragma unroll
    for (int e = 0; e < 4; ++e) PS[(quad * 4 + e) * 168 + l15] = 0;
#pragma unroll
    for (int kt = 0; kt < 9; ++kt)
#pragma unroll
        for (int e = 0; e < 4; ++e) { const float pe = __expf(s[kt][e] - mx[e]); den[e] += pe; PS[(quad * 4 + e) * 168 + 16 * (kt + 1) + l15] = f2bf(pe); }
#pragma unroll
    for (int e = 0; e < 4; ++e) { den[e] += __shfl_xor(den[e], 1); den[e] += __shfl_xor(den[e], 2); den[e] += __shfl_xor(den[e], 4); den[e] += __shfl_xor(den[e], 8); }
    __syncthreads();
    f32x4 o[4];
#pragma unroll
    for (int dt = 0; dt < 4; ++dt) o[dt] = (f32x4){0.f, 0.f, 0.f, 0.f};
#pragma unroll
    for (int ks = 0; ks < 5; ++ks) { const bf16x8 a = *(const bf16x8*)(PS + l15 * 168 + ks * 32 + quad * 8);
#pragma unroll
        for (int dt = 0; dt < 4; ++dt) { const bf16x8 bb = *(const bf16x8*)(VT + (16 * dt + l15) * 280 + 16 * wid + ks * 32 + quad * 8); o[dt] = mfma16(a, bb, o[dt]); } }
    bf16_t* og = (bf16_t*)(p->ws + WS_OG); float* lse = (float*)(p->ws + WS_LSE);
#pragma unroll
    for (int e = 0; e < 4; ++e) { const int tk = b * T + (l0 + 16 * wid + quad * 4 + e) * dil + r; const float inv = 1.f / den[e];
#pragma unroll
        for (int dt = 0; dt < 4; ++dt) og[(size_t)tk * 768 + gh * 64 + 16 * dt + l15] = f2bf(o[dt][e] * inv);
        if (l15 == 0) lse[tk * 12 + gh] = mx[e] + __logf(den[e]); }
    __syncthreads();
}

__device__ void dsw_combine(KP p) {
    const int gtid = blockIdx.x * 512 + threadIdx.x, gsz = gridDim.x * 512;
    const bf16_t* og = (const bf16_t*)(p->ws + WS_OG); const float* lse = (const float*)(p->ws + WS_LSE); bf16_t* ob = (bf16_t*)(p->ws + WS_OB);
    for (int idx = gtid; idx < TP * 32; idx += gsz) { const int d8 = idx & 7, hh = (idx >> 3) & 3, tk = idx >> 5;
        const float l0 = lse[tk * 12 + hh], l1 = lse[tk * 12 + 4 + hh], l2 = lse[tk * 12 + 8 + hh];
        const float mx = fmaxf(l0, fmaxf(l1, l2)); float w0 = __expf(l0 - mx), w1 = __expf(l1 - mx), w2 = __expf(l2 - mx); const float inv = 1.f / (w0 + w1 + w2); w0 *= inv; w1 *= inv; w2 *= inv;
        f32x4 a0, b0, a1, b1, a2, b2;
        unpack8(*(const u32x4*)(og + (size_t)tk * 768 + hh * 64 + d8 * 8), a0, b0);
        unpack8(*(const u32x4*)(og + (size_t)tk * 768 + (4 + hh) * 64 + d8 * 8), a1, b1);
        unpack8(*(const u32x4*)(og + (size_t)tk * 768 + (8 + hh) * 64 + d8 * 8), a2, b2);
        *(u32x4*)(ob + (size_t)tk * 256 + hh * 64 + d8 * 8) = pack8(a0 * w0 + a1 * w1 + a2 * w2, b0 * w0 + b1 * w1 + b2 * w2); }
}

__device__ void dsw_sample(KP p, unsigned char* smem, int witem) {
    const int lane = threadIdx.x & 63, wid = threadIdx.x >> 6;
    float* qs = (float*)smem + wid * 256; float* ps = qs + 64;
    const int s = witem & 3, hh = (witem >> 2) & 3, db = witem >> 4, row = TP + db * 4 + s;
    const bf16_t* proj = (const bf16_t*)(p->ws + WS_PROJ);
    float rmx = -INFINITY, rws = 0.f; f32x4 racc = (f32x4){0.f, 0.f, 0.f, 0.f};
    const int ksl = lane >> 2, part = lane & 3, kq = lane >> 4, d4 = (lane & 15) * 4;
#pragma unroll 1
    for (int g = 0; g < 3; ++g) {
        const int W = 128 << (2 * g), dil = 1 << (2 * g);
        const float* cache = p->in[3 + g] + (size_t)db * W * 512 + hh * 64;
        const float* kvn = p->out + okvs(g) + (size_t)(db * W + W - 4) * 512 + hh * 64;
        qs[lane] = bf2f(proj[(size_t)row * NIN + C_DQ + (g * 4 + hh) * 64 + 2 * (lane & 31) + (lane >> 5)]);
        __builtin_amdgcn_wave_barrier();
        f32x4 q4[4];
#pragma unroll
        for (int c = 0; c < 4; ++c) q4[c] = *(const f32x4*)(qs + part * 16 + c * 4);
#pragma unroll 5
        for (int pi = 0; pi < 9; ++pi) { const int j = pi * 16 + ksl; float dot = 0.f;
            if (j <= 128) { const int idx = W + s - j * dil; const float* kr = (idx >= W ? kvn + (size_t)(idx - W) * 512 : cache + (size_t)idx * 512) + part * 16;
#pragma unroll
                for (int c = 0; c < 4; ++c) { const f32x4 k4 = *(const f32x4*)(kr + c * 4); dot += k4[0] * q4[c][0] + k4[1] * q4[c][1] + k4[2] * q4[c][2] + k4[3] * q4[c][3]; } }
            dot += __shfl_xor(dot, 1); dot += __shfl_xor(dot, 2);
            if (part == 0 && j <= 128) ps[j] = dot * 0.125f; }
        __builtin_amdgcn_wave_barrier();
        float sc[3]; float m = -INFINITY;
#pragma unroll
        for (int jj = 0; jj < 3; ++jj) { const int j = lane + 64 * jj; sc[jj] = j <= 128 ? ps[j] : -INFINITY; m = fmaxf(m, sc[jj]); }
#pragma unroll
        for (int o = 32; o >= 1; o >>= 1) m = fmaxf(m, __shfl_xor(m, o));
        float den = 0.f;
        __builtin_amdgcn_wave_barrier();
#pragma unroll
        for (int jj = 0; jj < 3; ++jj) { const int j = lane + 64 * jj; if (j <= 128) { const float e = __expf(sc[jj] - m); den += e; ps[j] = e; } }
#pragma unroll
        for (int o = 32; o >= 1; o >>= 1) den += __shfl_xor(den, o);
        __builtin_amdgcn_wave_barrier();
        f32x4 o = (f32x4){0.f, 0.f, 0.f, 0.f};
#pragma unroll 17
        for (int jt = 0; jt < 33; ++jt) { const int j = jt * 4 + kq;
            if (j <= 128) { const int idx = W + s - j * dil; const float* vr = (idx >= W ? kvn + (size_t)(idx - W) * 512 : cache + (size_t)idx * 512) + 256 + d4;
                o += *(const f32x4*)vr * ps[j]; } }
#pragma unroll
        for (int c = 0; c < 4; ++c) { o[c] += __shfl_xor(o[c], 16); o[c] += __shfl_xor(o[c], 32); }
        const float lg = m + __logf(den), nm = fmaxf(rmx, lg), sc_old = __expf(rmx - nm), wg = __expf(lg - nm);
        racc = racc * sc_old + o * (wg / den); rws = rws * sc_old + wg; rmx = nm;
        __builtin_amdgcn_wave_barrier();
    }
    if (lane < 16) { const float inv = 1.f / rws; u32x2 w; w.x = pk2(racc[0] * inv, racc[1] * inv); w.y = pk2(racc[2] * inv, racc[3] * inv);
        *(u32x2*)((bf16_t*)(p->ws + WS_OB) + (size_t)row * 256 + hh * 64 + d4) = w; }
}

constexpr unsigned NCH0 = 496, NCH1 = 2032, NCH2 = 8176, NCHUNK = NCH0 + NCH1 + NCH2;
__device__ __forceinline__ void half_where(KP p, unsigned c, const f32x4*& src, f32x4*& dst, unsigned& cl, unsigned& per) {
    if (c < NCH0) { src = (const f32x4*)p->in[3]; dst = (f32x4*)(p->out + O_KVS0); cl = c; per = 124u * 128u; }
    else if (c < NCH0 + NCH1) { src = (const f32x4*)p->in[4]; dst = (f32x4*)(p->out + O_KVS1); cl = c - NCH0; per = 508u * 128u; }
    else { src = (const f32x4*)p->in[5]; dst = (f32x4*)(p->out + O_KVS2); cl = c - NCH0 - NCH1; per = 2044u * 128u; }
}
#define HALF_LOAD(H, c) do { const f32x4* src_; f32x4* dst_; unsigned cl_, per_; half_where(p, (c), src_, dst_, cl_, per_); \
    const unsigned i0_ = cl_ * 4096u + threadIdx.x, db0_ = i0_ / per_, rem0_ = i0_ - db0_ * per_; \
    _Pragma("unroll") for (int u = 0; u < 8; ++u) { const unsigned rem_ = rem0_ + u * 512u; H##d[u] = i0_ + u * 512u + 512u * (db0_ + (rem_ >= per_ ? 1u : 0u)); H##v[u] = __builtin_nontemporal_load(src_ + H##d[u] + 512u); } } while (0)
#define HALF_STORE(H, c) do { const f32x4* src_; f32x4* dst_; unsigned cl_, per_; half_where(p, (c), src_, dst_, cl_, per_); \
    _Pragma("unroll") for (int u = 0; u < 8; ++u) __builtin_nontemporal_store(H##v[u], dst_ + H##d[u]); } while (0)
__device__ __forceinline__ unsigned copier_claim(unsigned* ctl, int done_slot, unsigned need) {
    const bool stop = need != 0u && __hip_atomic_load(ctl + 32 * done_slot, __ATOMIC_RELAXED, __HIP_MEMORY_SCOPE_AGENT) >= need;
    return stop ? 0xffffffffu : __hip_atomic_fetch_add(ctl, 1u, __ATOMIC_RELAXED, __HIP_MEMORY_SCOPE_AGENT);
}
__device__ void copier(KP p, int done_slot, unsigned need, unsigned char* smem) {
    unsigned* ctl = (unsigned*)(p->ws + WS_CTL); volatile unsigned* sh = (volatile unsigned*)smem;
    f32x4 Av[8], Bv[8]; unsigned Ad[8], Bd[8];
    __syncthreads();
    if (threadIdx.x == 0) sh[0] = copier_claim(ctl, done_slot, need);
    __syncthreads();
    unsigned ca = sh[0];
    if (ca >= NCHUNK) return;
    HALF_LOAD(A, ca);
    for (;;) {
        __syncthreads();
        if (threadIdx.x == 0) sh[0] = copier_claim(ctl, done_slot, need);
        __syncthreads();
        const unsigned cb = sh[0];
        if (cb < NCHUNK) HALF_LOAD(B, cb);
        HALF_STORE(A, ca);
        if (cb >= NCHUNK) break;
        __syncthreads();
        if (threadIdx.x == 0) sh[0] = copier_claim(ctl, done_slot, need);
        __syncthreads();
        ca = sh[0];
        if (ca < NCHUNK) HALF_LOAD(A, ca);
        HALF_STORE(B, cb);
        if (ca >= NCHUNK) break;
    }
}
__device__ __forceinline__ void gemm_done(KP p, int done_slot) {
    __syncthreads();
    if (threadIdx.x == 0) __hip_atomic_fetch_add((unsigned*)(p->ws + WS_CTL) + 32 * done_slot, 1u, __ATOMIC_RELAXED, __HIP_MEMORY_SCOPE_AGENT);
}

__global__ void __launch_bounds__(512) fwd(Params pv) {
    extern __shared__ __attribute__((aligned(16))) unsigned char smem[];
    cg::grid_group grid = cg::this_grid();
    const int G = gridDim.x, bid = blockIdx.x;
    constexpr int C3 = 8, C10 = 8, CN = 120;
#define WSP(T, off) ((T*)(p->ws + (off)))
    if (threadIdx.x < 4) ((volatile LAS unsigned*)(smem + 131072))[threadIdx.x] = 0u;
    __syncthreads();
    const XcdBarrier xbar = xcd_barrier_post((unsigned*)(pv.ws + WS_BAR), (volatile LAS unsigned*)(smem + 131072));
    if (pv.ws == nullptr) grid.sync();
    { KP p = kargs(); if (PHMASK & 1) phase_prep(p, smem); }
    xcd_barrier(xbar);
    { KP p = kargs(); if (bid < 24) { run_gemm(smem, WSP(const bf16_t, WS_SC), WSP(const bf16_t, WS_WADA), 256, NADA, D, FMod{WSP(float, WS_MOD), p->in[11]}, 24, bid); gemm_done(p, 1); } else copier(p, 1, 1u, smem); }
    xcd_barrier(xbar);
    { KP p = kargs(); if (PHMASK & 4) phase_norm(p->in[0], p->in[1], p->in[8], WSP(const float, WS_MOD), 0, 1, WSP(bf16_t, WS_H), nullptr, 0, nullptr); }
    xcd_barrier(xbar);
    { KP p = kargs(); if (bid >= C3) {
        LAS float* lb = (LAS float*)(smem + LDS_XTRA);
        for (int i = threadIdx.x; i < NIN + 32; i += 512) { float v;
            if (i < NIN) v = WSP(const float, WS_BIN)[i];
            else { double inv = 1.0; for (int q = 0; q < i - NIN; ++q) inv *= 0.74989420933245582730; v = (float)inv; }
            lb[i] = v; }
        __syncthreads();
        run_gemm(smem, WSP(const bf16_t, WS_H), WSP(const bf16_t, WS_WIN), M, NIN, D, FIn{WSP(bf16_t, WS_PROJ), WSP(float, WS_GLR), lb, p->out}, G - C3, bid - C3); gemm_done(p, 2); } else copier(p, 2, 5u, smem); }
    xcd_barrier(xbar);
    { KP p = kargs();
      unsigned* qctr = (unsigned*)(p->ws + WS_CTL) + 32 * 7; volatile unsigned* shq = (volatile unsigned*)(smem + 131072 + 8);
      for (;;) {
          __syncthreads();
          if (threadIdx.x == 0) shq[0] = __hip_atomic_fetch_add(qctr, 1u, __ATOMIC_RELAXED, __HIP_MEMORY_SCOPE_AGENT);
          __syncthreads();
          const int k = (int)shq[0]; if (k >= 3328) break;
          const int q = k / 13, r = k - q * 13;
          if ((r & 3) == 0 && r < 12) { const int si = 3 * q + (r >> 2);
              if (si < 256) dsw_sample(p, smem, si * 8 + (int)(threadIdx.x >> 6)); else gla_sample(p, smem, si - 256); }
          else { const int pi = 10 * q + r - ((r + 3) >> 2);
              if (pi < 1536) dsw_prompt(p, smem, pi); else gla_passA(p, smem, pi - 1536); }
      } }
    xcd_barrier(xbar);
    { KP p = kargs(); if (PHMASK & 512) gla_passB(p); }
    xcd_barrier(xbar);
    { KP p = kargs(); if (PHMASK & 1024) dsw_combine(p); }
    { KP p = kargs(); if (PHMASK & 2048) for (int it = bid; it < 1024; it += G) gla_passC(p, smem, it); }
    xcd_barrier(xbar);
    { KP p = kargs(); if (bid >= CN) { run_gemm(smem, WSP(const bf16_t, WS_OA), WSP(const bf16_t, WS_WPA), M, D, D, FPa{WSP(bf16_t, WS_MG), WSP(const bf16_t, WS_PROJ)}, G - CN, bid - CN); } }
    { KP p = kargs(); if (bid >= CN) { run_gemm(smem, WSP(const bf16_t, WS_OB), WSP(const bf16_t, WS_WPB), M, D, 256, FPb{WSP(bf16_t, WS_MG), WSP(const bf16_t, WS_PROJ)}, G - CN, bid - CN); gemm_done(p, 3); } else copier(p, 3, 9u, smem); }
    xcd_barrier(xbar);
    { KP p = kargs(); if (bid >= CN) { run_gemm(smem, WSP(const bf16_t, WS_MG), WSP(const bf16_t, WS_WOUT), M, D, D, FOut{WSP(bf16_t, WS_X1), p->in[0], p->in[1], WSP(const float, WS_MOD)}, G - CN, bid - CN); gemm_done(p, 4); } else copier(p, 4, 9u, smem); }
    xcd_barrier(xbar);
    { KP p = kargs(); if (PHMASK & 32768) phase_norm(nullptr, nullptr, p->in[9], WSP(const float, WS_MOD), 3, 4, WSP(bf16_t, WS_H), nullptr, 0, WSP(const bf16_t, WS_X1)); }
    xcd_barrier(xbar);
    { KP p = kargs(); if (bid >= C10) { run_gemm(smem, WSP(const bf16_t, WS_H), WSP(const bf16_t, WS_WUP), M, NUP, D, FUp{WSP(bf16_t, WS_ACT)}, G - C10, bid - C10); gemm_done(p, 5); } else copier(p, 5, 37u, smem); }
    xcd_barrier(xbar);
    { KP p = kargs(); if (bid >= CN) { run_gemm(smem, WSP(const bf16_t, WS_ACT), WSP(const bf16_t, WS_WDN), M, D, DFF, FDown{WSP(bf16_t, WS_X1), WSP(const float, WS_MOD)}, G - CN, bid - CN); gemm_done(p, 6); } else copier(p, 6, 9u, smem); }
    xcd_barrier(xbar);
    { KP p = kargs(); if (PHMASK & 262144) phase_norm(nullptr, nullptr, p->in[22], WSP(const float, WS_MOD), 0, 0, nullptr, p->out + O_Y, 1, WSP(const bf16_t, WS_X1));
      copier(p, 0, 0u, smem); }
#undef WSP
}
}

extern "C" void kernel_launch(void* const* d_in, const int* in_sizes, int n_in, void* d_out, int out_size, void* d_ws, size_t ws_size, hipStream_t stream) {
    static int grid = 0;
    if (grid == 0) {
        int dev = 0, cus = 0, per_cu = 0;
        hipGetDevice(&dev);
        hipDeviceGetAttribute(&cus, hipDeviceAttributeMultiprocessorCount, dev);
        if (hipFuncSetAttribute((const void*)mk::fwd, hipFuncAttributeMaxDynamicSharedMemorySize, mk::LDS_BYTES) != hipSuccess) fprintf(stderr, "kernel_launch: hipFuncSetAttribute failed\n");
        if (hipOccupancyMaxActiveBlocksPerMultiprocessor(&per_cu, (const void*)mk::fwd, 512, mk::LDS_BYTES) != hipSuccess || per_cu < 1) { fprintf(stderr, "kernel_launch: occupancy query says %d blocks per CU\n", per_cu); per_cu = 1; }
        (void)hipGetLastError();
        grid = cus > 0 ? cus : 256;
        if (n_in != 23 || (size_t)out_size != mk::O_END || ws_size < mk::WS_END) fprintf(stderr, "kernel_launch: unexpected sizes n_in %d out %d ws %zu (need %zu)\n", n_in, out_size, ws_size, (size_t)mk::WS_END);
    }
    if (hipMemsetAsync((char*)d_ws + mk::WS_CTL, 0, 4096 + 16384, stream) != hipSuccess) fprintf(stderr, "kernel_launch: memset of control words failed\n");
    mk::Params p{};
    for (int i = 0; i < 23; ++i) p.in[i] = (const float*)d_in[i];
    p.out = (float*)d_out; p.ws = (unsigned char*)d_ws;
    void* args[] = {&p};
    hipError_t e = hipLaunchCooperativeKernel((const void*)mk::fwd, dim3(grid), dim3(512), args, mk::LDS_BYTES, stream);
    if (e != hipSuccess) fprintf(stderr, "cooperative launch failed: %s (grid %d)\n", hipGetErrorString(e), grid);
}
```

```cpp
#include <hip/hip_runtime.h>
#include <hip/hip_cooperative_groups.h>
#include <cstdio>
namespace cg = cooperative_groups;
namespace pg8 {
#define PG8_LAS __attribute__((address_space(3)))
typedef unsigned short bf16_t;
typedef short bf16x8 __attribute__((ext_vector_type(8)));
typedef float f32x4 __attribute__((ext_vector_type(4)));
typedef unsigned u32x4 __attribute__((ext_vector_type(4)));
constexpr int BM = 256, BK = 64, HALF = 128, HTB = HALF * BK * 2  , STAGE_BYTES = 8 * HTB, NXCD = 8, WGM = 8;

__host__ __device__ __forceinline__ int lds_byte(int r, int c) { const int st = (r >> 4) * 2 + (c >> 5), rr = r & 15, cc = c & 31, ob = rr * 64 + cc * 2; return st * 1024 + (ob ^ (((ob >> 9) & 1) << 5)); }
__host__ __device__ __forceinline__ void stage_rc(int b, int& R, int& C) { const int st = b / 1024, sb = b % 1024, swz = sb ^ (((sb >> 9) & 1) << 5); R = (st >> 1) * 16 + swz / 64; C = (st & 1) * 32 + (swz % 64) / 2; }
__host__ __device__ __forceinline__ int perm32(int rho) { const int n = rho >> 4, i = rho & 15; return 8 * (i >> 2) + 4 * n + (i & 3); }

struct Unit { int pm, pn; };
struct Gemm { const bf16_t* A; const bf16_t* Bt; int M, N, K; };

struct StaticOrder {
    int nM, nN, nwg, G, c;
    __host__ __device__ void init(int M, int N, int G_, int c_) { nM = M / BM; nN = N / BM; nwg = nM * nN; G = G_; c = c_; }
    __host__ __device__ bool next(int i, Unit& u) const {
        const long L = (long)i * G + c; if (L >= nwg) return false;
        int wgid = (int)L; { const int q = nwg / NXCD, r = nwg % NXCD, xcd = wgid % NXCD, off = wgid / NXCD; wgid = (xcd < r ? xcd * (q + 1) : r * (q + 1) + (xcd - r) * q) + off; }
        const int nig = WGM * nN, gid = wgid / nig, fm = gid * WGM, gsz = (nM - fm) < WGM ? (nM - fm) : WGM;
        u.pm = fm + ((wgid % nig) % gsz); u.pn = (wgid % nig) / gsz; return true;
    }
    __device__ __forceinline__ void a_ready(const Unit&) const {}
    __device__ __forceinline__ void done(const Unit&) const {}
};
__device__ __forceinline__ unsigned cvt_pk_bf16(float lo, float hi) { unsigned r; asm volatile("v_cvt_pk_bf16_f32 %0, %1, %2" : "=v"(r) : "v"(lo), "v"(hi)); return r; }
typedef float f32x2 __attribute__((ext_vector_type(2)));
template <class Epi, class Sched, bool STAMP = false>
__device__ __forceinline__ void gemm_phase(PG8_LAS unsigned char* lds, const Gemm g, const Sched& S, const Epi& E, unsigned long long* stamps) {
    const int tid = threadIdx.x, wid = __builtin_amdgcn_readfirstlane(tid >> 6), lane = tid & 63, wr = wid >> 2, wc = wid & 3, fr = lane & 15, fq = lane >> 4;
    const int K = g.K, nt = K / BK;
    int ts_lo = 0, ts_hi = 0, nts = 0; const unsigned long long rt_entry = STAMP ? (unsigned long long)wall_clock64() : 0ull;
#define PG8_STAMP() do { if (STAMP && wid == 0 && nts < 64) { const unsigned long long _c = (unsigned long long)clock64(); \
        ts_lo = (lane == nts) ? (int)(unsigned)_c : ts_lo; ts_hi = (lane == nts) ? (int)(unsigned)(_c >> 32) : ts_hi; ++nts; } } while (0)
    PG8_STAMP();
    unsigned voffA[2], voffB[2];
#pragma unroll
    for (int i = 0; i < 2; ++i) { int R, C; stage_rc(tid * 16 + i * 8192, R, C); const int Rb = Epi::PERM ? ((R & ~31) + perm32(R & 31)) : R;
        voffA[i] = (unsigned)(R * K + C) * 2u; voffB[i] = (unsigned)(Rb * K + C) * 2u; }
    const size_t kstep = (size_t)(BK * 2);
    const size_t hstep = (size_t)HALF * K * 2;
    const size_t tstep = 2 * hstep;
    const unsigned ldsw = (unsigned)wid * 1024u;
    const int aoff = lds_byte(wr * 64 + fr, fq * 8), boff = lds_byte(wc * 32 + fr, fq * 8);
#define PG8_SA(b, h) (((b) * 2 + (h)) * HTB)
#define PG8_SB(b, h) ((4 + (b) * 2 + (h)) * HTB)
#define PG8_STAGE(bufoff, gbase, voff) do { _Pragma("unroll") for (int _i = 0; _i < 2; ++_i) \
        __builtin_amdgcn_global_load_lds((const unsigned*)((const char*)(gbase) + (voff)[_i]), (PG8_LAS unsigned*)(lds + (bufoff) + ldsw + _i * 8192), 16, 0, 0); } while (0)
#define PG8_LDA(dst, b, h) do { _Pragma("unroll") for (int m = 0; m < 4; ++m) _Pragma("unroll") for (int k = 0; k < 2; ++k) dst[m][k] = *(const PG8_LAS bf16x8*)(lds + PG8_SA(b, h) + aoff + m * 2048 + k * 1024); } while (0)
#define PG8_LDB(dst, b, h) do { _Pragma("unroll") for (int n = 0; n < 2; ++n) _Pragma("unroll") for (int k = 0; k < 2; ++k) dst[n][k] = *(const PG8_LAS bf16x8*)(lds + PG8_SB(b, h) + boff + n * 2048 + k * 1024); } while (0)
#define PG8_MMA(ai, bj, At, Bt) do { __builtin_amdgcn_s_setprio(1); _Pragma("unroll") for (int m = 0; m < 4; ++m) _Pragma("unroll") for (int n = 0; n < 2; ++n) _Pragma("unroll") for (int k = 0; k < 2; ++k) \
        acc[ai][bj][m][n] = __builtin_amdgcn_mfma_f32_16x16x32_bf16(Bt[n][k], At[m][k], acc[ai][bj][m][n], 0, 0, 0); __builtin_amdgcn_s_setprio(0); } while (0)
#define PG8_WAIT_V(n) asm volatile("s_waitcnt vmcnt(" #n ")" ::: "memory")
#define PG8_WAIT_L(n) asm volatile("s_waitcnt lgkmcnt(" #n ")" ::: "memory")
#define PG8_BAR __builtin_amdgcn_s_barrier()
#define PG8_SCHED __builtin_amdgcn_sched_barrier(0)
    Unit cur, nxt; int ui = 0;
    if (!S.next(0, cur)) return;
    f32x4 acc[2][2][4][2];
#pragma unroll
    for (int a = 0; a < 2; ++a)
#pragma unroll
        for (int b = 0; b < 2; ++b)
#pragma unroll
            for (int m = 0; m < 4; ++m)
#pragma unroll
                for (int n = 0; n < 2; ++n) acc[a][b][m][n] = (f32x4){0.f, 0.f, 0.f, 0.f};
    bf16x8 At[4][2], B0[2][2], B1[2][2];
    const char* cA = (const char*)g.A + (size_t)cur.pm * tstep; const char* cB = (const char*)g.Bt + (size_t)cur.pn * tstep;
    S.a_ready(cur);
    PG8_STAGE(PG8_SB(0, 0), cB, voffB); PG8_STAGE(PG8_SA(0, 0), cA, voffA); PG8_STAGE(PG8_SB(0, 1), cB + hstep, voffB); PG8_STAGE(PG8_SA(0, 1), cA + hstep, voffA);
    if (wr == 1) PG8_BAR;
    PG8_WAIT_V(4); PG8_BAR;
    PG8_STAGE(PG8_SB(1, 0), cB + kstep, voffB); PG8_STAGE(PG8_SA(1, 0), cA + kstep, voffA); PG8_STAGE(PG8_SB(1, 1), cB + hstep + kstep, voffB);
    PG8_WAIT_V(6); PG8_BAR;
    PG8_STAMP();
    for (;;) {
        const bool has_next = S.next(ui + 1, nxt);
        const char* nA = has_next ? (const char*)g.A + (size_t)nxt.pm * tstep : cA; const char* nB = has_next ? (const char*)g.Bt + (size_t)nxt.pn * tstep : cB;
        for (int t = 0; t < nt; t += 2) {
            const bool last = (t == nt - 2);
            const char* a1 = cA + (size_t)(t + 1) * kstep;
            const char* a2 = last ? nA : cA + (size_t)(t + 2) * kstep; const char* b2 = last ? nB : cB + (size_t)(t + 2) * kstep;
            const char* a3 = a2 + kstep; const char* b3 = b2 + kstep;
            if (last && has_next) S.a_ready(nxt);
            PG8_LDB(B0, 0, 0); PG8_SCHED; PG8_LDA(At, 0, 0); PG8_STAGE(PG8_SA(1, 1), a1 + hstep, voffA);
            PG8_WAIT_L(8); PG8_BAR; PG8_WAIT_L(0); PG8_MMA(0, 0, At, B0); PG8_BAR; PG8_SCHED;
            PG8_LDB(B1, 0, 1); PG8_STAGE(PG8_SB(0, 0), b2, voffB);
            PG8_BAR; PG8_WAIT_L(0); PG8_MMA(0, 1, At, B1); PG8_BAR;
            PG8_LDA(At, 0, 1); PG8_STAGE(PG8_SA(0, 0), a2, voffA);
            PG8_BAR; PG8_WAIT_L(0); PG8_MMA(1, 0, At, B0); PG8_BAR; PG8_SCHED;
            PG8_STAGE(PG8_SB(0, 1), b2 + hstep, voffB);
            PG8_WAIT_V(6); PG8_BAR; PG8_MMA(1, 1, At, B1); PG8_BAR;
            PG8_LDB(B0, 1, 0); PG8_SCHED; PG8_LDA(At, 1, 0); PG8_STAGE(PG8_SA(0, 1), a2 + hstep, voffA);
            PG8_WAIT_L(8); PG8_BAR; PG8_WAIT_L(0); PG8_MMA(0, 0, At, B0); PG8_BAR; PG8_SCHED;
            PG8_LDB(B1, 1, 1); PG8_STAGE(PG8_SB(1, 0), b3, voffB);
            PG8_BAR; PG8_WAIT_L(0); PG8_MMA(0, 1, At, B1); PG8_BAR;
            PG8_LDA(At, 1, 1); PG8_STAGE(PG8_SA(1, 0), a3, voffA);
            PG8_BAR; PG8_WAIT_L(0); PG8_MMA(1, 0, At, B0); PG8_BAR; PG8_SCHED;
            PG8_STAGE(PG8_SB(1, 1), b3 + hstep, voffB);
            PG8_WAIT_V(6); PG8_BAR; PG8_MMA(1, 1, At, B1); PG8_BAR;
        }
        PG8_STAMP();
        if constexpr (!Epi::AFTER_DRAIN) { E(acc, cur, wr, wc, fr, fq); S.done(cur); }
        PG8_STAMP();
        if (!has_next) break;
#pragma unroll
        for (int a = 0; a < 2; ++a)
#pragma unroll
            for (int b = 0; b < 2; ++b)
#pragma unroll
                for (int m = 0; m < 4; ++m)
#pragma unroll
                    for (int n = 0; n < 2; ++n) acc[a][b][m][n] = (f32x4){0.f, 0.f, 0.f, 0.f};
        cur = nxt; cA = nA; cB = nB; ++ui;
    }
    PG8_WAIT_V(0);
    if (wr == 0) PG8_BAR;
    PG8_BAR;
    if constexpr (Epi::AFTER_DRAIN) { E.fused(acc, cur, wr, wc, fr, fq, lds, wid, lane); S.done(cur); }
    PG8_STAMP();
    if (STAMP && wid == 0) { stamps[lane] = lane < nts ? (((unsigned long long)(unsigned)ts_hi << 32) | (unsigned)ts_lo) : 0ull;
        if (lane == 62) stamps[62] = rt_entry; if (lane == 63) stamps[63] = (unsigned long long)wall_clock64(); }
#undef PG8_STAMP
#undef PG8_SA
#undef PG8_SB
#undef PG8_STAGE
#undef PG8_LDA
#undef PG8_LDB
#undef PG8_MMA
#undef PG8_WAIT_V
#undef PG8_WAIT_L
#undef PG8_BAR
#undef PG8_SCHED
}
}

#define XB_TMO      128
#define XB_XCNT(j)  (256  + 64 * (j))
#define XB_XSUB(j)  (1280 + 64 * (j))
#define XB_XGEN(j)  (2304 + 64 * (j))
#define XB_TOP      3328
#define XB_TOPGEN   3392
#define XCD_BAR_WORDS 3456
#define XB_SPIN_CAP (1u << 18)
#define LAS __attribute__((address_space(3)))

__device__ __forceinline__ unsigned xb_ld(unsigned* p)              { return __hip_atomic_load(p, __ATOMIC_RELAXED, __HIP_MEMORY_SCOPE_AGENT); }
__device__ __forceinline__ unsigned xb_add(unsigned* p, unsigned v) { return __hip_atomic_fetch_add(p, v, __ATOMIC_RELAXED, __HIP_MEMORY_SCOPE_AGENT); }
__device__ __forceinline__ unsigned xb_xcc_id() { return (unsigned)__builtin_amdgcn_s_getreg((3 << 11) | 20) & 0xFu; }
#define XB_SPIN(cond, bar) do { unsigned _sp = 0; while (cond) { __builtin_amdgcn_s_sleep(1); \
    if ((++_sp & 255u) == 0u) { if (xb_ld(&(bar)[XB_TMO])) break; if (_sp > XB_SPIN_CAP) { atomicAdd(&(bar)[XB_TMO], 1u); break; } } } } while (0)

struct XcdBarrier {
    unsigned* bar; unsigned x;
    volatile LAS unsigned* st;
};

__device__ __forceinline__ XcdBarrier xcd_barrier_post(unsigned* bar, volatile LAS unsigned* st) {
    XcdBarrier b; b.bar = bar; b.x = xb_xcc_id(); b.st = st;
    if (threadIdx.x == 0) (void)xb_add(&bar[XB_XCNT(b.x)], 1u);
    return b;
}
__device__ __forceinline__ void xcd_barrier_complete(unsigned* bar, unsigned x, unsigned& nloc, unsigned& nx) {
    const unsigned G = gridDim.x * gridDim.y * gridDim.z;
    unsigned sum, cnt, mine, sp = 0u;
    for (;;) {
        sum = 0u; cnt = 0u; mine = 0u;
#pragma unroll
        for (unsigned j = 0; j < 16; ++j) { const unsigned c = xb_ld(&bar[XB_XCNT(j)]); sum += c; cnt += (c > 0u) ? 1u : 0u; mine = (j == x) ? c : mine; }
        if (sum == G) break;
        __builtin_amdgcn_s_sleep(1);
        if ((++sp & 255u) == 0u) { if (xb_ld(&bar[XB_TMO])) break; if (sp > XB_SPIN_CAP) { atomicAdd(&bar[XB_TMO], 1u); break; } }
    }
    nloc = mine > 0u ? mine : 1u; nx = cnt > 0u ? cnt : 1u;
}

__device__ __forceinline__ void xcd_barrier(const XcdBarrier& b) {
    asm volatile("s_waitcnt vmcnt(0)" ::: "memory");
    __syncthreads();
    if (threadIdx.x == 0) {
        unsigned* bar = b.bar;
        __builtin_amdgcn_s_waitcnt(0);
        unsigned nloc = b.st[0], nx = b.st[1];
        if (nloc == 0u) { xcd_barrier_complete(bar, b.x, nloc, nx); b.st[0] = nloc; b.st[1] = nx; }
        const unsigned old = xb_add(&bar[XB_XSUB(b.x)], 1u);
        const unsigned gen = old / nloc;
        if (old + 1u == (gen + 1u) * nloc) {
            __builtin_amdgcn_fence(__ATOMIC_RELEASE, "agent");
            asm volatile("s_waitcnt vmcnt(0)" ::: "memory");
            const unsigned og = xb_add(&bar[XB_TOP], 1u);
            const unsigned tg = og / nx;
            if (og + 1u == (tg + 1u) * nx) xb_add(&bar[XB_TOPGEN], 1u);
            else XB_SPIN(xb_ld(&bar[XB_TOPGEN]) == tg, bar);
            __builtin_amdgcn_fence(__ATOMIC_ACQUIRE, "agent");
            xb_add(&bar[XB_XGEN(b.x)], 1u);
            asm volatile("s_waitcnt vmcnt(0)" ::: "memory");
        } else {
            XB_SPIN(xb_ld(&bar[XB_XGEN(b.x)]) == gen, bar);
            __builtin_amdgcn_fence(__ATOMIC_ACQUIRE, "agent");
            asm volatile("s_waitcnt vmcnt(0)" ::: "memory");
        }
    }
    __syncthreads();
}

#ifndef PHMASK
#define PHMASK 0x7FFFF
#endif
namespace mk {
using pg8::bf16_t; using pg8::bf16x8; using pg8::f32x4; using pg8::u32x4;
typedef unsigned u32x2 __attribute__((ext_vector_type(2)));
typedef float f32x2 __attribute__((ext_vector_type(2)));

constexpr int D = 1024, T = 4096, NB = 4, TP = NB * T, DBATCH = 128, SS = 4, TS = DBATCH * SS, M = TP + TS;
constexpr int NIN = 7680, NADA = 6144, NUP = 5632, DFF = 2816;
constexpr int C_GQ = 0, C_GK = 512, C_GV = 1024, C_GR = 2048, C_DQ = 3072, C_DK = 3840, C_DV = 4608, C_GA = 5376, C_GB = 6400, C_GLR = 7424, C_END = 7440;
constexpr int LDS_XTRA = 131072 + 16;
constexpr int LDS_BYTES = LDS_XTRA + (7680 + 32) * 4;
constexpr float EPS = 1e-6f;

constexpr size_t al(size_t x) { return (x + 255) & ~(size_t)255; }
constexpr size_t WS_WADA = 0;
constexpr size_t WS_WIN = WS_WADA + al((size_t)NADA * D * 2);
constexpr size_t WS_WPA = WS_WIN + al((size_t)NIN * D * 2);
constexpr size_t WS_WPB = WS_WPA + al((size_t)D * D * 2);
constexpr size_t WS_WOUT = WS_WPB + al((size_t)D * 256 * 2);
constexpr size_t WS_WUP = WS_WOUT + al((size_t)D * D * 2);
constexpr size_t WS_WDN = WS_WUP + al((size_t)NUP * D * 2);
constexpr size_t WS_BIN = WS_WDN + al((size_t)D * DFF * 2);
constexpr size_t WS_SC = WS_BIN + al((size_t)NIN * 4);
constexpr size_t WS_ROPE = WS_SC + al((size_t)256 * D * 2);
constexpr size_t WS_MOD = WS_ROPE + al((size_t)4100 * 32 * 8);
constexpr size_t WS_H = WS_MOD + al((size_t)256 * NADA * 4);
constexpr size_t WS_PROJ = WS_H + al((size_t)M * D * 2);
constexpr size_t WS_GLR = WS_PROJ + al((size_t)M * NIN * 2);
constexpr size_t WS_U = WS_GLR + al((size_t)M * 16 * 4);
constexpr size_t WS_DEC = WS_U + al((size_t)1024 * 32768 * 4);
constexpr size_t WS_SST = WS_DEC + al((size_t)1024 * 128 * 4);
constexpr size_t WS_OG = WS_SST + al((size_t)1024 * 32768 * 2);
constexpr size_t WS_LSE = WS_OG + al((size_t)TP * 768 * 2);
constexpr size_t WS_OA = WS_LSE + al((size_t)TP * 12 * 4);
constexpr size_t WS_OB = WS_OA + al((size_t)M * D * 2);
constexpr size_t WS_MG = WS_OB + al((size_t)M * 256 * 2);
constexpr size_t WS_X1 = WS_MG + al((size_t)M * D * 2);
constexpr size_t WS_ACT = WS_X1 + al((size_t)M * D * 4);
constexpr size_t WS_CTL = WS_ACT + al((size_t)M * DFF * 2);
constexpr size_t WS_BAR = WS_CTL + 4096;
constexpr size_t WS_END = WS_BAR + 16384;

constexpr size_t O_Y = 0;
constexpr size_t O_SGP = O_Y + (size_t)M * D;
constexpr size_t O_KVP0 = O_SGP + (size_t)4 * 4 * 128 * 256;
constexpr size_t O_KVP1 = O_KVP0 + (size_t)4 * 128 * 512;
constexpr size_t O_KVP2 = O_KVP1 + (size_t)4 * 512 * 512;
constexpr size_t O_SGS = O_KVP2 + (size_t)4 * 2048 * 512;
constexpr size_t O_KVS0 = O_SGS + (size_t)128 * 4 * 128 * 256;
constexpr size_t O_KVS1 = O_KVS0 + (size_t)128 * 128 * 512;
constexpr size_t O_KVS2 = O_KVS1 + (size_t)128 * 512 * 512;
constexpr size_t O_END = O_KVS2 + (size_t)128 * 2048 * 512;

struct Params { const float* in[23]; float* out; unsigned char* ws; };
typedef const __attribute__((address_space(4))) Params* KP;
__device__ __forceinline__ KP kargs() { KP k = (KP)__builtin_amdgcn_kernarg_segment_ptr(); asm volatile("" : "+s"(k)); return k; }

__device__ __forceinline__ float bf2f(unsigned short b) { return __uint_as_float(((unsigned)b) << 16); }
__device__ __forceinline__ unsigned short f2bf(float f) { unsigned u = __float_as_uint(f); u += 0x7FFFu + ((u >> 16) & 1u); return (unsigned short)(u >> 16); }
__device__ __forceinline__ unsigned pk2(float lo, float hi) { unsigned r; asm("v_cvt_pk_bf16_f32 %0, %1, %2" : "=v"(r) : "v"(lo), "v"(hi)); return r; }
__device__ __forceinline__ float silu_f(float x) { return x * __builtin_amdgcn_rcpf(1.f + __expf(-x)); }
__device__ __forceinline__ float sigm_f(float x) { return __builtin_amdgcn_rcpf(1.f + __expf(-x)); }
__device__ __forceinline__ int brow_of(int row) { return row < TP ? (row >> 12) : 4 + ((row - TP) >> 2); }
__device__ __forceinline__ size_t okvp(int g) { return g == 0 ? O_KVP0 : (g == 1 ? O_KVP1 : O_KVP2); }
__device__ __forceinline__ size_t okvs(int g) { return g == 0 ? O_KVS0 : (g == 1 ? O_KVS1 : O_KVS2); }
__device__ __forceinline__ f32x4 mfma16(bf16x8 a, bf16x8 b, f32x4 c) { return __builtin_amdgcn_mfma_f32_16x16x32_bf16(a, b, c, 0, 0, 0); }
__device__ __forceinline__ u32x4 pack8(f32x4 a, f32x4 b) { u32x4 w; w.x = pk2(a[0], a[1]); w.y = pk2(a[2], a[3]); w.z = pk2(b[0], b[1]); w.w = pk2(b[2], b[3]); return w; }
__device__ __forceinline__ void unpack8(u32x4 w, f32x4& a, f32x4& b) {
    a[0] = __uint_as_float(w.x << 16); a[1] = __uint_as_float(w.x & 0xffff0000u); a[2] = __uint_as_float(w.y << 16); a[3] = __uint_as_float(w.y & 0xffff0000u);
    b[0] = __uint_as_float(w.z << 16); b[1] = __uint_as_float(w.z & 0xffff0000u); b[2] = __uint_as_float(w.w << 16); b[3] = __uint_as_float(w.w & 0xffff0000u); }

__device__ __forceinline__ int map_in(int n) {
    if (n < 3072) return n;
    if (n < C_DV) { const int isK = n >= C_DK; const int j = n - (isK ? C_DK : C_DQ); const int head = j >> 6, p = j & 63; return (isK ? 3856 : 3088) + head * 64 + (p >> 1) + 32 * (p & 1); }
    if (n < C_GA) return 4624 + (n - C_DV);
    if (n < C_GB) return 5392 + (n - C_GA);
    if (n < C_GLR) return 6416 + (n - C_GB);
    if (n < C_END) return 3072 + (n - C_GLR);
    return -1;
}
__device__ __forceinline__ int map_up(int n) { const int q = n >> 3, e = n & 7; return e < 4 ? 4 * q + e : DFF + 4 * q + e - 4; }

__device__ __forceinline__ void tr_tile(const float* __restrict__ W, int ldw, bf16_t* __restrict__ Bt, int K, int n0, int k0, int mapid, unsigned char* smem) {
    unsigned short* t = (unsigned short*)smem;
    const int tid = threadIdx.x, lane = tid & 63, w8 = tid >> 6;
    const int n = n0 + lane; const int src = mapid == 0 ? n : (mapid == 1 ? map_in(n) : map_up(n));
#pragma unroll
    for (int j = 0; j < 8; ++j) { const int kk = w8 + 8 * j; const float v = src >= 0 ? W[(size_t)(k0 + kk) * ldw + src] : 0.f; t[kk * 66 + lane] = f2bf(v); }
    __syncthreads();
#pragma unroll
    for (int j = 0; j < 8; ++j) { const int nn = w8 + 8 * j; Bt[(size_t)(n0 + nn) * K + k0 + lane] = t[lane * 66 + nn]; }
    __syncthreads();
}

__device__ void phase_prep(KP p, unsigned char* smem) {
    const int G = gridDim.x;
    for (int ti = blockIdx.x; ti < 6144; ti += G) {
        const float* W; int ldw, K, kT, mapid, base; bf16_t* Bt;
        if (ti < 1536)      { W = p->in[10]; ldw = NADA; K = D;   kT = 16; mapid = 0; base = 0;    Bt = (bf16_t*)(p->ws + WS_WADA); }
        else if (ti < 3456) { W = p->in[12]; ldw = 7440; K = D;   kT = 16; mapid = 1; base = 1536; Bt = (bf16_t*)(p->ws + WS_WIN); }
        else if (ti < 3712) { W = p->in[17]; ldw = D;    K = D;   kT = 16; mapid = 0; base = 3456; Bt = (bf16_t*)(p->ws + WS_WPA); }
        else if (ti < 3776) { W = p->in[18]; ldw = D;    K = 256; kT = 4;  mapid = 0; base = 3712; Bt = (bf16_t*)(p->ws + WS_WPB); }
        else if (ti < 4032) { W = p->in[19]; ldw = D;    K = D;   kT = 16; mapid = 0; base = 3776; Bt = (bf16_t*)(p->ws + WS_WOUT); }
        else if (ti < 5440) { W = p->in[20]; ldw = NUP;  K = D;   kT = 16; mapid = 2; base = 4032; Bt = (bf16_t*)(p->ws + WS_WUP); }
        else                { W = p->in[21]; ldw = D;    K = DFF; kT = 44; mapid = 0; base = 5440; Bt = (bf16_t*)(p->ws + WS_WDN); }
        const int li = ti - base, nt = li / kT, kt = li % kT;
        tr_tile(W, ldw, Bt, K, nt * 64, kt * 64, mapid, smem);
    }
    const int gtid = blockIdx.x * 512 + threadIdx.x, gsz = G * 512;
    float* bin = (float*)(p->ws + WS_BIN);
    for (int n = gtid; n < NIN; n += gsz) { const int m = map_in(n); bin[n] = m >= 0 ? p->in[13][m] : 0.f; }
    bf16_t* sc = (bf16_t*)(p->ws + WS_SC);
    for (int i = gtid; i < 256 * D; i += gsz) { const int r = i >> 10, c = i & 1023; float v = 0.f;
        if (r < 4) v = p->in[6][r * D + c]; else if (r < 132) v = p->in[7][(r - 4) * D + c];
        sc[i] = f2bf(silu_f(v)); }
}

template <class F> struct EpiF {
    static constexpr bool PERM = true, AFTER_DRAIN = false;
    F f;
    __device__ __forceinline__ void operator()(const f32x4 (&acc)[2][2][4][2], const pg8::Unit& u, int wr, int wc, int fr, int fq) const {
#pragma unroll
        for (int ai = 0; ai < 2; ++ai)
#pragma unroll
            for (int m = 0; m < 4; ++m) {
                const int row = u.pm * 256 + ai * 128 + wr * 64 + m * 16 + fr;
#pragma unroll
                for (int bj = 0; bj < 2; ++bj) { const int col = u.pn * 256 + bj * 128 + wc * 32 + 8 * fq; f(row, col, acc[ai][bj][m][0], acc[ai][bj][m][1]); }
            }
    }
};

struct FMod { float* mod; const float* bias;
    __device__ __forceinline__ void operator()(int row, int col, f32x4 a, f32x4 b) const {
        a += *(const f32x4*)(bias + col); b += *(const f32x4*)(bias + col + 4);
        float* d = mod + (size_t)row * NADA + col; *(f32x4*)d = a; *(f32x4*)(d + 4) = b; } };

struct FIn { bf16_t* proj; float* glr; const LAS float* lb; float* out;
    __device__ __forceinline__ void kvout(int row, int g, int hh, int kv, int f, f32x4 v) const {
        const int W = 128 << (2 * g);
        if (row < TP) { const int t = row & 4095, b = row >> 12; if (t >= T - W) { float* d = out + okvp(g) + ((size_t)(b * W + t - (T - W)) * 2 + kv) * 256 + hh * 64 + f; *(f32x4*)d = v; } }
        else { const int r = row - TP, db = r >> 2, s = r & 3; float* d = out + okvs(g) + ((size_t)(db * W + W - 4 + s) * 2 + kv) * 256 + hh * 64 + f; *(f32x4*)d = v; }
    }
    __device__ __forceinline__ void operator()(int row, int col, f32x4 a, f32x4 b) const {
        if (col >= C_END) return;
        a += *(const LAS f32x4*)(lb + col); b += *(const LAS f32x4*)(lb + col + 4);
        if (col >= C_GLR) { float* d = glr + (size_t)row * 16 + (col - C_GLR); *(f32x4*)d = a; *(f32x4*)(d + 4) = b; return; }
        if (col >= C_GA) {
#pragma unroll
            for (int j = 0; j < 4; ++j) { a[j] = sigm_f(a[j]); b[j] = sigm_f(b[j]); }
        } else if (col >= C_DQ && col < C_DV) {
            const int isK = col >= C_DK; const int j = col - (isK ? C_DK : C_DQ); const int head = j >> 6, i0 = (j & 63) >> 1;
            const float posf = (float)(row < TP ? (row & 4095) : 8192 + ((row - TP) & 3));
            const f32x4 inv4 = *(const LAS f32x4*)(lb + NIN + i0);
            f32x4 cs0, cs1;
            { const float r0 = __builtin_amdgcn_fractf(posf * inv4[0] * 0.15915494309189535f), r1 = __builtin_amdgcn_fractf(posf * inv4[1] * 0.15915494309189535f),
                          r2 = __builtin_amdgcn_fractf(posf * inv4[2] * 0.15915494309189535f), r3 = __builtin_amdgcn_fractf(posf * inv4[3] * 0.15915494309189535f);
              cs0[0] = __builtin_amdgcn_cosf(r0); cs0[1] = __builtin_amdgcn_sinf(r0); cs0[2] = __builtin_amdgcn_cosf(r1); cs0[3] = __builtin_amdgcn_sinf(r1);
              cs1[0] = __builtin_amdgcn_cosf(r2); cs1[1] = __builtin_amdgcn_sinf(r2); cs1[2] = __builtin_amdgcn_cosf(r3); cs1[3] = __builtin_amdgcn_sinf(r3); }
            f32x4 ra, rb;
            ra[0] = a[0] * cs0[0] - a[1] * cs0[1]; ra[1] = a[1] * cs0[0] + a[0] * cs0[1];
            ra[2] = a[2] * cs0[2] - a[3] * cs0[3]; ra[3] = a[3] * cs0[2] + a[2] * cs0[3];
            rb[0] = b[0] * cs1[0] - b[1] * cs1[1]; rb[1] = b[1] * cs1[0] + b[0] * cs1[1];
            rb[2] = b[2] * cs1[2] - b[3] * cs1[3]; rb[3] = b[3] * cs1[2] + b[2] * cs1[3];
            a = ra; b = rb;
            if (isK) { f32x4 x1, x2; x1[0] = a[0]; x1[1] = a[2]; x1[2] = b[0]; x1[3] = b[2]; x2[0] = a[1]; x2[1] = a[3]; x2[2] = b[1]; x2[3] = b[3];
                kvout(row, head >> 2, head & 3, 0, i0, x1); kvout(row, head >> 2, head & 3, 0, 32 + i0, x2); }
        } else if (col >= C_DV && col < C_GA) {
            const int j = col - C_DV, head = j >> 6, f = j & 63;
            kvout(row, head >> 2, head & 3, 1, f, a); kvout(row, head >> 2, head & 3, 1, f + 4, b);
        }
        *(u32x4*)(proj + (size_t)row * NIN + col) = pack8(a, b);
    } };

struct FPa { bf16_t* mg; const bf16_t* proj;
    __device__ __forceinline__ void operator()(int row, int col, f32x4 a, f32x4 b) const {
        f32x4 g0, g1; unpack8(*(const u32x4*)(proj + (size_t)row * NIN + C_GA + col), g0, g1);
        *(u32x4*)(mg + (size_t)row * D + col) = pack8(a * g0, b * g1); } };
struct FPb { bf16_t* mg; const bf16_t* proj;
    __device__ __forceinline__ void operator()(int row, int col, f32x4 a, f32x4 b) const {
        f32x4 g0, g1, m0, m1; unpack8(*(const u32x4*)(proj + (size_t)row * NIN + C_GB + col), g0, g1);
        unpack8(*(const u32x4*)(mg + (size_t)row * D + col), m0, m1);
        *(u32x4*)(mg + (size_t)row * D + col) = pack8(m0 + a * g0, m1 + b * g1); } };
struct FOut { bf16_t* x1; const float* xp; const float* xs; const float* mod;
    __device__ __forceinline__ void operator()(int row, int col, f32x4 a, f32x4 b) const {
        const float* xr = row < TP ? xp + (size_t)row * D + col : xs + (size_t)(row - TP) * D + col;
        const float* g = mod + (size_t)brow_of(row) * NADA + 2 * D + col;
        *(u32x4*)(x1 + (size_t)row * D + col) = pack8(*(const f32x4*)xr + *(const f32x4*)g * a, *(const f32x4*)(xr + 4) + *(const f32x4*)(g + 4) * b); } };
struct FUp { bf16_t* act;
    __device__ __forceinline__ void operator()(int row, int col, f32x4 a, f32x4 b) const {
        u32x2 w; w.x = pk2(silu_f(a[0]) * b[0], silu_f(a[1]) * b[1]); w.y = pk2(silu_f(a[2]) * b[2], silu_f(a[3]) * b[3]);
        *(u32x2*)(act + (size_t)row * DFF + (col >> 1)) = w; } };
struct FDown { bf16_t* x1; const float* mod;
    __device__ __forceinline__ void operator()(int row, int col, f32x4 a, f32x4 b) const {
        const float* g = mod + (size_t)brow_of(row) * NADA + 5 * D + col;
        bf16_t* d = x1 + (size_t)row * D + col; f32x4 x0, x4; unpack8(*(const u32x4*)d, x0, x4);
        *(u32x4*)d = pack8(x0 + *(const f32x4*)g * a, x4 + *(const f32x4*)(g + 4) * b); } };

template <class F> __device__ __forceinline__ void run_gemm(unsigned char* smem, const bf16_t* A, const bf16_t* Bt, int Mm, int Nn, int Kk, const F& f, int Gg, int cc) {
    asm volatile("" : "+s"(Kk));
    pg8::Gemm g{A, Bt, Mm, Nn, Kk}; pg8::StaticOrder S; S.init(Mm, Nn, Gg, cc);
    EpiF<F> E{f};
    pg8::gemm_phase<EpiF<F>, pg8::StaticOrder, false>((PG8_LAS unsigned char*)smem, g, S, E, nullptr);
}

__device__ __forceinline__ void phase_norm(const float* xa, const float* xb, const float* gain, const float* mod, int sh_i, int sc_i, bf16_t* ob, float* of, int mode, const bf16_t* xh) {
    const int lane = threadIdx.x & 63, gw = blockIdx.x * 8 + (threadIdx.x >> 6), nw = gridDim.x * 8;
    f32x4 gn[4];
#pragma unroll
    for (int j = 0; j < 4; ++j) gn[j] = *(const f32x4*)(gain + j * 256 + lane * 4);
    for (int rowa = gw; rowa < M; rowa += 2 * nw) {
        f32x4 v[2][4], sc[2][4], sh[2][4];
#pragma unroll
        for (int r = 0; r < 2; ++r) { const int row = (rowa + r * nw) < M ? (rowa + r * nw) : (M - 1);
            {
                const float* xr = row < TP ? xa + (size_t)row * D : xb + (size_t)(row - TP) * D;
                const float* mr = mod + (size_t)brow_of(row) * NADA;
#pragma unroll
                for (int j = 0; j < 4; ++j) { const int c = j * 256 + lane * 4;
                    f32x4 t;
                    if (xh) { const u32x2 w = *(const u32x2*)(xh + (size_t)row * D + c); t = (f32x4){__uint_as_float(w.x << 16), __uint_as_float(w.x & 0xffff0000u), __uint_as_float(w.y << 16), __uint_as_float(w.y & 0xffff0000u)}; }
                    else t = *(const f32x4*)(xr + c);
                    v[r][j] = t;
                    sc[r][j] = *(const f32x4*)(mr + sc_i * D + c); sh[r][j] = *(const f32x4*)(mr + sh_i * D + c); } } }
#pragma unroll
        for (int r = 0; r < 2; ++r) { const int row = rowa + r * nw;
            if (row < M) {
                float ss = 0.f;
#pragma unroll
                for (int j = 0; j < 4; ++j) ss += v[r][j][0] * v[r][j][0] + v[r][j][1] * v[r][j][1] + v[r][j][2] * v[r][j][2] + v[r][j][3] * v[r][j][3];
#pragma unroll
                for (int o = 32; o >= 1; o >>= 1) ss += __shfl_xor(ss, o);
                const float rstd = rsqrtf(ss * (1.f / D) + EPS);
#pragma unroll
                for (int j = 0; j < 4; ++j) { const int c = j * 256 + lane * 4; f32x4 y = v[r][j] * rstd * gn[j];
                    if (mode == 0) { y = y * (sc[r][j] + 1.f) + sh[r][j];
                        u32x2 w; w.x = pk2(y[0], y[1]); w.y = pk2(y[2], y[3]); *(u32x2*)(ob + (size_t)row * D + c) = w; }
                    else *(f32x4*)(of + (size_t)row * D + c) = y; } } }
    }
}

__device__ __forceinline__ void gla_front(KP p, int row0, int h, float* LA, float* SEG) {
    const int tid = threadIdx.x; const float* glr = (const float*)(p->ws + WS_GLR);
    const float* wa = p->in[14]; const int ch = tid & 127, tg = tid >> 7;
    float* GL = SEG + 512;
    const f32x2 g2 = *(const f32x2*)(glr + (size_t)row0 * 16 + tid * 2);
    float w[16];
#pragma unroll
    for (int r = 0; r < 16; ++r) w[r] = wa[r * 512 + h * 128 + ch];
    const float bb = p->in[15][h * 128 + ch];
    *(f32x2*)(GL + tid * 2) = g2;
    __syncthreads();
    float run = 0.f;
#pragma unroll 4
    for (int i = 0; i < 16; ++i) { const int tok = tg * 16 + i; const float* g = GL + tok * 16; float z = bb;
#pragma unroll
        for (int r4 = 0; r4 < 4; ++r4) { const f32x4 g4 = *(const f32x4*)(g + r4 * 4); z += g4[0] * w[r4 * 4] + g4[1] * w[r4 * 4 + 1] + g4[2] * w[r4 * 4 + 2] + g4[3] * w[r4 * 4 + 3]; }
        const float ls = fminf(z, 0.f) - __logf(1.f + __expf(-fabsf(z)));
        run += ls * (1.f / 16.f); LA[tok * 132 + ch] = run; }
    SEG[tg * 128 + ch] = run;
    __syncthreads();
    if (tg > 0) { float off = SEG[ch]; if (tg > 1) off += SEG[128 + ch]; if (tg > 2) off += SEG[256 + ch];
#pragma unroll 4
        for (int i = 0; i < 16; ++i) LA[(tg * 16 + i) * 132 + ch] += off; }
    __syncthreads();
}
struct VRows { bf16x8 r[4]; };
__device__ __forceinline__ VRows gla_fetch_v(const bf16_t* proj, int row0, int h) {
    const int tid = threadIdx.x, t4 = tid & 15, vg = tid >> 4; VRows v;
#pragma unroll
    for (int j = 0; j < 4; ++j) v.r[j] = *(const bf16x8*)(proj + (size_t)(row0 + 4 * t4 + j) * NIN + C_GV + h * 256 + vg * 8);
    return v;
}
__device__ __forceinline__ void gla_put_vt(const VRows& v, unsigned short* VT) {
    const int tid = threadIdx.x, t4 = tid & 15, vg = tid >> 4;
#pragma unroll
    for (int e = 0; e < 8; ++e) { u32x2 w; w.x = (unsigned)(unsigned short)v.r[0][e] | ((unsigned)(unsigned short)v.r[1][e] << 16); w.y = (unsigned)(unsigned short)v.r[2][e] | ((unsigned)(unsigned short)v.r[3][e] << 16);
        *(u32x2*)(VT + (vg * 8 + e) * 72 + 4 * t4) = w; }
}

__device__ void gla_passA(KP p, unsigned char* smem, int item) {
    const int tid = threadIdx.x, lane = tid & 63, wid = tid >> 6, l15 = lane & 15, quad = lane >> 4;
    const int bh = item >> 6, n = item & 63, b = bh >> 2, h = bh & 3, row0 = b * T + n * 64;
    float* LA = (float*)smem; unsigned short* KLT = (unsigned short*)(smem + 33792); unsigned short* VT = (unsigned short*)(smem + 33792 + 18432);
    const bf16_t* proj = (const bf16_t*)(p->ws + WS_PROJ);
    const VRows vrows = gla_fetch_v(proj, row0, h);
    bf16x8 r[4];
    { const int t4 = tid & 15, cgp = (tid >> 4) & 15;
#pragma unroll
        for (int j = 0; j < 4; ++j) r[j] = *(const bf16x8*)(proj + (size_t)(row0 + 4 * t4 + j) * NIN + C_GK + h * 128 + cgp * 8); }
    gla_front(p, row0, h, LA, (float*)(smem + 118784));
    if (tid < 256) { const int t4 = tid & 15, cgp = tid >> 4;
#pragma unroll
        for (int e = 0; e < 8; ++e) { const int ch = cgp * 8 + e; const float bl = LA[63 * 132 + ch]; float kf[4];
#pragma unroll
            for (int j = 0; j < 4; ++j) kf[j] = bf2f((unsigned short)r[j][e]) * __expf(bl - LA[(4 * t4 + j) * 132 + ch]);
            u32x2 w; w.x = pk2(kf[0], kf[1]); w.y = pk2(kf[2], kf[3]); *(u32x2*)(KLT + ch * 72 + 4 * t4) = w; } }
    gla_put_vt(vrows, VT);
    if (tid < 128) ((float*)(p->ws + WS_DEC))[item * 128 + tid] = __expf(LA[63 * 132 + tid]);
    __syncthreads();
    f32x4 acc[2][8];
#pragma unroll
    for (int i = 0; i < 2; ++i)
#pragma unroll
        for (int j = 0; j < 8; ++j) acc[i][j] = (f32x4){0.f, 0.f, 0.f, 0.f};
#pragma unroll
    for (int ks = 0; ks < 2; ++ks) { bf16x8 a[2];
#pragma unroll
        for (int mt = 0; mt < 2; ++mt) a[mt] = *(const bf16x8*)(VT + (32 * wid + 16 * mt + l15) * 72 + ks * 32 + quad * 8);
#pragma unroll
        for (int nt = 0; nt < 8; ++nt) { const bf16x8 bb = *(const bf16x8*)(KLT + (16 * nt + l15) * 72 + ks * 32 + quad * 8);
#pragma unroll
            for (int mt = 0; mt < 2; ++mt) acc[mt][nt] = mfma16(a[mt], bb, acc[mt][nt]); } }
    bf16_t* U = (bf16_t*)(p->ws + WS_U) + (size_t)item * 32768;
#pragma unroll
    for (int mt = 0; mt < 2; ++mt)
#pragma unroll
        for (int nt = 0; nt < 8; ++nt)
#pragma unroll
            for (int e = 0; e < 4; ++e) U[(32 * wid + 16 * mt + quad * 4 + e) * 128 + 16 * nt + l15] = f2bf(acc[mt][nt][e]);
    __syncthreads();
}

__device__ void gla_passC(KP p, unsigned char* smem, int item) {
    const int tid = threadIdx.x, lane = tid & 63, wid = tid >> 6, l15 = lane & 15, quad = lane >> 4;
    const int bh = item >> 6, n = item & 63, b = bh >> 2, h = bh & 3, row0 = b * T + n * 64;
    float* LA = (float*)smem; unsigned short* QG = (unsigned short*)(smem + 33792); unsigned short* KD = (unsigned short*)(smem + 51200);
    unsigned short* VT = (unsigned short*)(smem + 68608); unsigned short* ATT = (unsigned short*)(smem + 105472); float* RED = (float*)(smem + 114688);
    const bf16_t* proj = (const bf16_t*)(p->ws + WS_PROJ);
    const VRows vrows = gla_fetch_v(proj, row0, h);
    bf16x8 q8s[2], k8s[2];
#pragma unroll
    for (int it = 0; it < 2; ++it) { const int idx = tid + it * 512, cgp = idx & 15, tok = idx >> 4;
        q8s[it] = *(const bf16x8*)(proj + (size_t)(row0 + tok) * NIN + C_GQ + h * 128 + cgp * 8); k8s[it] = *(const bf16x8*)(proj + (size_t)(row0 + tok) * NIN + C_GK + h * 128 + cgp * 8); }
    const bf16_t* sst = (const bf16_t*)(p->ws + WS_SST) + (size_t)item * 32768;
    bf16x8 bsall[4][2];
#pragma unroll
    for (int ks = 0; ks < 4; ++ks)
#pragma unroll
        for (int nt = 0; nt < 2; ++nt) bsall[ks][nt] = *(const bf16x8*)(sst + (32 * wid + 16 * nt + l15) * 128 + ks * 32 + quad * 8);
    gla_front(p, row0, h, LA, (float*)(smem + 118784));
#pragma unroll
    for (int it = 0; it < 2; ++it) { const int idx = tid + it * 512, cgp = idx & 15, tok = idx >> 4;
        const bf16x8 q8 = q8s[it], k8 = k8s[it];
        f32x4 qa, qb, ka, kb;
#pragma unroll
        for (int e = 0; e < 8; ++e) { const float bc = LA[tok * 132 + cgp * 8 + e];
            const float qf = bf2f((unsigned short)q8[e]) * 0.08838834764831845f * __expf(bc), kf = bf2f((unsigned short)k8[e]) * __expf(-bc);
            if (e < 4) { qa[e] = qf; ka[e] = kf; } else { qb[e - 4] = qf; kb[e - 4] = kf; } }
        *(u32x4*)(QG + tok * 136 + cgp * 8) = pack8(qa, qb); *(u32x4*)(KD + tok * 136 + cgp * 8) = pack8(ka, kb); }
    gla_put_vt(vrows, VT);
    __syncthreads();
    { const int mt = wid >> 1; f32x4 c2[2] = {(f32x4){0.f, 0.f, 0.f, 0.f}, (f32x4){0.f, 0.f, 0.f, 0.f}};
#pragma unroll
        for (int ks = 0; ks < 4; ++ks) { const bf16x8 a = *(const bf16x8*)(QG + (16 * mt + l15) * 136 + ks * 32 + quad * 8);
#pragma unroll
            for (int j = 0; j < 2; ++j) { const int nt = 2 * (wid & 1) + j; const bf16x8 bb = *(const bf16x8*)(KD + (16 * nt + l15) * 136 + ks * 32 + quad * 8); c2[j] = mfma16(a, bb, c2[j]); } }
#pragma unroll
        for (int j = 0; j < 2; ++j)
#pragma unroll
            for (int e = 0; e < 4; ++e) { const int c = 16 * mt + quad * 4 + e, s = 16 * (2 * (wid & 1) + j) + l15; ATT[c * 72 + s] = f2bf(s <= c ? c2[j][e] : 0.f); } }
    __syncthreads();
    f32x4 o[4][2];
#pragma unroll
    for (int i = 0; i < 4; ++i)
#pragma unroll
        for (int j = 0; j < 2; ++j) o[i][j] = (f32x4){0.f, 0.f, 0.f, 0.f};
#pragma unroll
    for (int ks = 0; ks < 2; ++ks) { bf16x8 bv[2];
#pragma unroll
        for (int nt = 0; nt < 2; ++nt) bv[nt] = *(const bf16x8*)(VT + (32 * wid + 16 * nt + l15) * 72 + ks * 32 + quad * 8);
#pragma unroll
        for (int mt = 0; mt < 4; ++mt) { const bf16x8 a = *(const bf16x8*)(ATT + (16 * mt + l15) * 72 + ks * 32 + quad * 8);
#pragma unroll
            for (int nt = 0; nt < 2; ++nt) o[mt][nt] = mfma16(a, bv[nt], o[mt][nt]); } }
#pragma unroll
    for (int ks = 0; ks < 4; ++ks) { bf16x8 bs[2];
#pragma unroll
        for (int nt = 0; nt < 2; ++nt) bs[nt] = bsall[ks][nt];
#pragma unroll
        for (int mt = 0; mt < 4; ++mt) { const bf16x8 a = *(const bf16x8*)(QG + (16 * mt + l15) * 136 + ks * 32 + quad * 8);
#pragma unroll
            for (int nt = 0; nt < 2; ++nt) o[mt][nt] = mfma16(a, bs[nt], o[mt][nt]); } }
#pragma unroll
    for (int mt = 0; mt < 4; ++mt)
#pragma unroll
        for (int e = 0; e < 4; ++e) { float ss = o[mt][0][e] * o[mt][0][e] + o[mt][1][e] * o[mt][1][e];
            ss += __shfl_xor(ss, 1); ss += __shfl_xor(ss, 2); ss += __shfl_xor(ss, 4); ss += __shfl_xor(ss, 8);
            if (l15 == 0) RED[(16 * mt + quad * 4 + e) * 8 + wid] = ss; }
    __syncthreads();
    bf16_t* oa = (bf16_t*)(p->ws + WS_OA); const float* gng = p->in[16];
    unsigned short* OS = (unsigned short*)smem;
#pragma unroll
    for (int mt = 0; mt < 4; ++mt)
#pragma unroll
        for (int e = 0; e < 4; ++e) { const int c = 16 * mt + quad * 4 + e; const f32x4 r0 = *(const f32x4*)(RED + c * 8), r1 = *(const f32x4*)(RED + c * 8 + 4);
            const float tot = (r0[0] + r0[1]) + (r0[2] + r0[3]) + (r1[0] + r1[1]) + (r1[2] + r1[3]); const float rstd = rsqrtf(tot * (1.f / 256.f) + EPS);
#pragma unroll
            for (int nt = 0; nt < 2; ++nt) OS[c * 264 + 32 * wid + 16 * nt + l15] = f2bf(o[mt][nt][e] * rstd); }
    __syncthreads();
#pragma unroll
    for (int it = 0; it < 4; ++it) { const int idx = tid + it * 512, c = idx >> 5, d8 = (idx & 31) * 8;
        f32x4 o0, o1, s0, s1; unpack8(*(const u32x4*)(OS + c * 264 + d8), o0, o1);
        unpack8(*(const u32x4*)(proj + (size_t)(row0 + c) * NIN + C_GR + h * 256 + d8), s0, s1);
        const f32x4 g0 = *(const f32x4*)(gng + d8), g1 = *(const f32x4*)(gng + d8 + 4);
#pragma unroll
        for (int j = 0; j < 4; ++j) { s0[j] = silu_f(s0[j]); s1[j] = silu_f(s1[j]); }
        *(u32x4*)(oa + (size_t)(row0 + c) * D + h * 256 + d8) = pack8(o0 * g0 * s0, o1 * g1 * s1); }
    __syncthreads();
}

__device__ void gla_passB(KP p) {
    const int gtid = blockIdx.x * 512 + threadIdx.x, gsz = gridDim.x * 512;
    const bf16_t* U = (const bf16_t*)(p->ws + WS_U); const float* DEC = (const float*)(p->ws + WS_DEC); bf16_t* SST = (bf16_t*)(p->ws + WS_SST);
    for (int e4 = gtid; e4 < 131072; e4 += gsz) {
        const int bh = e4 >> 13, dv = (e4 >> 5) & 255, dk4 = (e4 & 31) * 4;
        f32x4 S = (f32x4){0.f, 0.f, 0.f, 0.f};
#pragma unroll 8
        for (int n = 0; n < 64; ++n) { const int item = bh * 64 + n; const size_t off = (size_t)item * 32768 + dv * 128 + dk4;
            u32x2 w; w.x = pk2(S[0], S[1]); w.y = pk2(S[2], S[3]); *(u32x2*)(SST + off) = w;
            const u32x2 ub = *(const u32x2*)(U + off); const f32x4 d4 = *(const f32x4*)(DEC + item * 128 + dk4);
            f32x4 u4; u4[0] = __uint_as_float(ub.x << 16); u4[1] = __uint_as_float(ub.x & 0xffff0000u); u4[2] = __uint_as_float(ub.y << 16); u4[3] = __uint_as_float(ub.y & 0xffff0000u);
            S = d4 * S + u4; }
#pragma unroll
        for (int j = 0; j < 4; ++j) p->out[O_SGP + ((size_t)(bh * 128 + dk4 + j)) * 256 + dv] = S[j];
    }
}

__device__ void gla_sample(KP p, unsigned char* smem, int item) {
    const int tid = threadIdx.x, lane = tid & 63, wid = tid >> 6;
    const int db = item >> 2, h = item & 3, row0 = TP + db * 4;
    float* BC = (float*)smem;
    float* QG = BC + 512; float* KD = QG + 512; float* KL = KD + 512; float* DECs = KL + 512;
    float* V = DECs + 128;
    float* ATT = V + 1024;
    float* RS = ATT + 16;
    float* RED = RS + 16;
    const bf16_t* proj = (const bf16_t*)(p->ws + WS_PROJ); const float* glr = (const float*)(p->ws + WS_GLR);
    const int tok = tid >> 7, ch = tid & 127;
    { float z = p->in[15][h * 128 + ch]; const float* g = glr + (size_t)(row0 + tok) * 16;
#pragma unroll
        for (int r = 0; r < 16; ++r) z += g[r] * p->in[14][r * 512 + h * 128 + ch];
        BC[tok * 128 + ch] = (fminf(z, 0.f) - __logf(1.f + __expf(-fabsf(z)))) * (1.f / 16.f); }
    __syncthreads();
    if (tid < 128) { float s = 0.f;
#pragma unroll
        for (int t = 0; t < 4; ++t) { s += BC[t * 128 + tid]; BC[t * 128 + tid] = s; } }
    __syncthreads();
    { const float bc = BC[tok * 128 + ch], bl = BC[3 * 128 + ch];
        const float q = bf2f(proj[(size_t)(row0 + tok) * NIN + C_GQ + h * 128 + ch]), k = bf2f(proj[(size_t)(row0 + tok) * NIN + C_GK + h * 128 + ch]);
        QG[tok * 128 + ch] = q * 0.08838834764831845f * __expf(bc); KD[tok * 128 + ch] = k * __expf(-bc); KL[tok * 128 + ch] = k * __expf(bl - bc);
        if (tok == 0) DECs[ch] = __expf(bl);
#pragma unroll
        for (int j = 0; j < 2; ++j) { const int i = tid + j * 512, t2 = i >> 8, dv = i & 255; V[i] = bf2f(proj[(size_t)(row0 + t2) * NIN + C_GV + h * 256 + dv]); } }
    __syncthreads();
    {
#pragma unroll
        for (int j = 0; j < 2; ++j) { const int pr = wid + 8 * j, c = pr >> 2, s = pr & 3;
            float d = QG[c * 128 + lane] * KD[s * 128 + lane] + QG[c * 128 + 64 + lane] * KD[s * 128 + 64 + lane];
#pragma unroll
            for (int o = 32; o >= 1; o >>= 1) d += __shfl_xor(d, o);
            if (lane == 0) ATT[pr] = s <= c ? d : 0.f; } }
    __syncthreads();
    const int dvq = lane * 4;
    f32x4 v4[4], inter[4];
#pragma unroll
    for (int t = 0; t < 4; ++t) { v4[t] = *(const f32x4*)(V + t * 256 + dvq); inter[t] = (f32x4){0.f, 0.f, 0.f, 0.f}; }
    const float* S0 = p->in[2] + (size_t)(db * 4 + h) * 32768; float* S1 = p->out + O_SGS + (size_t)(db * 4 + h) * 32768;
#pragma unroll 4
    for (int it = 0; it < 16; ++it) { const int dk = it * 8 + wid;
        const f32x4 s4 = __builtin_nontemporal_load((const f32x4*)(S0 + dk * 256 + dvq));
        f32x4 nw = s4 * DECs[dk];
#pragma unroll
        for (int t = 0; t < 4; ++t) { inter[t] += s4 * QG[t * 128 + dk]; nw += v4[t] * KL[t * 128 + dk]; }
        __builtin_nontemporal_store(nw, (f32x4*)(S1 + dk * 256 + dvq)); }
#pragma unroll
    for (int t = 0; t < 4; ++t) *(f32x4*)(RED + (wid * 4 + t) * 256 + dvq) = inter[t];
    __syncthreads();
    { const int dv2 = (tid & 127) * 2; float o0 = 0.f, o1 = 0.f;
#pragma unroll
        for (int w = 0; w < 8; ++w) { const f32x2 r = *(const f32x2*)(RED + (w * 4 + tok) * 256 + dv2); o0 += r[0]; o1 += r[1]; }
#pragma unroll
        for (int s = 0; s < 4; ++s) { const float a = ATT[tok * 4 + s]; o0 += a * V[s * 256 + dv2]; o1 += a * V[s * 256 + dv2 + 1]; }
        float ss = o0 * o0 + o1 * o1;
#pragma unroll
        for (int o = 32; o >= 1; o >>= 1) ss += __shfl_xor(ss, o);
        if (lane == 0) RS[wid] = ss;
        __syncthreads();
        const float rstd = rsqrtf((RS[2 * tok] + RS[2 * tok + 1]) * (1.f / 256.f) + EPS);
        const int row = row0 + tok; const float* gng = p->in[16];
        const float y0 = o0 * rstd * gng[dv2] * silu_f(bf2f(proj[(size_t)row * NIN + C_GR + h * 256 + dv2]));
        const float y1 = o1 * rstd * gng[dv2 + 1] * silu_f(bf2f(proj[(size_t)row * NIN + C_GR + h * 256 + dv2 + 1]));
        *(unsigned*)((bf16_t*)(p->ws + WS_OA) + (size_t)row * D + h * 256 + dv2) = pk2(y0, y1); }
    __syncthreads();
}

__device__ void dsw_prompt(KP p, unsigned char* smem, int item) {
    const int tid = threadIdx.x, lane = tid & 63, wid = tid >> 6, l15 = lane & 15, quad = lane >> 4;
    const int blk = item & 31, gh = (item >> 5) % 12, b = item / 384;
    const int g = gh >> 2, dil = 1 << (2 * g), nbc = 32 >> (2 * g);
    const int r = blk / nbc, l0 = (blk % nbc) * 128;
    unsigned short* KS = (unsigned short*)smem;
    unsigned short* VT = (unsigned short*)(smem + 39168);
    unsigned short* PS = (unsigned short*)(smem + 75008) + wid * (16 * 168);
    const bf16_t* proj = (const bf16_t*)(p->ws + WS_PROJ);
    const int qrow = b * T + (l0 + 16 * wid + l15) * dil + r;
    bf16x8 qa[2];
#pragma unroll
    for (int ks = 0; ks < 2; ++ks) qa[ks] = *(const bf16x8*)(proj + (size_t)qrow * NIN + C_DQ + gh * 64 + ks * 32 + quad * 8);
    u32x4 kreg[5];
#pragma unroll
    for (int it = 0; it < 5; ++it) { const int idx = tid + it * 512, i = idx >> 3, c8 = idx & 7, l = l0 - 144 + i; kreg[it] = (u32x4){0u, 0u, 0u, 0u};
        if (idx < 2176 && l >= 0) kreg[it] = *(const u32x4*)(proj + (size_t)(b * T + l * dil + r) * NIN + C_DK + gh * 64 + c8 * 8); }
    bf16x8 vreg[2][4];
#pragma unroll
    for (int it = 0; it < 2; ++it) { const int idx = tid + it * 512, c8 = idx / 68, i = 4 * (idx - c8 * 68), l = l0 - 144 + i;
#pragma unroll
        for (int j = 0; j < 4; ++j) { vreg[it][j] = (bf16x8){0, 0, 0, 0, 0, 0, 0, 0}; if (idx < 544 && l >= 0) vreg[it][j] = *(const bf16x8*)(proj + (size_t)(b * T + (l + j) * dil + r) * NIN + C_DV + gh * 64 + c8 * 8); } }
#pragma unroll
    for (int it = 0; it < 5; ++it) { const int idx = tid + it * 512, i = idx >> 3, c8 = idx & 7; if (idx < 2176) *(u32x4*)(KS + i * 72 + c8 * 8) = kreg[it]; }
#pragma unroll
    for (int it = 0; it < 2; ++it) { const int idx = tid + it * 512, c8 = idx / 68, i = 4 * (idx - c8 * 68);
        if (idx < 544) {
#pragma unroll
            for (int e = 0; e < 8; ++e) { u32x2 w; w.x = (unsigned)(unsigned short)vreg[it][0][e] | ((unsigned)(unsigned short)vreg[it][1][e] << 16); w.y = (unsigned)(unsigned short)vreg[it][2][e] | ((unsigned)(unsigned short)vreg[it][3][e] << 16);
                *(u32x2*)(VT + (c8 * 8 + e) * 280 + i) = w; } } }
    __syncthreads();
    f32x4 s[9];
#pragma unroll
    for (int kt = 0; kt < 9; ++kt) { s[kt] = (f32x4){0.f, 0.f, 0.f, 0.f};
#pragma unroll
        for (int ks = 0; ks < 2; ++ks) { const bf16x8 bb = *(const bf16x8*)(KS + (16 * wid + 16 * (kt + 1) + l15) * 72 + ks * 32 + quad * 8); s[kt] = mfma16(qa[ks], bb, s[kt]); } }
    float mx[4] = {-INFINITY, -INFINITY, -INFINITY, -INFINITY};
#pragma unroll
    for (int kt = 0; kt < 9; ++kt)
#pragma unroll
        for (int e = 0; e < 4; ++e) { const int dist = 144 + quad * 4 + e - 16 * (kt + 1) - l15, lk = l0 - 144 + 16 * wid + 16 * (kt + 1) + l15;
            const bool valid = dist >= 0 && dist <= 128 && lk >= 0; const float v = valid ? s[kt][e] * 0.125f : -INFINITY; s[kt][e] = v; mx[e] = fmaxf(mx[e], v); }
#pragma unroll
    for (int e = 0; e < 4; ++e) { mx[e] = fmaxf(mx[e], __shfl_xor(mx[e], 1)); mx[e] = fmaxf(mx[e], __shfl_xor(mx[e], 2)); mx[e] = fmaxf(mx[e], __shfl_xor(mx[e], 4)); mx[e] = fmaxf(mx[e], __shfl_xor(mx[e], 8)); }
    float den[4] = {0.f, 0.f, 0.f, 0.f};
#pragma unroll
    for (int e = 0; e < 4; ++e) PS[(quad * 4 + e) * 168 + l15] = 0;
#pragma unroll
    for (int kt = 0; kt < 9; ++kt)
#pragma unroll
        for (int e = 0; e < 4; ++e) { const float pe = __expf(s[kt][e] - mx[e]); den[e] += pe; PS[(quad * 4 + e) * 168 + 16 * (kt + 1) + l15] = f2bf(pe); }
#pragma unroll
    for (int e = 0; e < 4; ++e) { den[e] += __shfl_xor(den[e], 1); den[e] += __shfl_xor(den[e], 2); den[e] += __shfl_xor(den[e], 4); den[e] += __shfl_xor(den[e], 8); }
    __syncthreads();
    f32x4 o[4];
#pragma unroll
    for (int dt = 0; dt < 4; ++dt) o[dt] = (f32x4){0.f, 0.f, 0.f, 0.f};
#pragma unroll
    for (int ks = 0; ks < 5; ++ks) { const bf16x8 a = *(const bf16x8*)(PS + l15 * 168 + ks * 32 + quad * 8);
#pragma unroll
        for (int dt = 0; dt < 4; ++dt) { const bf16x8 bb = *(const bf16x8*)(VT + (16 * dt + l15) * 280 + 16 * wid + ks * 32 + quad * 8); o[dt] = mfma16(a, bb, o[dt]); } }
    bf16_t* og = (bf16_t*)(p->ws + WS_OG); float* lse = (float*)(p->ws + WS_LSE);
#pragma unroll
    for (int e = 0; e < 4; ++e) { const int tk = b * T + (l0 + 16 * wid + quad * 4 + e) * dil + r; const float inv = 1.f / den[e];
#pragma unroll
        for (int dt = 0; dt < 4; ++dt) og[(size_t)tk * 768 + gh * 64 + 16 * dt + l15] = f2bf(o[dt][e] * inv);
        if (l15 == 0) lse[tk * 12 + gh] = mx[e] + __logf(den[e]); }
    __syncthreads();
}

__device__ void dsw_combine(KP p) {
    const int gtid = blockIdx.x * 512 + threadIdx.x, gsz = gridDim.x * 512;
    const bf16_t* og = (const bf16_t*)(p->ws + WS_OG); const float* lse = (const float*)(p->ws + WS_LSE); bf16_t* ob = (bf16_t*)(p->ws + WS_OB);
    for (int idx = gtid; idx < TP * 32; idx += gsz) { const int d8 = idx & 7, hh = (idx >> 3) & 3, tk = idx >> 5;
        const float l0 = lse[tk * 12 + hh], l1 = lse[tk * 12 + 4 + hh], l2 = lse[tk * 12 + 8 + hh];
        const float mx = fmaxf(l0, fmaxf(l1, l2)); float w0 = __expf(l0 - mx), w1 = __expf(l1 - mx), w2 = __expf(l2 - mx); const float inv = 1.f / (w0 + w1 + w2); w0 *= inv; w1 *= inv; w2 *= inv;
        f32x4 a0, b0, a1, b1, a2, b2;
        unpack8(*(const u32x4*)(og + (size_t)tk * 768 + hh * 64 + d8 * 8), a0, b0);
        unpack8(*(const u32x4*)(og + (size_t)tk * 768 + (4 + hh) * 64 + d8 * 8), a1, b1);
        unpack8(*(const u32x4*)(og + (size_t)tk * 768 + (8 + hh) * 64 + d8 * 8), a2, b2);
        *(u32x4*)(ob + (size_t)tk * 256 + hh * 64 + d8 * 8) = pack8(a0 * w0 + a1 * w1 + a2 * w2, b0 * w0 + b1 * w1 + b2 * w2); }
}

__device__ void dsw_sample(KP p, unsigned char* smem, int witem) {
    const int lane = threadIdx.x & 63, wid = threadIdx.x >> 6;
    float* qs = (float*)smem + wid * 256; float* ps = qs + 64;
    const int s = witem & 3, hh = (witem >> 2) & 3, db = witem >> 4, row = TP + db * 4 + s;
    const bf16_t* proj = (const bf16_t*)(p->ws + WS_PROJ);
    float rmx = -INFINITY, rws = 0.f; f32x4 racc = (f32x4){0.f, 0.f, 0.f, 0.f};
    const int ksl = lane >> 2, part = lane & 3, kq = lane >> 4, d4 = (lane & 15) * 4;
#pragma unroll 1
    for (int g = 0; g < 3; ++g) {
        const int W = 128 << (2 * g), dil = 1 << (2 * g);
        const float* cache = p->in[3 + g] + (size_t)db * W * 512 + hh * 64;
        const float* kvn = p->out + okvs(g) + (size_t)(db * W + W - 4) * 512 + hh * 64;
        qs[lane] = bf2f(proj[(size_t)row * NIN + C_DQ + (g * 4 + hh) * 64 + 2 * (lane & 31) + (lane >> 5)]);
        __builtin_amdgcn_wave_barrier();
        f32x4 q4[4];
#pragma unroll
        for (int c = 0; c < 4; ++c) q4[c] = *(const f32x4*)(qs + part * 16 + c * 4);
#pragma unroll 5
        for (int pi = 0; pi < 9; ++pi) { const int j = pi * 16 + ksl; float dot = 0.f;
            if (j <= 128) { const int idx = W + s - j * dil; const float* kr = (idx >= W ? kvn + (size_t)(idx - W) * 512 : cache + (size_t)idx * 512) + part * 16;
#pragma unroll
                for (int c = 0; c < 4; ++c) { const f32x4 k4 = *(const f32x4*)(kr + c * 4); dot += k4[0] * q4[c][0] + k4[1] * q4[c][1] + k4[2] * q4[c][2] + k4[3] * q4[c][3]; } }
            dot += __shfl_xor(dot, 1); dot += __shfl_xor(dot, 2);
            if (part == 0 && j <= 128) ps[j] = dot * 0.125f; }
        __builtin_amdgcn_wave_barrier();
        float sc[3]; float m = -INFINITY;
#pragma unroll
        for (int jj = 0; jj < 3; ++jj) { const int j = lane + 64 * jj; sc[jj] = j <= 128 ? ps[j] : -INFINITY; m = fmaxf(m, sc[jj]); }
#pragma unroll
        for (int o = 32; o >= 1; o >>= 1) m = fmaxf(m, __shfl_xor(m, o));
        float den = 0.f;
        __builtin_amdgcn_wave_barrier();
#pragma unroll
        for (int jj = 0; jj < 3; ++jj) { const int j = lane + 64 * jj; if (j <= 128) { const float e = __expf(sc[jj] - m); den += e; ps[j] = e; } }
#pragma unroll
        for (int o = 32; o >= 1; o >>= 1) den += __shfl_xor(den, o);
        __builtin_amdgcn_wave_barrier();
        f32x4 o = (f32x4){0.f, 0.f, 0.f, 0.f};
#pragma unroll 17
        for (int jt = 0; jt < 33; ++jt) { const int j = jt * 4 + kq;
            if (j <= 128) { const int idx = W + s - j * dil; const float* vr = (idx >= W ? kvn + (size_t)(idx - W) * 512 : cache + (size_t)idx * 512) + 256 + d4;
                o += *(const f32x4*)vr * ps[j]; } }
#pragma unroll
        for (int c = 0; c < 4; ++c) { o[c] += __shfl_xor(o[c], 16); o[c] += __shfl_xor(o[c], 32); }
        const float lg = m + __logf(den), nm = fmaxf(rmx, lg), sc_old = __expf(rmx - nm), wg = __expf(lg - nm);
        racc = racc * sc_old + o * (wg / den); rws = rws * sc_old + wg; rmx = nm;
        __builtin_amdgcn_wave_barrier();
    }
    if (lane < 16) { const float inv = 1.f / rws; u32x2 w; w.x = pk2(racc[0] * inv, racc[1] * inv); w.y = pk2(racc[2] * inv, racc[3] * inv);
        *(u32x2*)((bf16_t*)(p->ws + WS_OB) + (size_t)row * 256 + hh * 64 + d4) = w; }
}

constexpr unsigned NCH0 = 496, NCH1 = 2032, NCH2 = 8176, NCHUNK = NCH0 + NCH1 + NCH2;
__device__ __forceinline__ void half_where(KP p, unsigned c, const f32x4*& src, f32x4*& dst, unsigned& cl, unsigned& per) {
    if (c < NCH0) { src = (const f32x4*)p->in[3]; dst = (f32x4*)(p->out + O_KVS0); cl = c; per = 124u * 128u; }
    else if (c < NCH0 + NCH1) { src = (const f32x4*)p->in[4]; dst = (f32x4*)(p->out + O_KVS1); cl = c - NCH0; per = 508u * 128u; }
    else { src = (const f32x4*)p->in[5]; dst = (f32x4*)(p->out + O_KVS2); cl = c - NCH0 - NCH1; per = 2044u * 128u; }
}
#define HALF_LOAD(H, c) do { const f32x4* src_; f32x4* dst_; unsigned cl_, per_; half_where(p, (c), src_, dst_, cl_, per_); \
    const unsigned i0_ = cl_ * 4096u + threadIdx.x, db0_ = i0_ / per_, rem0_ = i0_ - db0_ * per_; \
    _Pragma("unroll") for (int u = 0; u < 8; ++u) { const unsigned rem_ = rem0_ + u * 512u; H##d[u] = i0_ + u * 512u + 512u * (db0_ + (rem_ >= per_ ? 1u : 0u)); H##v[u] = __builtin_nontemporal_load(src_ + H##d[u] + 512u); } } while (0)
#define HALF_STORE(H, c) do { const f32x4* src_; f32x4* dst_; unsigned cl_, per_; half_where(p, (c), src_, dst_, cl_, per_); \
    _Pragma("unroll") for (int u = 0; u < 8; ++u) __builtin_nontemporal_store(H##v[u], dst_ + H##d[u]); } while (0)
__device__ __forceinline__ unsigned copier_claim(unsigned* ctl, int done_slot, unsigned need) {
    const bool stop = need != 0u && __hip_atomic_load(ctl + 32 * done_slot, __ATOMIC_RELAXED, __HIP_MEMORY_SCOPE_AGENT) >= need;
    return stop ? 0xffffffffu : __hip_atomic_fetch_add(ctl, 1u, __ATOMIC_RELAXED, __HIP_MEMORY_SCOPE_AGENT);
}
__device__ void copier(KP p, int done_slot, unsigned need, unsigned char* smem) {
    unsigned* ctl = (unsigned*)(p->ws + WS_CTL); volatile unsigned* sh = (volatile unsigned*)smem;
    f32x4 Av[8], Bv[8]; unsigned Ad[8], Bd[8];
    __syncthreads();
    if (threadIdx.x == 0) sh[0] = copier_claim(ctl, done_slot, need);
    __syncthreads();
    unsigned ca = sh[0];
    if (ca >= NCHUNK) return;
    HALF_LOAD(A, ca);
    for (;;) {
        __syncthreads();
        if (threadIdx.x == 0) sh[0] = copier_claim(ctl, done_slot, need);
        __syncthreads();
        const unsigned cb = sh[0];
        if (cb < NCHUNK) HALF_LOAD(B, cb);
        HALF_STORE(A, ca);
        if (cb >= NCHUNK) break;
        __syncthreads();
        if (threadIdx.x == 0) sh[0] = copier_claim(ctl, done_slot, need);
        __syncthreads();
        ca = sh[0];
        if (ca < NCHUNK) HALF_LOAD(A, ca);
        HALF_STORE(B, cb);
        if (ca >= NCHUNK) break;
    }
}
__device__ __forceinline__ void gemm_done(KP p, int done_slot) {
    __syncthreads();
    if (threadIdx.x == 0) __hip_atomic_fetch_add((unsigned*)(p->ws + WS_CTL) + 32 * done_slot, 1u, __ATOMIC_RELAXED, __HIP_MEMORY_SCOPE_AGENT);
}

__global__ void __launch_bounds__(512) fwd(Params pv) {
    extern __shared__ __attribute__((aligned(16))) unsigned char smem[];
    cg::grid_group grid = cg::this_grid();
    const int G = gridDim.x, bid = blockIdx.x;
    constexpr int C3 = 8, C10 = 8, CN = 120;
#define WSP(T, off) ((T*)(p->ws + (off)))
    if (threadIdx.x < 4) ((volatile LAS unsigned*)(smem + 131072))[threadIdx.x] = 0u;
    __syncthreads();
    const XcdBarrier xbar = xcd_barrier_post((unsigned*)(pv.ws + WS_BAR), (volatile LAS unsigned*)(smem + 131072));
    if (pv.ws == nullptr) grid.sync();
    { KP p = kargs(); if (PHMASK & 1) phase_prep(p, smem); }
    xcd_barrier(xbar);
    { KP p = kargs(); if (bid < 24) { run_gemm(smem, WSP(const bf16_t, WS_SC), WSP(const bf16_t, WS_WADA), 256, NADA, D, FMod{WSP(float, WS_MOD), p->in[11]}, 24, bid); gemm_done(p, 1); } else copier(p, 1, 1u, smem); }
    xcd_barrier(xbar);
    { KP p = kargs(); if (PHMASK & 4) phase_norm(p->in[0], p->in[1], p->in[8], WSP(const float, WS_MOD), 0, 1, WSP(bf16_t, WS_H), nullptr, 0, nullptr); }
    xcd_barrier(xbar);
    { KP p = kargs(); if (bid >= C3) {
        LAS float* lb = (LAS float*)(smem + LDS_XTRA);
        for (int i = threadIdx.x; i < NIN + 32; i += 512) { float v;
            if (i < NIN) v = WSP(const float, WS_BIN)[i];
            else { double inv = 1.0; for (int q = 0; q < i - NIN; ++q) inv *= 0.74989420933245582730; v = (float)inv; }
            lb[i] = v; }
        __syncthreads();
        run_gemm(smem, WSP(const bf16_t, WS_H), WSP(const bf16_t, WS_WIN), M, NIN, D, FIn{WSP(bf16_t, WS_PROJ), WSP(float, WS_GLR), lb, p->out}, G - C3, bid - C3); gemm_done(p, 2); } else copier(p, 2, 5u, smem); }
    xcd_barrier(xbar);
    { KP p = kargs();
      unsigned* qctr = (unsigned*)(p->ws + WS_CTL) + 32 * 7; volatile unsigned* shq = (volatile unsigned*)(smem + 131072 + 8);
      for (;;) {
          __syncthreads();
          if (threadIdx.x == 0) shq[0] = __hip_atomic_fetch_add(qctr, 1u, __ATOMIC_RELAXED, __HIP_MEMORY_SCOPE_AGENT);
          __syncthreads();
          const int k = (int)shq[0]; if (k >= 3328) break;
          const int q = k / 13, r = k - q * 13;
          if ((r & 3) == 0 && r < 12) { const int si = 3 * q + (r >> 2);
              if (si < 256) dsw_sample(p, smem, si * 8 + (int)(threadIdx.x >> 6)); else gla_sample(p, smem, si - 256); }
          else { const int pi = 10 * q + r - ((r + 3) >> 2);
              if (pi < 1536) dsw_prompt(p, smem, pi); else gla_passA(p, smem, pi - 1536); }
      } }
    xcd_barrier(xbar);
    { KP p = kargs(); if (PHMASK & 512) gla_passB(p); }
    xcd_barrier(xbar);
    { KP p = kargs(); if (PHMASK & 1024) dsw_combine(p); }
    { KP p = kargs(); if (PHMASK & 2048) for (int it = bid; it < 1024; it += G) gla_passC(p, smem, it); }
    xcd_barrier(xbar);
    { KP p = kargs(); if (bid >= CN) { run_gemm(smem, WSP(const bf16_t, WS_OA), WSP(const bf16_t, WS_WPA), M, D, D, FPa{WSP(bf16_t, WS_MG), WSP(const bf16_t, WS_PROJ)}, G - CN, bid - CN); } }
    { KP p = kargs(); if (bid >= CN) { run_gemm(smem, WSP(const bf16_t, WS_OB), WSP(const bf16_t, WS_WPB), M, D, 256, FPb{WSP(bf16_t, WS_MG), WSP(const bf16_t, WS_PROJ)}, G - CN, bid - CN); gemm_done(p, 3); } else copier(p, 3, 9u, smem); }
    xcd_barrier(xbar);
    { KP p = kargs(); if (bid >= CN) { run_gemm(smem, WSP(const bf16_t, WS_MG), WSP(const bf16_t, WS_WOUT), M, D, D, FOut{WSP(bf16_t, WS_X1), p->in[0], p->in[1], WSP(const float, WS_MOD)}, G - CN, bid - CN); gemm_done(p, 4); } else copier(p, 4, 9u, smem); }
    xcd_barrier(xbar);
    { KP p = kargs(); if (PHMASK & 32768) phase_norm(nullptr, nullptr, p->in[9], WSP(const float, WS_MOD), 3, 4, WSP(bf16_t, WS_H), nullptr, 0, WSP(const bf16_t, WS_X1)); }
    xcd_barrier(xbar);
    { KP p = kargs(); if (bid >= C10) { run_gemm(smem, WSP(const bf16_t, WS_H), WSP(const bf16_t, WS_WUP), M, NUP, D, FUp{WSP(bf16_t, WS_ACT)}, G - C10, bid - C10); gemm_done(p, 5); } else copier(p, 5, 37u, smem); }
    xcd_barrier(xbar);
    { KP p = kargs(); if (bid >= CN) { run_gemm(smem, WSP(const bf16_t, WS_ACT), WSP(const bf16_t, WS_WDN), M, D, DFF, FDown{WSP(bf16_t, WS_X1), WSP(const float, WS_MOD)}, G - CN, bid - CN); gemm_done(p, 6); } else copier(p, 6, 9u, smem); }
    xcd_barrier(xbar);
    { KP p = kargs(); if (PHMASK & 262144) phase_norm(nullptr, nullptr, p->in[22], WSP(const float, WS_MOD), 0, 0, nullptr, p->out + O_Y, 1, WSP(const bf16_t, WS_X1));
      copier(p, 0, 0u, smem); }
#undef WSP
}
}

extern "C" void kernel_launch(void* const* d_in, const int* in_sizes, int n_in, void* d_out, int out_size, void* d_ws, size_t ws_size, hipStream_t stream) {
    static int grid = 0;
    if (grid == 0) {
        int dev = 0, cus = 0, per_cu = 0;
        hipGetDevice(&dev);
        hipDeviceGetAttribute(&cus, hipDeviceAttributeMultiprocessorCount, dev);
        if (hipFuncSetAttribute((const void*)mk::fwd, hipFuncAttributeMaxDynamicSharedMemorySize, mk::LDS_BYTES) != hipSuccess) fprintf(stderr, "kernel_launch: hipFuncSetAttribute failed\n");
        if (hipOccupancyMaxActiveBlocksPerMultiprocessor(&per_cu, (const void*)mk::fwd, 512, mk::LDS_BYTES) != hipSuccess || per_cu < 1) { fprintf(stderr, "kernel_launch: occupancy query says %d blocks per CU\n", per_cu); per_cu = 1; }
        (void)hipGetLastError();
        grid = cus > 0 ? cus : 256;
        if (n_in != 23 || (size_t)out_size != mk::O_END || ws_size < mk::WS_END) fprintf(stderr, "kernel_launch: unexpected sizes n_in %d out %d ws %zu (need %zu)\n", n_in, out_size, ws_size, (size_t)mk::WS_END);
    }
    if (hipMemsetAsync((char*)d_ws + mk::WS_CTL, 0, 4096 + 16384, stream) != hipSuccess) fprintf(stderr, "kernel_launch: memset of control words failed\n");
    mk::Params p{};
    for (int i = 0; i < 23; ++i) p.in[i] = (const float*)d_in[i];
    p.out = (float*)d_out; p.ws = (unsigned char*)d_ws;
    void* args[] = {&p};
    hipError_t e = hipLaunchCooperativeKernel((const void*)mk::fwd, dim3(grid), dim3(512), args, mk::LDS_BYTES, stream);
    if (e != hipSuccess) fprintf(stderr, "cooperative launch failed: %s (grid %d)\n", hipGetErrorString(e), grid);
}
```
